# Optimizing an MI355X kernel written in HIP

```python
import math
import jax, jax.numpy as jnp
from jax import lax
import numpy as np

D_MODEL = 1024
BATCH = 4
SEQ = 4096
DEPTH = 1

SSM_WIDTH = D_MODEL // 2
SSM_GROUP = 16
SSM_GROUPS = SSM_WIDTH // SSM_GROUP
SSM_STATE = 64
NSA_HEADS = 8
NSA_KV_GROUPS = 2
NSA_HEAD_DIM = (D_MODEL // 2) // NSA_HEADS
NSA_WIDTH = NSA_HEADS * NSA_HEAD_DIM
KV_WIDTH = NSA_KV_GROUPS * NSA_HEAD_DIM
CMP_BLOCK = 32
CMP_STRIDE = 16
CMP_HIDDEN = 2 * NSA_HEAD_DIM
SEL_BLOCK = 64
SEL_TOPK = 16
WINDOW = 512
Q_BLOCK = 128
FORCE_BONUS = 1.0e4
PEER_HEADS = 8
PEER_NKEYS = 128
PEER_EXPERTS = PEER_NKEYS * PEER_NKEYS
PEER_KEY_DIM = 128
PEER_TOPK = 16
PEER_CHUNK = 128
IN_COLS = SSM_WIDTH + NSA_WIDTH + 6 * KV_WIDTH + 3 * NSA_HEADS + 2 * D_MODEL
DN_ALPHA = (2.0 * DEPTH) ** 0.25
DN_BETA = (8.0 * DEPTH) ** -0.25
LN_EPS = 1e-5
NEG = -1e30

kernel_name = "hybrid_s5_nsa_peer_deepnorm"


def layer_norm(x, g, b):
    xf = x.astype(jnp.float32)
    mu = xf.mean(-1, keepdims=True)
    var = jnp.square(xf - mu).mean(-1, keepdims=True)
    return ((xf - mu) * lax.rsqrt(var + LN_EPS) * g.astype(jnp.float32) + b.astype(jnp.float32)).astype(x.dtype)


def masked_softmax(s, mask):
    s = jnp.where(mask, s.astype(jnp.float32), NEG)
    m = jnp.max(s, axis=-1, keepdims=True)
    p = jnp.exp(s - m) * mask
    return p / jnp.maximum(p.sum(-1, keepdims=True), 1e-30)


def alibi_slopes():
    return jnp.exp2(-8.0 * jnp.arange(1, NSA_HEADS + 1, dtype=jnp.float32) / NSA_HEADS)


def s5_mixer(u, a_re, a_im, log_dt, b_re, b_im, c_re, c_im, d_skip, w_glu):
    Bsz, S, _ = u.shape
    f32 = jnp.float32
    uf = u.astype(f32).reshape(Bsz, S, SSM_GROUPS, SSM_GROUP)
    lam = lax.complex(a_re.astype(f32), a_im.astype(f32))
    dt = jnp.exp(log_dt.astype(f32))[:, None]
    lam_bar = jnp.exp(lam * dt)
    b = lax.complex(b_re.astype(f32), b_im.astype(f32))
    b_bar = ((lam_bar - 1.0) / lam)[:, :, None] * b
    bu = lax.complex(jnp.einsum('bsgh,gph->sbgp', uf, jnp.real(b_bar)),
                     jnp.einsum('bsgh,gph->sbgp', uf, jnp.imag(b_bar)))
    a = jnp.broadcast_to(lam_bar[None, None], (S, 1) + lam_bar.shape)

    def combine(left, right):
        a_l, b_l = left
        a_r, b_r = right
        return a_r * a_l, a_r * b_l + b_r

    _, xs = lax.associative_scan(combine, (a, bu), axis=0)
    y = (jnp.einsum('sbgp,ghp->bsgh', jnp.real(xs), c_re.astype(f32))
         - jnp.einsum('sbgp,ghp->bsgh', jnp.imag(xs), c_im.astype(f32)))
    y = y.reshape(Bsz, S, SSM_WIDTH) + d_skip.astype(f32) * uf.reshape(Bsz, S, SSM_WIDTH)
    y = jax.nn.gelu(y)
    ga, gb = jnp.split(y @ w_glu.astype(f32), 2, axis=-1)
    return (ga * jax.nn.sigmoid(gb)).astype(u.dtype)


def compress(kv, pe, w1, w2):
    S = kv.shape[2]
    n_cmp = (S - CMP_BLOCK) // CMP_STRIDE + 1
    pos = jnp.arange(n_cmp)[:, None] * CMP_STRIDE + jnp.arange(CMP_BLOCK)[None, :]
    blocks = kv[:, :, pos] + pe
    flat = blocks.reshape(blocks.shape[:3] + (CMP_BLOCK * NSA_HEAD_DIM,))
    return jax.nn.gelu(flat @ w1) @ w2


def nsa_mixer(q, k_cmp, v_cmp, k_slc, v_slc, k_win, v_win, gates,
              pe_k, w1_k, w2_k, pe_v, w1_v, w2_v):
    Bsz, S, _ = q.shape
    G, R, dk = NSA_KV_GROUPS, NSA_HEADS // NSA_KV_GROUPS, NSA_HEAD_DIM
    f32 = jnp.float32
    qh = q.reshape(Bsz, S, G, R, dk).transpose(0, 2, 3, 1, 4) * (dk ** -0.5)

    def kvh(t):
        return t.reshape(Bsz, S, G, dk).transpose(0, 2, 1, 3)

    gate = jax.nn.sigmoid(gates.astype(f32)).reshape(Bsz, S, G, R, 3).transpose(0, 2, 3, 1, 4)
    slopes = alibi_slopes().reshape(G, R)[None, :, :, None, None]

    kc = compress(kvh(k_cmp), pe_k, w1_k, w2_k)
    vc = compress(kvh(v_cmp), pe_v, w1_v, w2_v)
    n_cmp = kc.shape[2]
    c_start = jnp.arange(n_cmp) * CMP_STRIDE
    c_end = c_start + CMP_BLOCK - 1
    n_slc = S // SEL_BLOCK
    s_start = jnp.arange(n_slc) * SEL_BLOCK
    overlap = ((c_start[:, None] < s_start[None, :] + SEL_BLOCK)
               & (c_start[:, None] + CMP_BLOCK > s_start[None, :])).astype(f32)
    n_pick = min(SEL_TOPK, n_slc)
    ks_blk = kvh(k_slc).reshape(Bsz, G, n_slc, SEL_BLOCK, dk)
    vs_blk = kvh(v_slc).reshape(Bsz, G, n_slc, SEL_BLOCK, dk)
    pad = ((0, 0), (0, 0), (WINDOW, 0), (0, 0))
    kw_pad = jnp.pad(kvh(k_win), pad)
    vw_pad = jnp.pad(kvh(v_win), pad)
    gather = jax.vmap(jax.vmap(lambda blk, ix: blk[ix]))
    j_idx = jnp.arange(n_slc)

    def query_block(i):
        qs = i * Q_BLOCK
        t = qs + jnp.arange(Q_BLOCK)
        qb = lax.dynamic_slice_in_dim(qh, qs, Q_BLOCK, axis=3)
        gb = lax.dynamic_slice_in_dim(gate, qs, Q_BLOCK, axis=3)
        s_c = jnp.einsum('bgrqd,bgcd->bgrqc', qb, kc)
        dist_c = (t[:, None] - c_end[None, :]).astype(f32)
        p_c = masked_softmax(s_c - slopes * dist_c, dist_c >= 0)
        o_c = jnp.einsum('bgrqc,bgcd->bgrqd', p_c.astype(vc.dtype), vc)
        imp = jnp.einsum('bgrqc,cj->bgqj', p_c, overlap)
        cur = t // SEL_BLOCK
        forced = (j_idx[None, :] == 0) | (j_idx[None, :] == cur[:, None]) | (j_idx[None, :] == cur[:, None] - 1)
        valid = s_start[None, :] <= t[:, None]
        score = jnp.where(valid, imp + forced * FORCE_BONUS, NEG)
        _, idx = lax.top_k(score, n_pick)
        ks = gather(ks_blk, idx).reshape(Bsz, G, Q_BLOCK, n_pick * SEL_BLOCK, dk)
        vs = gather(vs_blk, idx).reshape(Bsz, G, Q_BLOCK, n_pick * SEL_BLOCK, dk)
        kpos = (idx[..., None] * SEL_BLOCK + jnp.arange(SEL_BLOCK)).reshape(Bsz, G, Q_BLOCK, n_pick * SEL_BLOCK)
        dist_s = (t[None, None, :, None] - kpos).astype(f32)[:, :, None]
        s_s = jnp.einsum('bgrqd,bgqkd->bgrqk', qb, ks)
        p_s = masked_softmax(s_s - slopes * dist_s, dist_s >= 0)
        o_s = jnp.einsum('bgrqk,bgqkd->bgrqd', p_s.astype(vs.dtype), vs)
        kw = lax.dynamic_slice_in_dim(kw_pad, qs, Q_BLOCK + WINDOW, axis=2)
        vw = lax.dynamic_slice_in_dim(vw_pad, qs, Q_BLOCK + WINDOW, axis=2)
        wpos = qs - WINDOW + jnp.arange(Q_BLOCK + WINDOW)
        dist_w = t[:, None] - wpos[None, :]
        mask_w = (dist_w >= 0) & (dist_w < WINDOW) & (wpos[None, :] >= 0)
        s_w = jnp.einsum('bgrqd,bgkd->bgrqk', qb, kw)
        p_w = masked_softmax(s_w - slopes * dist_w.astype(f32), mask_w)
        o_w = jnp.einsum('bgrqk,bgkd->bgrqd', p_w.astype(vw.dtype), vw)
        return gb[..., 0:1] * o_c + gb[..., 1:2] * o_s + gb[..., 2:3] * o_w

    o = lax.map(query_block, jnp.arange(S // Q_BLOCK))
    return o.transpose(1, 0, 4, 2, 3, 5).reshape(Bsz, S, NSA_WIDTH).astype(q.dtype)


def peer_ffn(x, w_q, subkeys, u_tab, v_tab):
    Bsz, S, D = x.shape
    xt = x.reshape((Bsz * S) // PEER_CHUNK, PEER_CHUNK, D)
    half = PEER_KEY_DIM // 2

    def chunk(xc):
        q = (xc @ w_q).reshape(PEER_CHUNK, PEER_HEADS, 2, half)
        s = jnp.einsum('thcd,hckd->thck', q, subkeys).astype(jnp.float32)
        sv, si = lax.top_k(s, PEER_TOPK)
        cand = sv[..., 0, :, None] + sv[..., 1, None, :]
        cidx = si[..., 0, :, None] * PEER_NKEYS + si[..., 1, None, :]
        best, pos = lax.top_k(cand.reshape(PEER_CHUNK, PEER_HEADS, -1), PEER_TOPK)
        experts = jnp.take_along_axis(cidx.reshape(PEER_CHUNK, PEER_HEADS, -1), pos, axis=-1)
        g = jax.nn.softmax(best, axis=-1)
        u = u_tab[experts]
        v = v_tab[experts]
        h = jax.nn.gelu(jnp.einsum('thkd,td->thk', u, xc).astype(jnp.float32))
        return jnp.einsum('thk,thkd->td', (g * h).astype(v.dtype), v)

    return lax.map(chunk, xt).reshape(Bsz, S, D).astype(x.dtype)


def hybrid_layer(x, w_in, b_in, ssm_a_re, ssm_a_im, ssm_log_dt, ssm_b_re, ssm_b_im,
                 ssm_c_re, ssm_c_im, ssm_d, w_glu, w_up_ssm,
                 nsa_pe_k, nsa_w1_k, nsa_w2_k, nsa_pe_v, nsa_w1_v, nsa_w2_v, w_up_nsa,
                 w_out, ln1_g, ln1_b, peer_w_q, peer_subkeys, peer_u, peer_v, ln2_g, ln2_b):
    sizes = [SSM_WIDTH, NSA_WIDTH] + [KV_WIDTH] * 6 + [3 * NSA_HEADS, 2 * D_MODEL]
    offsets = np.cumsum(sizes)[:-1].tolist()
    proj = x @ w_in + b_in
    u_ssm, q, k_cmp, v_cmp, k_slc, v_slc, k_win, v_win, nsa_gates, merge_logits = jnp.split(proj, offsets, axis=-1)
    y_a = s5_mixer(u_ssm, ssm_a_re, ssm_a_im, ssm_log_dt, ssm_b_re, ssm_b_im,
                   ssm_c_re, ssm_c_im, ssm_d, w_glu) @ w_up_ssm
    y_b = nsa_mixer(q, k_cmp, v_cmp, k_slc, v_slc, k_win, v_win, nsa_gates,
                    nsa_pe_k, nsa_w1_k, nsa_w2_k, nsa_pe_v, nsa_w1_v, nsa_w2_v) @ w_up_nsa
    g_a, g_b = jnp.split(jax.nn.sigmoid(merge_logits), 2, axis=-1)
    mix = (g_a * y_a + g_b * y_b) @ w_out
    x = layer_norm(DN_ALPHA * x + mix, ln1_g, ln1_b)
    y = peer_ffn(x, peer_w_q, peer_subkeys, peer_u, peer_v)
    return layer_norm(DN_ALPHA * x + y, ln2_g, ln2_b)


def setup_inputs(seed: int = 0) -> dict:
    key = jax.random.key(seed)
    ks = jax.random.split(key, 32)
    f32 = jnp.float32

    def nrm(k, shape, scale):
        return jax.random.normal(k, shape, f32) * scale

    L = DEPTH
    P, G, H = SSM_STATE, SSM_GROUPS, SSM_GROUP
    ldk = CMP_BLOCK * NSA_HEAD_DIM
    return {
        "x": nrm(ks[0], (BATCH, SEQ, D_MODEL), 1.0),
        "w_in": nrm(ks[1], (L, D_MODEL, IN_COLS), D_MODEL ** -0.5),
        "b_in": nrm(ks[2], (L, IN_COLS), 0.02),
        "ssm_a_re": -0.5 + nrm(ks[3], (L, G, P), 0.01),
        "ssm_a_im": jnp.pi * jnp.arange(P, dtype=f32)[None, None, :] + nrm(ks[4], (L, G, P), 0.01),
        "ssm_log_dt": jax.random.uniform(ks[5], (L, G), f32, math.log(1e-3), math.log(1e-1)),
        "ssm_b_re": nrm(ks[6], (L, G, P, H), (2.0 * H) ** -0.5),
        "ssm_b_im": nrm(ks[7], (L, G, P, H), (2.0 * H) ** -0.5),
        "ssm_c_re": nrm(ks[8], (L, G, H, P), P ** -0.5),
        "ssm_c_im": nrm(ks[9], (L, G, H, P), P ** -0.5),
        "ssm_d": nrm(ks[10], (L, SSM_WIDTH), 1.0),
        "w_glu": nrm(ks[11], (L, SSM_WIDTH, 2 * SSM_WIDTH), SSM_WIDTH ** -0.5),
        "w_up_ssm": nrm(ks[12], (L, SSM_WIDTH, D_MODEL), SSM_WIDTH ** -0.5),
        "nsa_pe_k": nrm(ks[13], (L, CMP_BLOCK, NSA_HEAD_DIM), 0.1),
        "nsa_w1_k": nrm(ks[14], (L, ldk, CMP_HIDDEN), ldk ** -0.5),
        "nsa_w2_k": nrm(ks[15], (L, CMP_HIDDEN, NSA_HEAD_DIM), CMP_HIDDEN ** -0.5),
        "nsa_pe_v": nrm(ks[16], (L, CMP_BLOCK, NSA_HEAD_DIM), 0.1),
        "nsa_w1_v": nrm(ks[17], (L, ldk, CMP_HIDDEN), ldk ** -0.5),
        "nsa_w2_v": nrm(ks[18], (L, CMP_HIDDEN, NSA_HEAD_DIM), CMP_HIDDEN ** -0.5),
        "w_up_nsa": nrm(ks[19], (L, NSA_WIDTH, D_MODEL), NSA_WIDTH ** -0.5),
        "w_out": nrm(ks[20], (L, D_MODEL, D_MODEL), DN_BETA * D_MODEL ** -0.5),
        "ln1_g": 1.0 + nrm(ks[21], (L, D_MODEL), 0.05),
        "ln1_b": nrm(ks[22], (L, D_MODEL), 0.02),
        "peer_w_q": nrm(ks[23], (L, D_MODEL, PEER_HEADS * PEER_KEY_DIM), D_MODEL ** -0.5),
        "peer_subkeys": nrm(ks[24], (L, PEER_HEADS, 2, PEER_NKEYS, PEER_KEY_DIM // 2), (PEER_KEY_DIM // 2) ** -0.5),
        "peer_u": nrm(ks[25], (L, PEER_EXPERTS, D_MODEL), D_MODEL ** -0.5),
        "peer_v": nrm(ks[26], (L, PEER_EXPERTS, D_MODEL), DN_BETA),
        "ln2_g": 1.0 + nrm(ks[27], (L, D_MODEL), 0.05),
        "ln2_b": nrm(ks[28], (L, D_MODEL), 0.02),
    }


def reference(x, w_in, b_in, ssm_a_re, ssm_a_im, ssm_log_dt, ssm_b_re, ssm_b_im,
              ssm_c_re, ssm_c_im, ssm_d, w_glu, w_up_ssm,
              nsa_pe_k, nsa_w1_k, nsa_w2_k, nsa_pe_v, nsa_w1_v, nsa_w2_v, w_up_nsa,
              w_out, ln1_g, ln1_b, peer_w_q, peer_subkeys, peer_u, peer_v, ln2_g, ln2_b):
    for l in range(DEPTH):
        x = hybrid_layer(x, w_in[l], b_in[l], ssm_a_re[l], ssm_a_im[l], ssm_log_dt[l],
                         ssm_b_re[l], ssm_b_im[l], ssm_c_re[l], ssm_c_im[l], ssm_d[l],
                         w_glu[l], w_up_ssm[l],
                         nsa_pe_k[l], nsa_w1_k[l], nsa_w2_k[l], nsa_pe_v[l], nsa_w1_v[l], nsa_w2_v[l],
                         w_up_nsa[l], w_out[l], ln1_g[l], ln1_b[l],
                         peer_w_q[l], peer_subkeys[l], peer_u[l], peer_v[l], ln2_g[l], ln2_b[l])
    return x
```

```cpp
#define STOP_AFTER 99
#define DG_A -1
#define DG_B 0
#include <hip/hip_runtime.h>
#include <hip/hip_cooperative_groups.h>
#include <cstdio>
namespace cg = cooperative_groups;
#ifndef ABL_NOPEER
#define ABL_NOPEER 0
#endif
#ifndef ABL_NOMIX
#define ABL_NOMIX 0
#endif
#ifndef ABL_NOSSM
#define ABL_NOSSM 0
#endif
#ifndef ABL_NONSA
#define ABL_NONSA 0
#endif
#ifndef ABL_NOCMP
#define ABL_NOCMP 0
#endif
#ifndef ABL_NOSLC
#define ABL_NOSLC 0
#endif
#ifndef ABL_NOWIN
#define ABL_NOWIN 0
#endif
#ifndef ABL_NOH
#define ABL_NOH 0
#endif

#define LAS __attribute__((address_space(3)))
typedef unsigned short bf16_t;
typedef short bf16x8 __attribute__((ext_vector_type(8)));
typedef short s16x4 __attribute__((ext_vector_type(4)));
typedef float f32x4 __attribute__((ext_vector_type(4)));
typedef float f32x16 __attribute__((ext_vector_type(16)));
typedef unsigned u32x4 __attribute__((ext_vector_type(4)));
typedef unsigned u32x2 __attribute__((ext_vector_type(2)));
typedef _Float16 h16x2 __attribute__((ext_vector_type(2)));

constexpr int T_TOK = 16384, DM = 1024, SEQ = 4096, NBATCH = 4;
constexpr int INC = 3864, INCP = 4096;
constexpr float DN_ALPHA = 1.189207115002721f;
constexpr float LN_EPS = 1e-5f;
constexpr float LOG2E = 1.4426950408889634f;

constexpr size_t MiB = 1u << 20, KiB = 1u << 10;
constexpr size_t WS_CTL = 0;
constexpr size_t CTL_BYTES = 64 * KiB;
constexpr size_t WS_SUBK = 1 * MiB;
constexpr size_t WS_W2K = WS_SUBK + 256 * KiB;
constexpr size_t WS_W2V = WS_W2K + 16 * KiB;
constexpr size_t WS_B1K = WS_W2V + 16 * KiB;
constexpr size_t WS_B1V = WS_B1K + 1 * KiB;
constexpr size_t WS_LAML = WS_B1V + 1 * KiB;
constexpr size_t WS_W1K = 2 * MiB;
constexpr size_t WS_W1V = 2 * MiB + 512 * KiB;
constexpr size_t WS_KTAB = 3 * MiB;
constexpr size_t WS_ETAB = 5 * MiB;
constexpr size_t WS_FTAB = 13 * MiB;
constexpr size_t WS_WGLU = 21 * MiB;
constexpr size_t WS_WUPS = 22 * MiB;
constexpr size_t WS_WUPN = 23 * MiB;
constexpr size_t WS_WOUT = 24 * MiB;
constexpr size_t WS_WQ = 26 * MiB;
constexpr size_t WS_KC = 28 * MiB;
constexpr size_t WS_VC = WS_KC + 256 * KiB;
constexpr size_t WS_GATES = 29 * MiB;
constexpr size_t WS_UTAB = 32 * MiB;
constexpr size_t WS_VTAB = 64 * MiB;
constexpr size_t WS_XB = 96 * MiB;
constexpr size_t WS_Z = 96 * MiB;
constexpr size_t WS_O = 112 * MiB;
constexpr size_t WS_WIN = 128 * MiB;
constexpr size_t WS_UG = 136 * MiB;
constexpr size_t WS_MIXIN = 136 * MiB;
constexpr size_t WS_Q = 152 * MiB;
constexpr size_t WS_KV = 168 * MiB;
constexpr size_t WS_X1B = 168 * MiB;
constexpr size_t WS_YG = 192 * MiB;
constexpr size_t WS_M1 = 208 * MiB;
constexpr size_t WS_QP = 208 * MiB;
constexpr size_t WS_PK = 240 * MiB;
constexpr size_t WS_NEED = 256 * MiB;
constexpr int CW_Q2 = 64, CW_Q3 = 128, CW_Q3B = 192, CW_BAR = 4096;

constexpr int LDS_BYTES = 147456;

struct Params {
    const float* in[29];
    float* out;
    unsigned char* ws;
};

typedef __bf16 bf16v2 __attribute__((ext_vector_type(2)));
__device__ __forceinline__ unsigned cvt_pk_bf16(float lo, float hi) { bf16v2 v; v.x = (__bf16)lo; v.y = (__bf16)hi; return __builtin_bit_cast(unsigned, v); }
__device__ __forceinline__ float bf_lo(unsigned w) { return __uint_as_float(w << 16); }
__device__ __forceinline__ float bf_hi(unsigned w) { return __uint_as_float(w & 0xffff0000u); }
__device__ __forceinline__ float bf2f(bf16_t b) { return __uint_as_float(((unsigned)b) << 16); }
__device__ __forceinline__ bf16_t f2bf(float f) { return (bf16_t)(cvt_pk_bf16(f, 0.f) & 0xffffu); }
__device__ __forceinline__ float fast_exp2(float x) { return __builtin_amdgcn_exp2f(x); }
__device__ __forceinline__ float fast_rcp(float x) { return __builtin_amdgcn_rcpf(x); }
__device__ __forceinline__ float sigmoidf_(float x) { return fast_rcp(1.0f + fast_exp2(-x * LOG2E)); }
__device__ __forceinline__ float gelu_tanh(float x) { const float u = 1.5957691216057308f * x * (1.0f + 0.044715f * x * x); return x * fast_rcp(1.0f + fast_exp2(-u * LOG2E)); }
__device__ __forceinline__ float wave_sum(float v) {
#pragma unroll
    for (int o = 1; o < 64; o <<= 1) v += __shfl_xor(v, o);
    return v;
}
__device__ __forceinline__ unsigned pack_h2(float a, float b) { h16x2 h; h.x = (_Float16)a; h.y = (_Float16)b; return __builtin_bit_cast(unsigned, h); }

namespace pg8 {
constexpr int BM = 256, BK = 64, HALF = 128, HTB = HALF * BK * 2, STAGE_BYTES = 8 * HTB, NXCD = 8, WGM = 8;
__host__ __device__ __forceinline__ int lds_byte(int r, int c) { const int st = (r >> 4) * 2 + (c >> 5), rr = r & 15, cc = c & 31, ob = rr * 64 + cc * 2; return st * 1024 + (ob ^ (((ob >> 9) & 1) << 5)); }
__host__ __device__ __forceinline__ void stage_rc(int b, int& R, int& C) { const int st = b / 1024, sb = b % 1024, swz = sb ^ (((sb >> 9) & 1) << 5); R = (st >> 1) * 16 + swz / 64; C = (st & 1) * 32 + (swz % 64) / 2; }
__host__ __device__ __forceinline__ int perm32(int rho) { const int n = rho >> 4, i = rho & 15; return 8 * (i >> 2) + 4 * n + (i & 3); }
struct Unit { int pm, pn; };
struct Gemm { const bf16_t* A; const bf16_t* Bt; int M, N, K; };
struct StaticOrder {
    int nM, nN, nwg, G, c;
    __device__ void init(int M, int N, int G_, int c_) { nM = M / BM; nN = N / BM; nwg = nM * nN; G = G_; c = c_; }
    __device__ bool next(int i, Unit& u) const {
        const long L = (long)i * G + c; if (L >= nwg) return false;
        int wgid = (int)L; { const int q = nwg / NXCD, r = nwg % NXCD, xcd = wgid % NXCD, off = wgid / NXCD; wgid = (xcd < r ? xcd * (q + 1) : r * (q + 1) + (xcd - r) * q) + off; }
        const int nig = WGM * nN, gid = wgid / nig, fm = gid * WGM, gsz = (nM - fm) < WGM ? (nM - fm) : WGM;
        u.pm = fm + ((wgid % nig) % gsz); u.pn = (wgid % nig) / gsz; return true;
    }
};
template <class Epi>
__device__ __forceinline__ void gemm_phase(LAS unsigned char* lds, const Gemm g, const StaticOrder& S, const Epi& E) {
    const int tid = threadIdx.x, wid = __builtin_amdgcn_readfirstlane(tid >> 6), lane = tid & 63, wr = wid >> 2, wc = wid & 3, fr = lane & 15, fq = lane >> 4;
    const int K = g.K, nt = K / BK;
    unsigned voffA[2], voffB[2];
#pragma unroll
    for (int i = 0; i < 2; ++i) { int R, C; stage_rc(tid * 16 + i * 8192, R, C); const int Rb = (R & ~31) + perm32(R & 31);
        voffA[i] = (unsigned)(R * K + C) * 2u; voffB[i] = (unsigned)(Rb * K + C) * 2u; }
    const size_t kstep = (size_t)(BK * 2);
    const size_t hstep = (size_t)HALF * K * 2;
    const size_t tstep = 2 * hstep;
    const unsigned ldsw = (unsigned)wid * 1024u;
    const int aoff = lds_byte(wr * 64 + fr, fq * 8), boff = lds_byte(wc * 32 + fr, fq * 8);
#define PG8_SA(b, h) (((b) * 2 + (h)) * HTB)
#define PG8_SB(b, h) ((4 + (b) * 2 + (h)) * HTB)
#define PG8_STAGE(bufoff, gbase, voff) do { _Pragma("unroll") for (int _i = 0; _i < 2; ++_i) \
        __builtin_amdgcn_global_load_lds((const unsigned*)((const char*)(gbase) + (voff)[_i]), (LAS unsigned*)(lds + (bufoff) + ldsw + _i * 8192), 16, 0, 0); } while (0)
#define PG8_LDA(dst, b, h) do { _Pragma("unroll") for (int m = 0; m < 4; ++m) _Pragma("unroll") for (int k = 0; k < 2; ++k) dst[m][k] = *(const LAS bf16x8*)(lds + PG8_SA(b, h) + aoff + m * 2048 + k * 1024); } while (0)
#define PG8_LDB(dst, b, h) do { _Pragma("unroll") for (int n = 0; n < 2; ++n) _Pragma("unroll") for (int k = 0; k < 2; ++k) dst[n][k] = *(const LAS bf16x8*)(lds + PG8_SB(b, h) + boff + n * 2048 + k * 1024); } while (0)
#define PG8_MMA(ai, bj, At, Bt) do { __builtin_amdgcn_s_setprio(1); _Pragma("unroll") for (int m = 0; m < 4; ++m) _Pragma("unroll") for (int n = 0; n < 2; ++n) _Pragma("unroll") for (int k = 0; k < 2; ++k) \
        acc[ai][bj][m][n] = __builtin_amdgcn_mfma_f32_16x16x32_bf16(Bt[n][k], At[m][k], acc[ai][bj][m][n], 0, 0, 0); __builtin_amdgcn_s_setprio(0); } while (0)
#define PG8_WAIT_V(n) asm volatile("s_waitcnt vmcnt(" #n ")" ::: "memory")
#define PG8_WAIT_L(n) asm volatile("s_waitcnt lgkmcnt(" #n ")" ::: "memory")
#define PG8_BAR __builtin_amdgcn_s_barrier()
#define PG8_SCHED __builtin_amdgcn_sched_barrier(0)
    Unit cur, nxt; int ui = 0;
    if (!S.next(0, cur)) return;
    f32x4 acc[2][2][4][2];
#pragma unroll
    for (int a = 0; a < 2; ++a)
#pragma unroll
        for (int b = 0; b < 2; ++b)
#pragma unroll
            for (int m = 0; m < 4; ++m)
#pragma unroll
                for (int n = 0; n < 2; ++n) acc[a][b][m][n] = (f32x4){0.f, 0.f, 0.f, 0.f};
    bf16x8 At[4][2], B0[2][2], B1[2][2];
    const char* cA = (const char*)g.A + (size_t)cur.pm * tstep; const char* cB = (const char*)g.Bt + (size_t)cur.pn * tstep;
    PG8_STAGE(PG8_SB(0, 0), cB, voffB); PG8_STAGE(PG8_SA(0, 0), cA, voffA); PG8_STAGE(PG8_SB(0, 1), cB + hstep, voffB); PG8_STAGE(PG8_SA(0, 1), cA + hstep, voffA);
    if (wr == 1) PG8_BAR;
    PG8_WAIT_V(4); PG8_BAR;
    PG8_STAGE(PG8_SB(1, 0), cB + kstep, voffB); PG8_STAGE(PG8_SA(1, 0), cA + kstep, voffA); PG8_STAGE(PG8_SB(1, 1), cB + hstep + kstep, voffB);
    PG8_WAIT_V(6); PG8_BAR;
    for (;;) {
        const bool has_next = S.next(ui + 1, nxt);
        const char* nA = has_next ? (const char*)g.A + (size_t)nxt.pm * tstep : cA; const char* nB = has_next ? (const char*)g.Bt + (size_t)nxt.pn * tstep : cB;
        for (int t = 0; t < nt; t += 2) {
            const bool last = (t == nt - 2);
            const char* a1 = cA + (size_t)(t + 1) * kstep;
            const char* a2 = last ? nA : cA + (size_t)(t + 2) * kstep; const char* b2 = last ? nB : cB + (size_t)(t + 2) * kstep;
            const char* a3 = a2 + kstep; const char* b3 = b2 + kstep;
            PG8_LDB(B0, 0, 0); PG8_SCHED; PG8_LDA(At, 0, 0); PG8_STAGE(PG8_SA(1, 1), a1 + hstep, voffA);
            PG8_WAIT_L(8); PG8_BAR; PG8_WAIT_L(0); PG8_MMA(0, 0, At, B0); PG8_BAR; PG8_SCHED;
            PG8_LDB(B1, 0, 1); PG8_STAGE(PG8_SB(0, 0), b2, voffB);
            PG8_BAR; PG8_WAIT_L(0); PG8_MMA(0, 1, At, B1); PG8_BAR;
            PG8_LDA(At, 0, 1); PG8_STAGE(PG8_SA(0, 0), a2, voffA);
            PG8_BAR; PG8_WAIT_L(0); PG8_MMA(1, 0, At, B0); PG8_BAR; PG8_SCHED;
            PG8_STAGE(PG8_SB(0, 1), b2 + hstep, voffB);
            PG8_WAIT_V(6); PG8_BAR; PG8_MMA(1, 1, At, B1); PG8_BAR;
            PG8_LDB(B0, 1, 0); PG8_SCHED; PG8_LDA(At, 1, 0); PG8_STAGE(PG8_SA(0, 1), a2 + hstep, voffA);
            PG8_WAIT_L(8); PG8_BAR; PG8_WAIT_L(0); PG8_MMA(0, 0, At, B0); PG8_BAR; PG8_SCHED;
            PG8_LDB(B1, 1, 1); PG8_STAGE(PG8_SB(1, 0), b3, voffB);
            PG8_BAR; PG8_WAIT_L(0); PG8_MMA(0, 1, At, B1); PG8_BAR;
            PG8_LDA(At, 1, 1); PG8_STAGE(PG8_SA(1, 0), a3, voffA);
            PG8_BAR; PG8_WAIT_L(0); PG8_MMA(1, 0, At, B0); PG8_BAR; PG8_SCHED;
            PG8_STAGE(PG8_SB(1, 1), b3 + hstep, voffB);
            PG8_WAIT_V(6); PG8_BAR; PG8_MMA(1, 1, At, B1); PG8_BAR;
        }
        E(acc, cur, wr, wc, fr, fq);
        if (!has_next) break;
#pragma unroll
        for (int a = 0; a < 2; ++a)
#pragma unroll
            for (int b = 0; b < 2; ++b)
#pragma unroll
                for (int m = 0; m < 4; ++m)
#pragma unroll
                    for (int n = 0; n < 2; ++n) acc[a][b][m][n] = (f32x4){0.f, 0.f, 0.f, 0.f};
        cur = nxt; cA = nA; cB = nB; ++ui;
    }
    PG8_WAIT_V(0);
    if (wr == 0) PG8_BAR;
    PG8_BAR;
#undef PG8_SA
#undef PG8_SB
#undef PG8_STAGE
#undef PG8_LDA
#undef PG8_LDB
#undef PG8_MMA
#undef PG8_WAIT_V
#undef PG8_WAIT_L
#undef PG8_BAR
#undef PG8_SCHED
}
template <class F> struct Epi8 {
    F f;
    __device__ __forceinline__ void operator()(const f32x4 (&acc)[2][2][4][2], const Unit& u, int wr, int wc, int fr, int fq) const {
        const int row0 = u.pm * BM + wr * 64 + fr, col0 = u.pn * BM + wc * 32 + 8 * fq;
#pragma unroll
        for (int ai = 0; ai < 2; ++ai)
#pragma unroll
            for (int m = 0; m < 4; ++m) {
                const int row = row0 + ai * HALF + m * 16;
#pragma unroll
                for (int bj = 0; bj < 2; ++bj) f(row, col0 + bj * HALF, acc[ai][bj][m][0], acc[ai][bj][m][1]);
            }
    }
};
}

__device__ __forceinline__ u32x4 pack8(const f32x4& a, const f32x4& b) {
    u32x4 w; w.x = cvt_pk_bf16(a[0], a[1]); w.y = cvt_pk_bf16(a[2], a[3]); w.z = cvt_pk_bf16(b[0], b[1]); w.w = cvt_pk_bf16(b[2], b[3]); return w;
}

struct FInProj {
    const float* bias; bf16_t* UG; bf16_t* Q; bf16_t* KV; float* GATES; bf16_t* GM;
    __device__ __forceinline__ void operator()(int row, int col, f32x4 v0, f32x4 v1) const {
        if (col >= INC) return;
        const f32x4 b0 = *(const f32x4*)(bias + col), b1 = *(const f32x4*)(bias + col + 4);
        v0 += b0; v1 += b1;
        if (col < 512) {
            const int b = row >> 12, s = row & 4095, g = col >> 4, hp = col & 15;
            *(u32x4*)(UG + ((size_t)((b * 32 + g) * 4096 + s)) * 16 + hp) = pack8(v0, v1);
        } else if (col < 1024) {
            *(u32x4*)(Q + (size_t)row * 512 + (col - 512)) = pack8(v0 * (0.125f * LOG2E), v1 * (0.125f * LOG2E));
        } else if (col < 1792) {
            const int idx = (col - 1024) >> 7, cc = (col - 1024) & 127;
            *(u32x4*)(KV + ((size_t)idx * T_TOK + row) * 128 + cc) = pack8(v0, v1);
        } else if (col < 1816) {
            f32x4 s0, s1;
#pragma unroll
            for (int j = 0; j < 4; ++j) { s0[j] = sigmoidf_(v0[j]); s1[j] = sigmoidf_(v1[j]); }
            float* gp = GATES + (size_t)row * 24 + (col - 1792);
            *(f32x4*)gp = s0; *(f32x4*)(gp + 4) = s1;
        } else {
            f32x4 s0, s1;
#pragma unroll
            for (int j = 0; j < 4; ++j) { s0[j] = sigmoidf_(v0[j]); s1[j] = sigmoidf_(v1[j]); }
            *(u32x4*)(GM + (size_t)row * 2048 + (col - 1816)) = pack8(s0, s1);
        }
    }
};
struct EpiGLU {
    bf16_t* ZO;
    __device__ __forceinline__ void operator()(const f32x4 (&acc)[2][2][4][2], const pg8::Unit& u, int wr, int wc, int fr, int fq) const {
        const int row0 = u.pm * 256 + wr * 64 + fr, col0 = u.pn * 128 + wc * 32 + 8 * fq;
#pragma unroll
        for (int ai = 0; ai < 2; ++ai)
#pragma unroll
            for (int m = 0; m < 4; ++m) {
                const int row = row0 + ai * 128 + m * 16;
                f32x4 z0, z1;
#pragma unroll
                for (int j = 0; j < 4; ++j) { z0[j] = acc[ai][0][m][0][j] * sigmoidf_(acc[ai][1][m][0][j]); z1[j] = acc[ai][0][m][1][j] * sigmoidf_(acc[ai][1][m][1][j]); }
                *(u32x4*)(ZO + (size_t)row * 512 + col0) = pack8(z0, z1);
            }
    }
};
struct FUp1 {
    const bf16_t* GM; bf16_t* M1;
    __device__ __forceinline__ void operator()(int row, int col, f32x4 v0, f32x4 v1) const {
        const u32x4 g = *(const u32x4*)(GM + (size_t)row * 2048 + col);
        if (ABL_NOSSM) { v0 = (f32x4){0.f, 0.f, 0.f, 0.f}; v1 = v0; }
        v0[0] *= bf_lo(g.x); v0[1] *= bf_hi(g.x); v0[2] *= bf_lo(g.y); v0[3] *= bf_hi(g.y);
        v1[0] *= bf_lo(g.z); v1[1] *= bf_hi(g.z); v1[2] *= bf_lo(g.w); v1[3] *= bf_hi(g.w);
        *(u32x4*)(M1 + (size_t)row * 1024 + col) = pack8(v0, v1);
    }
};
struct FUp2 {
    const bf16_t* GM; const bf16_t* M1; bf16_t* MX;
    __device__ __forceinline__ void operator()(int row, int col, f32x4 v0, f32x4 v1) const {
        const u32x4 g = *(const u32x4*)(GM + (size_t)row * 2048 + 1024 + col);
        const u32x4 a = *(const u32x4*)(M1 + (size_t)row * 1024 + col);
        if (ABL_NONSA) { v0 = (f32x4){0.f, 0.f, 0.f, 0.f}; v1 = v0; }
        v0[0] = v0[0] * bf_lo(g.x) + bf_lo(a.x); v0[1] = v0[1] * bf_hi(g.x) + bf_hi(a.x); v0[2] = v0[2] * bf_lo(g.y) + bf_lo(a.y); v0[3] = v0[3] * bf_hi(g.y) + bf_hi(a.y);
        v1[0] = v1[0] * bf_lo(g.z) + bf_lo(a.z); v1[1] = v1[1] * bf_hi(g.z) + bf_hi(a.z); v1[2] = v1[2] * bf_lo(g.w) + bf_lo(a.w); v1[3] = v1[3] * bf_hi(g.w) + bf_hi(a.w);
        *(u32x4*)(MX + (size_t)row * 1024 + col) = pack8(v0, v1);
    }
};
struct FOut {
    const float* x; float* R;
    __device__ __forceinline__ void operator()(int row, int col, f32x4 v0, f32x4 v1) const {
        const f32x4 x0 = *(const f32x4*)(x + (size_t)row * 1024 + col), x1 = *(const f32x4*)(x + (size_t)row * 1024 + col + 4);
        if (ABL_NOMIX) { v0 = (f32x4){0.f, 0.f, 0.f, 0.f}; v1 = v0; }
        *(f32x4*)(R + (size_t)row * 1024 + col) = x0 * DN_ALPHA + v0;
        *(f32x4*)(R + (size_t)row * 1024 + col + 4) = x1 * DN_ALPHA + v1;
    }
};
struct FQP {
    bf16_t* QP;
    __device__ __forceinline__ void operator()(int row, int col, f32x4 v0, f32x4 v1) const { *(u32x4*)(QP + (size_t)row * 1024 + col) = pack8(v0, v1); }
};

struct cpx { float re, im; };
__device__ __forceinline__ cpx cmul(cpx a, cpx b) { return {a.re * b.re - a.im * b.im, a.re * b.im + a.im * b.re}; }
__device__ __forceinline__ cpx lam_pow(float are, float aim, float dt, float tau) {
    const float er = are * dt * tau, ei = aim * dt * tau; const float m = expf(er); float s, c; sincosf(ei, &s, &c); return {m * c, m * s};
}
__device__ __forceinline__ cpx bbar_coef(float are, float aim, float dt) {
    const float x = are * dt, y = aim * dt; const float ex1 = expm1f(x); float s, c; sincosf(y, &s, &c); const float sh = sinf(0.5f * y);
    const float nr = ex1 * c - 2.f * sh * sh, ni = (ex1 + 1.f) * s;
    const float den = are * are + aim * aim;
    return {(nr * are + ni * aim) / den, (ni * are - nr * aim) / den};
}
template <class CM>
__device__ __forceinline__ void transpose_w(const float* src, int K, int Ns, bf16_t* dst, int Nd, CM cm, int gtid, int NT) {
    const int kch = K / 8; const long total = (long)Nd * kch;
    for (long i = gtid; i < total; i += NT) {
        const int n = (int)(i % Nd), kc = (int)(i / Nd); const int sc = cm(n);
        float v[8];
#pragma unroll
        for (int j = 0; j < 8; ++j) v[j] = sc >= 0 ? src[(size_t)(kc * 8 + j) * Ns + sc] : 0.f;
        u32x4 w; w.x = cvt_pk_bf16(v[0], v[1]); w.y = cvt_pk_bf16(v[2], v[3]); w.z = cvt_pk_bf16(v[4], v[5]); w.w = cvt_pk_bf16(v[6], v[7]);
        *(u32x4*)(dst + (size_t)n * K + kc * 8) = w;
    }
}
__device__ __forceinline__ void p0_prologue(const Params& P) {
    const int gtid = blockIdx.x * 512 + threadIdx.x, NT = gridDim.x * 512;
    unsigned char* ws = P.ws;
    { const f32x4* x4 = (const f32x4*)P.in[0]; u32x4* o = (u32x4*)(ws + WS_XB);
      for (int i = gtid; i < T_TOK * DM / 8; i += NT) { const f32x4 a = x4[2 * i], b = x4[2 * i + 1]; o[i] = pack8(a, b); } }
    { const f32x4* u4 = (const f32x4*)P.in[25]; const f32x4* v4 = (const f32x4*)P.in[26]; u32x4* uo = (u32x4*)(ws + WS_UTAB); u32x4* vo = (u32x4*)(ws + WS_VTAB);
      for (int i = gtid; i < 16384 * 1024 / 8; i += NT) {
          const f32x4 a = u4[2 * i], b = u4[2 * i + 1]; u32x4 w; w.x = pack_h2(a[0], a[1]); w.y = pack_h2(a[2], a[3]); w.z = pack_h2(b[0], b[1]); w.w = pack_h2(b[2], b[3]); uo[i] = w;
          const f32x4 c = v4[2 * i], d = v4[2 * i + 1]; u32x4 z; z.x = pack_h2(c[0], c[1]); z.y = pack_h2(c[2], c[3]); z.z = pack_h2(d[0], d[1]); z.w = pack_h2(d[2], d[3]); vo[i] = z; } }
    transpose_w(P.in[1], 1024, INC, (bf16_t*)(ws + WS_WIN), INCP, [](int n) { return n < INC ? n : -1; }, gtid, NT);
    transpose_w(P.in[11], 512, 1024, (bf16_t*)(ws + WS_WGLU), 1024, [](int R) { const int pn = R >> 8, bj = (R >> 7) & 1, i = R & 127; return bj * 512 + pn * 128 + i; }, gtid, NT);
    transpose_w(P.in[12], 512, 1024, (bf16_t*)(ws + WS_WUPS), 1024, [](int n) { return n; }, gtid, NT);
    transpose_w(P.in[19], 512, 1024, (bf16_t*)(ws + WS_WUPN), 1024, [](int n) { return n; }, gtid, NT);
    transpose_w(P.in[20], 1024, 1024, (bf16_t*)(ws + WS_WOUT), 1024, [](int n) { return n; }, gtid, NT);
    transpose_w(P.in[23], 1024, 1024, (bf16_t*)(ws + WS_WQ), 1024, [](int n) { return n; }, gtid, NT);
    transpose_w(P.in[14], 2048, 128, (bf16_t*)(ws + WS_W1K), 128, [](int n) { return n; }, gtid, NT);
    transpose_w(P.in[17], 2048, 128, (bf16_t*)(ws + WS_W1V), 128, [](int n) { return n; }, gtid, NT);
    transpose_w(P.in[15], 128, 64, (bf16_t*)(ws + WS_W2K), 64, [](int n) { return n; }, gtid, NT);
    transpose_w(P.in[18], 128, 64, (bf16_t*)(ws + WS_W2V), 64, [](int n) { return n; }, gtid, NT);
    { const float* sk = P.in[24]; bf16_t* o = (bf16_t*)(ws + WS_SUBK); for (int i = gtid; i < 8 * 2 * 128 * 64; i += NT) o[i] = f2bf(sk[i]); }
    if (gtid < 256) { const int kv = gtid >> 7, n = gtid & 127; const float* pe = P.in[kv ? 16 : 13]; const float* w1 = P.in[kv ? 17 : 14]; float s = 0.f;
        for (int k = 0; k < 2048; ++k) s += pe[k] * w1[(size_t)k * 128 + n];
        ((float*)(ws + (kv ? WS_B1V : WS_B1K)))[n] = s; }
    const float* a_re = P.in[3]; const float* a_im = P.in[4]; const float* log_dt = P.in[5]; const float* b_re = P.in[6]; const float* b_im = P.in[7]; const float* c_re = P.in[8]; const float* c_im = P.in[9];
    if (gtid < 2048) { const int g = gtid >> 6; const float dt = expf(log_dt[g]); const cpx l = lam_pow(a_re[gtid], a_im[gtid], dt, 64.f); ((float*)(ws + WS_LAML))[2 * gtid] = l.re; ((float*)(ws + WS_LAML))[2 * gtid + 1] = l.im; }
    for (int i = gtid; i < 32 * 65 * 16; i += NT) {
        const int h = i & 15, li = (i >> 4) % 65, g = i / (65 * 16); const int lag = li - 1;
        float acc[16];
#pragma unroll
        for (int j = 0; j < 16; ++j) acc[j] = 0.f;
        if (lag >= 0) {
            const float dt = expf(log_dt[g]);
            for (int p = 0; p < 64; ++p) {
                const float are = a_re[g * 64 + p], aim = a_im[g * 64 + p];
                const cpx lp = lam_pow(are, aim, dt, (float)lag); const cpx cf = bbar_coef(are, aim, dt);
                const cpx C = {c_re[(g * 16 + h) * 64 + p], c_im[(g * 16 + h) * 64 + p]};
                const cpx cl = cmul(cmul(C, lp), cf);
#pragma unroll
                for (int j = 0; j < 16; ++j) { const float br = b_re[(g * 64 + p) * 16 + j], bi = b_im[(g * 64 + p) * 16 + j]; acc[j] += cl.re * br - cl.im * bi; }
            }
        }
        u32x4 w0, w1;
        w0.x = cvt_pk_bf16(acc[0], acc[1]); w0.y = cvt_pk_bf16(acc[2], acc[3]); w0.z = cvt_pk_bf16(acc[4], acc[5]); w0.w = cvt_pk_bf16(acc[6], acc[7]);
        w1.x = cvt_pk_bf16(acc[8], acc[9]); w1.y = cvt_pk_bf16(acc[10], acc[11]); w1.z = cvt_pk_bf16(acc[12], acc[13]); w1.w = cvt_pk_bf16(acc[14], acc[15]);
        u32x4* o = (u32x4*)((bf16_t*)(ws + WS_KTAB) + ((size_t)(g * 65 + li) * 16 + h) * 16); o[0] = w0; o[1] = w1;
    }
    for (int i = gtid; i < 32 * 64 * 64; i += NT) {
        const int s = i & 63, p = (i >> 6) & 63, g = i >> 12; const float dt = expf(log_dt[g]);
        const float are = a_re[g * 64 + p], aim = a_im[g * 64 + p];
        const cpx f = cmul(lam_pow(are, aim, dt, (float)(63 - s)), bbar_coef(are, aim, dt));
        float vr[16], vi[16];
#pragma unroll
        for (int j = 0; j < 16; ++j) { const float br = b_re[(g * 64 + p) * 16 + j], bi = b_im[(g * 64 + p) * 16 + j]; vr[j] = f.re * br - f.im * bi; vi[j] = f.re * bi + f.im * br; }
        bf16_t* er = (bf16_t*)(ws + WS_ETAB) + ((size_t)g * 128 + p) * 1024 + s * 16; bf16_t* ei = er + (size_t)64 * 1024;
        u32x4 w;
        w.x = cvt_pk_bf16(vr[0], vr[1]); w.y = cvt_pk_bf16(vr[2], vr[3]); w.z = cvt_pk_bf16(vr[4], vr[5]); w.w = cvt_pk_bf16(vr[6], vr[7]); ((u32x4*)er)[0] = w;
        w.x = cvt_pk_bf16(vr[8], vr[9]); w.y = cvt_pk_bf16(vr[10], vr[11]); w.z = cvt_pk_bf16(vr[12], vr[13]); w.w = cvt_pk_bf16(vr[14], vr[15]); ((u32x4*)er)[1] = w;
        w.x = cvt_pk_bf16(vi[0], vi[1]); w.y = cvt_pk_bf16(vi[2], vi[3]); w.z = cvt_pk_bf16(vi[4], vi[5]); w.w = cvt_pk_bf16(vi[6], vi[7]); ((u32x4*)ei)[0] = w;
        w.x = cvt_pk_bf16(vi[8], vi[9]); w.y = cvt_pk_bf16(vi[10], vi[11]); w.z = cvt_pk_bf16(vi[12], vi[13]); w.w = cvt_pk_bf16(vi[14], vi[15]); ((u32x4*)ei)[1] = w;
    }
    for (int i = gtid; i < 32 * 64 * 64; i += NT) {
        const int p = i & 63, t = (i >> 6) & 63, g = i >> 12; const float dt = expf(log_dt[g]);
        const cpx lp = lam_pow(a_re[g * 64 + p], a_im[g * 64 + p], dt, (float)(t + 1));
        bf16_t* f = (bf16_t*)(ws + WS_FTAB) + ((size_t)g * 1024 + t * 16) * 128 + p;
        for (int h = 0; h < 16; ++h) { const cpx C = {c_re[(g * 16 + h) * 64 + p], c_im[(g * 16 + h) * 64 + p]}; const cpx cl = cmul(C, lp); f[h * 128] = f2bf(cl.re); f[h * 128 + 64] = f2bf(-cl.im); }
    }
}

__device__ __forceinline__ void compress_item(const Params& P, LAS unsigned char* lds, int item) {
    unsigned char* ws = P.ws;
    const int tid = threadIdx.x, lane = tid & 63, w = __builtin_amdgcn_readfirstlane(tid >> 6), fr = lane & 15, q = lane >> 4;
    const int ct = item & 15, g = (item >> 4) & 1, b = (item >> 5) & 3, kv = item >> 7;
    const bf16_t* src = (const bf16_t*)(ws + WS_KV) + (size_t)(kv ? 1 : 0) * T_TOK * 128;
    const bf16_t* W1T = (const bf16_t*)(ws + (kv ? WS_W1V : WS_W1K));
    const bf16_t* W2T = (const bf16_t*)(ws + (kv ? WS_W2V : WS_W2K));
    const float* bias1 = (const float*)(ws + (kv ? WS_B1V : WS_B1K));
    bf16_t* dst = (bf16_t*)(ws + (kv ? WS_VC : WS_KC));
    const int c = ct * 16 + fr;
    f32x4 acc = {0.f, 0.f, 0.f, 0.f};
    const bf16_t* brow = W1T + (size_t)(16 * w + fr) * 2048 + 8 * q;
#pragma unroll 4
    for (int kk = 0; kk < 64; ++kk) {
        const int l = kk >> 1, d = (kk & 1) * 32 + 8 * q; int tok = 16 * c + l; tok = tok > 4095 ? 4095 : tok;
        const bf16x8 A = *(const bf16x8*)(src + ((size_t)(b * 4096 + tok)) * 128 + g * 64 + d);
        const bf16x8 B = *(const bf16x8*)(brow + kk * 32);
        acc = __builtin_amdgcn_mfma_f32_16x16x32_bf16(A, B, acc, 0, 0, 0);
    }
    LAS bf16_t* H1 = (LAS bf16_t*)lds;
    { const int col = 16 * w + fr; const float bb = bias1[col];
#pragma unroll
      for (int r = 0; r < 4; ++r) H1[(4 * q + r) * 136 + col] = f2bf(gelu_tanh(acc[r] + bb)); }
    __syncthreads();
    if (w < 4) {
        f32x4 a2 = {0.f, 0.f, 0.f, 0.f};
#pragma unroll
        for (int kk = 0; kk < 4; ++kk) {
            const bf16x8 A = *(const LAS bf16x8*)(H1 + fr * 136 + kk * 32 + 8 * q);
            const bf16x8 B = *(const bf16x8*)(W2T + (size_t)(16 * w + fr) * 128 + kk * 32 + 8 * q);
            a2 = __builtin_amdgcn_mfma_f32_16x16x32_bf16(A, B, a2, 0, 0, 0);
        }
#pragma unroll
        for (int r = 0; r < 4; ++r) dst[((size_t)((b * 2 + g) * 256 + ct * 16 + 4 * q + r)) * 64 + 16 * w + fr] = f2bf(a2[r]);
    }
    __syncthreads();
}

constexpr int S5_KT_OFF = 0;
constexpr int S5_UB_OFF = 33280;
constexpr int S5_XE_OFF = S5_UB_OFF + 33024;
constexpr int S5_XIN_OFF = S5_XE_OFF + 8192;
__device__ __forceinline__ void s5_item(const Params& P, LAS unsigned char* lds, int g, int b) {
    unsigned char* ws = P.ws;
    const int tid = threadIdx.x, lane = tid & 63, w = __builtin_amdgcn_readfirstlane(tid >> 6), fr = lane & 15, q = lane >> 4;
    const bf16_t* UGp = (const bf16_t*)(ws + WS_UG) + ((size_t)(b * 32 + g) * 4096) * 16;
    const bf16_t* ET = (const bf16_t*)(ws + WS_ETAB) + (size_t)g * 128 * 1024;
    const bf16_t* FT = (const bf16_t*)(ws + WS_FTAB) + (size_t)g * 1024 * 128;
    bf16_t* YG = (bf16_t*)(ws + WS_YG);
    const float* dsk = P.in[10];
    { const u32x4* src = (const u32x4*)((const bf16_t*)(ws + WS_KTAB) + (size_t)g * 65 * 256);
      for (int i = tid; i < 33280 / 16; i += 512) *(LAS u32x4*)(lds + S5_KT_OFF + i * 16) = src[i]; }
    float st_re = 0.f, st_im = 0.f, lr = 0.f, li = 0.f;
    if (tid < 64) { const float* ll = (const float*)(ws + WS_LAML) + (size_t)(g * 64 + tid) * 2; lr = ll[0]; li = ll[1]; }
    float dval[4];
#pragma unroll
    for (int r = 0; r < 4; ++r) dval[r] = dsk[g * 16 + 4 * q + r];
    LAS float* XE = (LAS float*)(lds + S5_XE_OFF);
    LAS bf16_t* XIN = (LAS bf16_t*)(lds + S5_XIN_OFF);
    for (int batch = 0; batch < 4; ++batch) {
        __syncthreads();
        { const u32x4* src = (const u32x4*)(UGp + (size_t)batch * 1024 * 16);
#pragma unroll
          for (int i = 0; i < 4; ++i) { const int pc = tid + i * 512; *(LAS u32x4*)(lds + S5_UB_OFF + (pc >> 7) * 2064 + (pc & 127) * 16) = src[pc]; } }
        __syncthreads();
        {
            f32x4 acc = {0.f, 0.f, 0.f, 0.f};
            const bf16_t* arow = ET + (size_t)(16 * w + fr) * 1024 + 8 * q;
            const LAS unsigned char* bb = lds + S5_UB_OFF + fr * 2064 + (q >> 1) * 32 + (q & 1) * 16;
#pragma unroll 4
            for (int kk = 0; kk < 32; ++kk) {
                const bf16x8 A = *(const bf16x8*)(arow + kk * 32);
                const bf16x8 B = *(const LAS bf16x8*)(bb + kk * 64);
                acc = __builtin_amdgcn_mfma_f32_16x16x32_bf16(A, B, acc, 0, 0, 0);
            }
#pragma unroll
            for (int r = 0; r < 4; ++r) XE[(16 * w + 4 * q + r) * 16 + fr] = acc[r];
        }
        __syncthreads();
        if (tid < 64) {
            for (int c = 0; c < 16; ++c) {
                XIN[c * 136 + tid] = f2bf(st_re); XIN[c * 136 + 64 + tid] = f2bf(st_im);
                const float xr = XE[tid * 16 + c], xi = XE[(64 + tid) * 16 + c];
                const float nr = lr * st_re - li * st_im + xr, ni = lr * st_im + li * st_re + xi;
                st_re = nr; st_im = ni;
            }
        }
        __syncthreads();
        for (int t = w; t < 64; t += 8) {
            f32x4 acc = {0.f, 0.f, 0.f, 0.f};
            const LAS unsigned char* bb = lds + S5_UB_OFF + fr * 2064 + (q >> 1) * 32 + (q & 1) * 16;
            const LAS unsigned char* ka = lds + S5_KT_OFF + ((t + 1 - (q >> 1)) * 256 + fr * 16 + (q & 1) * 8) * 2;
            const int nk = (t >> 1) + 1;
            for (int kk = 0; kk < nk; ++kk) {
                const bf16x8 A = *(const LAS bf16x8*)(ka - kk * 1024);
                const bf16x8 B = *(const LAS bf16x8*)(bb + kk * 64);
                acc = __builtin_amdgcn_mfma_f32_16x16x32_bf16(A, B, acc, 0, 0, 0);
            }
            const bf16_t* frow = FT + (size_t)(t * 16 + fr) * 128 + 8 * q;
#pragma unroll
            for (int kk = 0; kk < 4; ++kk) {
                const bf16x8 A = *(const bf16x8*)(frow + kk * 32);
                const bf16x8 B = *(const LAS bf16x8*)(XIN + fr * 136 + kk * 32 + 8 * q);
                acc = __builtin_amdgcn_mfma_f32_16x16x32_bf16(A, B, acc, 0, 0, 0);
            }
            const u32x2 uu = *(const LAS u32x2*)(lds + S5_UB_OFF + fr * 2064 + t * 32 + q * 8);
            float y0 = acc[0] + dval[0] * bf_lo(uu.x), y1 = acc[1] + dval[1] * bf_hi(uu.x), y2 = acc[2] + dval[2] * bf_lo(uu.y), y3 = acc[3] + dval[3] * bf_hi(uu.y);
            u32x2 o; o.x = cvt_pk_bf16(gelu_tanh(y0), gelu_tanh(y1)); o.y = cvt_pk_bf16(gelu_tanh(y2), gelu_tanh(y3));
            const int tok = batch * 1024 + fr * 64 + t;
            *(u32x2*)(YG + ((size_t)(b * 4096 + tok)) * 512 + g * 16 + 4 * q) = o;
        }
    }
    __syncthreads();
}

constexpr int AT_K_OFF = 0;
constexpr int AT_V_OFF = 9216;
constexpr int AT_IMP_OFF = 18432;
constexpr int AT_SEL_OFF = AT_IMP_OFF + 65536;
__device__ __forceinline__ void load_tile64(LAS unsigned char* buf, const bf16_t* src, size_t row0, int rowstride, int coloff, int tid) {
    const u32x4 v = *(const u32x4*)(src + (row0 + (tid >> 3)) * rowstride + coloff + (tid & 7) * 8);
    *(LAS u32x4*)(buf + (tid >> 3) * 144 + (tid & 7) * 16) = v;
}
__device__ __forceinline__ void qk_tile(const LAS unsigned char* kbuf, const bf16x8 (&bq)[4], int lane, f32x16 (&st)[2]) {
    const int r = lane & 31, hh = lane >> 5;
#pragma unroll
    for (int kt = 0; kt < 2; ++kt) {
        f32x16 a = {0.f, 0.f, 0.f, 0.f, 0.f, 0.f, 0.f, 0.f, 0.f, 0.f, 0.f, 0.f, 0.f, 0.f, 0.f, 0.f};
#pragma unroll
        for (int ks = 0; ks < 4; ++ks) {
            const bf16x8 kf = *(const LAS bf16x8*)(kbuf + (32 * kt + r) * 144 + (16 * ks + 8 * hh) * 2);
            a = __builtin_amdgcn_mfma_f32_32x32x16_bf16(kf, bq[ks], a, 0, 0, 0);
        }
        st[kt] = a;
    }
}
__device__ __forceinline__ void pv_tile(const LAS unsigned char* vbuf, const f32x16 (&p)[2], int lane, f32x16 (&o)[2]) {
    const int hh = lane >> 5, i = lane & 15, d0 = 16 * ((lane >> 4) & 1), qq = i >> 2, pp = i & 3;
#pragma unroll
    for (int kt = 0; kt < 2; ++kt)
#pragma unroll
        for (int s = 0; s < 2; ++s) {
            u32x4 pw; pw.x = cvt_pk_bf16(p[kt][8 * s + 0], p[kt][8 * s + 1]); pw.y = cvt_pk_bf16(p[kt][8 * s + 2], p[kt][8 * s + 3]);
            pw.z = cvt_pk_bf16(p[kt][8 * s + 4], p[kt][8 * s + 5]); pw.w = cvt_pk_bf16(p[kt][8 * s + 6], p[kt][8 * s + 7]);
            const bf16x8 pb = __builtin_bit_cast(bf16x8, pw);
            const int kb = 32 * kt + 16 * s + 4 * hh;
#pragma unroll
            for (int dt = 0; dt < 2; ++dt) {
                const LAS unsigned char* a0 = vbuf + (kb + qq) * 144 + (32 * dt + d0 + 4 * pp) * 2;
                const s16x4 v0 = __builtin_amdgcn_ds_read_tr16_b64_v4i16((LAS s16x4*)a0);
                const s16x4 v1 = __builtin_amdgcn_ds_read_tr16_b64_v4i16((LAS s16x4*)(a0 + 8 * 144));
                bf16x8 va; va[0] = v0[0]; va[1] = v0[1]; va[2] = v0[2]; va[3] = v0[3]; va[4] = v1[0]; va[5] = v1[1]; va[6] = v1[2]; va[7] = v1[3];
                o[dt] = __builtin_amdgcn_mfma_f32_32x32x16_bf16(va, pb, o[dt], 0, 0, 0);
            }
        }
}
template <bool WIN, int CM>
__device__ __forceinline__ float mask_scores(f32x16 (&st)[2], float fdl, float nslope2) {
    float mx = -3.0e38f;
#pragma unroll
    for (int kt = 0; kt < 2; ++kt)
#pragma unroll
        for (int reg = 0; reg < 16; ++reg) {
            const float distf = fdl - (float)(CM * (32 * kt + (reg & 3) + 8 * (reg >> 2)));
            float s2 = __builtin_fmaf(distf, nslope2, st[kt][reg]);
            if (WIN) { const float d = distf - __builtin_amdgcn_fmed3f(distf, 0.0f, 511.0f); s2 = __builtin_fmaf(-__builtin_fabsf(d), 3.0e38f, s2); }
            else s2 = __builtin_fmaf(__builtin_fminf(distf, 0.0f), 3.0e38f, s2);
            st[kt][reg] = s2; mx = fmaxf(mx, s2);
        }
    return fmaxf(mx, __shfl_xor(mx, 32));
}
template <bool WIN>
__device__ __forceinline__ void online_block(const LAS unsigned char* kbuf, const LAS unsigned char* vbuf, const bf16x8 (&bq)[4], int lane, float fdl, float nslope2,
                                             float& m, float& l, f32x16 (&o)[2]) {
    f32x16 st[2];
    qk_tile(kbuf, bq, lane, st);
    const float mx = mask_scores<WIN, 1>(st, fdl, nslope2);
    const float mn = fmaxf(m, mx), alpha = fast_exp2(m - mn); m = mn;
    float sum = 0.f;
#pragma unroll
    for (int kt = 0; kt < 2; ++kt)
#pragma unroll
        for (int reg = 0; reg < 16; ++reg) { const float pv = fast_exp2(st[kt][reg] - mn); st[kt][reg] = pv; sum += pv; }
    l = l * alpha + sum;
#pragma unroll
    for (int dt = 0; dt < 2; ++dt)
#pragma unroll
        for (int reg = 0; reg < 16; ++reg) o[dt][reg] *= alpha;
    pv_tile(vbuf, st, lane, o);
}
__device__ __forceinline__ void attn_item(const Params& P, LAS unsigned char* lds, int b, int g, int qt) {
    unsigned char* ws = P.ws;
    const int tid = threadIdx.x, lane = tid & 63, w = __builtin_amdgcn_readfirstlane(tid >> 6);
    const int r = w & 3, qhalf = w >> 2, hh = lane >> 5, ql = 32 * qhalf + (lane & 31);
    const int tq = 64 * qt + ql, hd = g * 4 + r;
    const size_t rowq = (size_t)b * 4096 + tq;
    const bf16_t* Qp = (const bf16_t*)(ws + WS_Q);
    const bf16_t* KVp = (const bf16_t*)(ws + WS_KV);
    const bf16_t* KC = (const bf16_t*)(ws + WS_KC) + (size_t)(b * 2 + g) * 256 * 64;
    const bf16_t* VC = (const bf16_t*)(ws + WS_VC) + (size_t)(b * 2 + g) * 256 * 64;
    const float* GT = (const float*)(ws + WS_GATES);
    LAS unsigned char* kbuf = lds + AT_K_OFF; LAS unsigned char* vbuf = lds + AT_V_OFF;
    LAS float* IMP = (LAS float*)(lds + AT_IMP_OFF);
    LAS unsigned long long* SEL = (LAS unsigned long long*)(lds + AT_SEL_OFF);
    bf16x8 bq[4];
#pragma unroll
    for (int ks = 0; ks < 4; ++ks) bq[ks] = *(const bf16x8*)(Qp + rowq * 512 + hd * 64 + 16 * ks + 8 * hh);
    const float nslope2 = -exp2f(-(float)(hd + 1)) * LOG2E;
    const float gc = ABL_NOCMP ? 0.f : GT[rowq * 24 + g * 12 + r * 3 + 0], gs = ABL_NOSLC ? 0.f : GT[rowq * 24 + g * 12 + r * 3 + 1], gw = ABL_NOWIN ? 0.f : GT[rowq * 24 + g * 12 + r * 3 + 2];
    f32x16 tot[2];
#pragma unroll
    for (int dt = 0; dt < 2; ++dt)
#pragma unroll
        for (int reg = 0; reg < 16; ++reg) tot[dt][reg] = 0.f;

    const int ncb = ((4 * qt + 2) >> 6) + 1;
    float m = -1e30f, l = 0.f;
    for (int cb = 0; cb < ncb; ++cb) {
        __syncthreads();
        load_tile64(kbuf, KC, (size_t)cb * 64, 64, 0, tid);
        __syncthreads();
        f32x16 st[2];
        qk_tile(kbuf, bq, lane, st);
        const int dl = tq - 31 - 1024 * cb - 64 * hh;
        const float mx = mask_scores<false, 16>(st, (float)dl, nslope2);
        const float mn = fmaxf(m, mx), alpha = fast_exp2(m - mn); m = mn;
        float sum = 0.f;
#pragma unroll
        for (int kt = 0; kt < 2; ++kt)
#pragma unroll
            for (int reg = 0; reg < 16; ++reg) sum += fast_exp2(st[kt][reg] - mn);
        l = l * alpha + sum;
    }
    {
        const float ltot = l + __shfl_xor(l, 32);
        const float inv = 1.0f / fmaxf(ltot, 1e-30f);
        f32x16 o[2];
#pragma unroll
        for (int dt = 0; dt < 2; ++dt)
#pragma unroll
            for (int reg = 0; reg < 16; ++reg) o[dt][reg] = 0.f;
        float carry = 0.f;
        for (int cb = 0; cb < 4; ++cb) {
            if (cb < ncb) {
                __syncthreads();
                load_tile64(kbuf, KC, (size_t)cb * 64, 64, 0, tid);
                load_tile64(vbuf, VC, (size_t)cb * 64, 64, 0, tid);
                __syncthreads();
                f32x16 st[2];
                qk_tile(kbuf, bq, lane, st);
                const int dl = tq - 31 - 1024 * cb - 64 * hh;
                (void)mask_scores<false, 16>(st, (float)dl, nslope2);
#pragma unroll
                for (int kt = 0; kt < 2; ++kt)
#pragma unroll
                    for (int reg = 0; reg < 16; ++reg) st[kt][reg] = fast_exp2(st[kt][reg] - m) * inv;
                float pv3[2][4];
#pragma unroll
                for (int kt = 0; kt < 2; ++kt)
#pragma unroll
                    for (int i = 0; i < 4; ++i) pv3[kt][i] = __shfl_xor(st[kt][4 * i + 3], 32);
#pragma unroll
                for (int kt = 0; kt < 2; ++kt)
#pragma unroll
                    for (int i = 0; i < 4; ++i) {
                        const float s4 = (st[kt][4 * i] + st[kt][4 * i + 1]) + (st[kt][4 * i + 2] + st[kt][4 * i + 3]);
                        const float prev0 = (i > 0) ? pv3[kt][i > 0 ? i - 1 : 0] : (kt > 0 ? pv3[0][3] : carry);
                        const float prev = hh ? pv3[kt][i] : prev0;
                        IMP[(r * 64 + ql) * 64 + 16 * cb + 8 * kt + 2 * i + hh] = s4 + prev;
                    }
                carry = pv3[1][3];
                pv_tile(vbuf, st, lane, o);
            } else {
#pragma unroll
                for (int kt = 0; kt < 2; ++kt)
#pragma unroll
                    for (int i = 0; i < 4; ++i) {
                        const float prev = (!hh && kt == 0 && i == 0) ? carry : 0.f;
                        IMP[(r * 64 + ql) * 64 + 16 * cb + 8 * kt + 2 * i + hh] = prev;
                    }
                carry = 0.f;
            }
        }
#pragma unroll
        for (int dt = 0; dt < 2; ++dt)
#pragma unroll
            for (int reg = 0; reg < 16; ++reg) tot[dt][reg] = gc * o[dt][reg];
    }
    __syncthreads();
    {
        const int cur = qt, j = lane;
        for (int qi = 0; qi < 8; ++qi) {
            const int qq = 8 * w + qi;
            const float sc = ((IMP[(0 * 64 + qq) * 64 + j] + IMP[(1 * 64 + qq) * 64 + j]) + IMP[(2 * 64 + qq) * 64 + j]) + IMP[(3 * 64 + qq) * 64 + j];
            const bool valid = j <= cur, forced = (j == 0) || (j == cur) || (j == cur - 1);
            const float key = forced ? 3.0e38f : (valid ? sc : -1.0f);
            int cnt = 0;
            for (int jp = 0; jp <= cur; ++jp) {
                const float sj = __uint_as_float(__builtin_amdgcn_readlane(__float_as_uint(key), jp));
                cnt += ((sj > key) || (sj == key && jp < j)) ? 1 : 0;
            }
            const unsigned long long msk = __ballot(valid && cnt < 16);
            if (lane == 0) SEL[qq] = msk;
        }
    }
    __syncthreads();
    const unsigned long long mymask = SEL[ql];
    unsigned long long uni = SEL[lane];
#pragma unroll
    for (int o_ = 1; o_ < 64; o_ <<= 1) uni |= __shfl_xor(uni, o_);
    const unsigned uni_lo = __builtin_amdgcn_readfirstlane((unsigned)uni), uni_hi = __builtin_amdgcn_readfirstlane((unsigned)(uni >> 32));
    {
        float ms = -1e30f, ls = 0.f; f32x16 o[2];
#pragma unroll
        for (int dt = 0; dt < 2; ++dt)
#pragma unroll
            for (int reg = 0; reg < 16; ++reg) o[dt][reg] = 0.f;
        const bf16_t* Ks = KVp + (size_t)2 * T_TOK * 128; const bf16_t* Vs = KVp + (size_t)3 * T_TOK * 128;
        for (int j = 0; j <= qt; ++j) {
            const unsigned bit = j < 32 ? (uni_lo >> j) & 1u : (uni_hi >> (j - 32)) & 1u;
            if (!bit) continue;
            __syncthreads();
            load_tile64(kbuf, Ks, (size_t)b * 4096 + 64 * j, 128, g * 64, tid);
            load_tile64(vbuf, Vs, (size_t)b * 4096 + 64 * j, 128, g * 64, tid);
            __syncthreads();
            const bool ok = (mymask >> j) & 1ull;
            online_block<false>(kbuf, vbuf, bq, lane, ok ? (float)(tq - 64 * j - 4 * hh) : -1.0e6f, nslope2, ms, ls, o);
        }
        const float ltot = ls + __shfl_xor(ls, 32); const float sc = gs / fmaxf(ltot, 1e-30f);
#pragma unroll
        for (int dt = 0; dt < 2; ++dt)
#pragma unroll
            for (int reg = 0; reg < 16; ++reg) tot[dt][reg] += sc * o[dt][reg];
    }
    {
        float mw = -1e30f, lw = 0.f; f32x16 o[2];
#pragma unroll
        for (int dt = 0; dt < 2; ++dt)
#pragma unroll
            for (int reg = 0; reg < 16; ++reg) o[dt][reg] = 0.f;
        const bf16_t* Kw = KVp + (size_t)4 * T_TOK * 128; const bf16_t* Vw = KVp + (size_t)5 * T_TOK * 128;
        const int j0 = qt - 8 > 0 ? qt - 8 : 0;
        for (int j = j0; j <= qt; ++j) {
            __syncthreads();
            load_tile64(kbuf, Kw, (size_t)b * 4096 + 64 * j, 128, g * 64, tid);
            load_tile64(vbuf, Vw, (size_t)b * 4096 + 64 * j, 128, g * 64, tid);
            __syncthreads();
            online_block<true>(kbuf, vbuf, bq, lane, (float)(tq - 64 * j - 4 * hh), nslope2, mw, lw, o);
        }
        const float ltot = lw + __shfl_xor(lw, 32); const float sc = gw / fmaxf(ltot, 1e-30f);
#pragma unroll
        for (int dt = 0; dt < 2; ++dt)
#pragma unroll
            for (int reg = 0; reg < 16; ++reg) tot[dt][reg] += sc * o[dt][reg];
    }
    {
        bf16_t* O = (bf16_t*)(ws + WS_O) + rowq * 512 + hd * 64;
#pragma unroll
        for (int dt = 0; dt < 2; ++dt)
#pragma unroll
            for (int rg = 0; rg < 4; ++rg) {
                u32x2 v; v.x = cvt_pk_bf16(tot[dt][4 * rg], tot[dt][4 * rg + 1]); v.y = cvt_pk_bf16(tot[dt][4 * rg + 2], tot[dt][4 * rg + 3]);
                *(u32x2*)(O + 32 * dt + 8 * rg + 4 * hh) = v;
            }
    }
    __syncthreads();
}

__device__ __forceinline__ unsigned f2ord(float f) { const unsigned u = __float_as_uint(f); return u ^ ((unsigned)((int)u >> 31) | 0x80000000u); }
__device__ __forceinline__ float ord2f(unsigned o) { const unsigned u = (o & 0x80000000u) ? (o ^ 0x80000000u) : ~o; return __uint_as_float(u); }
__device__ __forceinline__ void ins16(unsigned (&L)[16], unsigned x) {
#pragma unroll
    for (int i = 0; i < 16; ++i) { const unsigned hi = L[i] > x ? L[i] : x; x = L[i] > x ? x : L[i]; L[i] = hi; }
}
__device__ __forceinline__ void peer_score_item(const Params& P, LAS unsigned char* lds, int item, int w, int lane) {
    unsigned char* ws = P.ws;
    const int t0 = (item >> 3) * 32, h = item & 7, r = lane & 31, hh = lane >> 5;
    const bf16_t* QP = (const bf16_t*)(ws + WS_QP);
    const bf16_t* SK = (const bf16_t*)(ws + WS_SUBK);
    LAS unsigned char* IDX = lds + w * 1024;
    unsigned Lc[2][16];
#pragma unroll
    for (int c = 0; c < 2; ++c) {
        bf16x8 bq[4];
#pragma unroll
        for (int ks = 0; ks < 4; ++ks) bq[ks] = *(const bf16x8*)(QP + (size_t)(t0 + r) * 1024 + h * 128 + c * 64 + 16 * ks + 8 * hh);
        unsigned L[16];
#pragma unroll
        for (int i = 0; i < 16; ++i) L[i] = 0u;
#pragma unroll
        for (int kt = 0; kt < 4; ++kt) {
            f32x16 a = {0.f, 0.f, 0.f, 0.f, 0.f, 0.f, 0.f, 0.f, 0.f, 0.f, 0.f, 0.f, 0.f, 0.f, 0.f, 0.f};
#pragma unroll
            for (int ks = 0; ks < 4; ++ks) {
                const bf16x8 kf = *(const bf16x8*)(SK + ((size_t)((h * 2 + c) * 128 + 32 * kt + r)) * 64 + 16 * ks + 8 * hh);
                a = __builtin_amdgcn_mfma_f32_32x32x16_bf16(kf, bq[ks], a, 0, 0, 0);
            }
#pragma unroll
            for (int reg = 0; reg < 16; ++reg) {
                const int key0 = 32 * kt + 8 * (reg >> 2) + (reg & 3);
                const unsigned low = (unsigned)(127 ^ key0) ^ (unsigned)(4 * hh);
                ins16(L, (f2ord(a[reg]) & ~127u) | low);
            }
        }
        unsigned tmp[16];
#pragma unroll
        for (int i = 0; i < 16; ++i) tmp[i] = __shfl_xor(L[i], 32);
#pragma unroll
        for (int i = 0; i < 16; ++i) ins16(L, tmp[i]);
#pragma unroll
        for (int i = 0; i < 16; ++i) Lc[c][i] = L[i];
        if (hh == 0) {
#pragma unroll
            for (int i = 0; i < 16; ++i) IDX[(r * 2 + c) * 16 + i] = (unsigned char)(127u - (L[i] & 127u));
        }
    }
    unsigned best[16];
#pragma unroll
    for (int i = 0; i < 16; ++i) best[i] = 0u;
#pragma unroll
    for (int i = 0; i < 16; ++i) {
        const float v0 = ord2f(Lc[0][i] & ~127u);
#pragma unroll
        for (int j = 0; j < 16; ++j) {
            if ((i + 1) * (j + 1) <= 16) {
                const float s = v0 + ord2f(Lc[1][j] & ~127u);
                ins16(best, (f2ord(s) & ~255u) | (unsigned)(255 - (i * 16 + j)));
            }
        }
    }
    const float mv = ord2f(best[0] & ~255u);
    float e[16], sum = 0.f;
#pragma unroll
    for (int k = 0; k < 16; ++k) { e[k] = fast_exp2((ord2f(best[k] & ~255u) - mv) * LOG2E); sum += e[k]; }
    const float inv = 1.0f / sum;
    asm volatile("s_waitcnt lgkmcnt(0)" ::: "memory");
    if (hh == 0) {
        u32x2* out = (u32x2*)(ws + WS_PK) + ((size_t)(t0 + r) * 8 + h) * 16;
#pragma unroll
        for (int k = 0; k < 16; ++k) {
            const unsigned flat = 255u - (best[k] & 255u); const unsigned i = flat >> 4, j = flat & 15u;
            const unsigned e0 = IDX[(r * 2 + 0) * 16 + i], e1 = IDX[(r * 2 + 1) * 16 + j];
            u32x2 v; v.x = e0 * 128u + e1; v.y = __float_as_uint(e[k] * inv); out[k] = v;
        }
    }
}

__device__ __forceinline__ void peer_token(const Params& P, int tok, int lane) {
    unsigned char* ws = P.ws;
    float* X1 = P.out + (size_t)tok * 1024 + lane * 16;
    const f32x4 xa = ((const f32x4*)X1)[0], xb = ((const f32x4*)X1)[1], xc = ((const f32x4*)X1)[2], xd = ((const f32x4*)X1)[3];
    float xr[16] = {xa[0], xa[1], xa[2], xa[3], xb[0], xb[1], xb[2], xb[3], xc[0], xc[1], xc[2], xc[3], xd[0], xd[1], xd[2], xd[3]};
    h16x2 xh[8];
#pragma unroll
    for (int i = 0; i < 8; ++i) { xh[i].x = (_Float16)xr[2 * i]; xh[i].y = (_Float16)xr[2 * i + 1]; }
    const u32x2* pk = (const u32x2*)(ws + WS_PK) + (size_t)tok * 128;
    const u32x2 p0 = pk[lane], p1 = pk[64 + lane];
    const unsigned char* UT = ws + WS_UTAB + lane * 32; const unsigned char* VT = ws + WS_VTAB + lane * 32;
    float h0 = 0.f, h1 = 0.f;
    for (int k = 0; k < 128; k += 2) {
        const unsigned ea = __builtin_amdgcn_readlane(k < 64 ? p0.x : p1.x, k & 63), eb = __builtin_amdgcn_readlane(k < 64 ? p0.x : p1.x, (k + 1) & 63);
        const u32x4 a0 = *(const u32x4*)(UT + (size_t)ea * 2048), a1 = *(const u32x4*)(UT + (size_t)ea * 2048 + 16);
        const u32x4 b0 = *(const u32x4*)(UT + (size_t)eb * 2048), b1 = *(const u32x4*)(UT + (size_t)eb * 2048 + 16);
        float da = 0.f, db = 0.f;
        {
            const unsigned aw[8] = {a0.x, a0.y, a0.z, a0.w, a1.x, a1.y, a1.z, a1.w}, bw[8] = {b0.x, b0.y, b0.z, b0.w, b1.x, b1.y, b1.z, b1.w};
#pragma unroll
            for (int i = 0; i < 8; ++i) {
                const h16x2 va = __builtin_bit_cast(h16x2, aw[i]), vb = __builtin_bit_cast(h16x2, bw[i]);
                da = __builtin_fmaf((float)va.x, xr[2 * i], da); da = __builtin_fmaf((float)va.y, xr[2 * i + 1], da);
                db = __builtin_fmaf((float)vb.x, xr[2 * i], db); db = __builtin_fmaf((float)vb.y, xr[2 * i + 1], db);
            }
        }
        da = wave_sum(da); db = wave_sum(db);
        if (k < 64) { h0 = (lane == k) ? da : h0; h0 = (lane == k + 1) ? db : h0; } else { h1 = (lane == k - 64) ? da : h1; h1 = (lane == k - 63) ? db : h1; }
    }
        const float w0 = __uint_as_float(p0.y) * (ABL_NOH ? 1.f : gelu_tanh(h0)), w1 = __uint_as_float(p1.y) * (ABL_NOH ? 1.f : gelu_tanh(h1));
    float acc[16];
#pragma unroll
    for (int i = 0; i < 16; ++i) acc[i] = 0.f;
    for (int k = 0; k < 128; k += 2) {
        const unsigned ea = __builtin_amdgcn_readlane(k < 64 ? p0.x : p1.x, k & 63), eb = __builtin_amdgcn_readlane(k < 64 ? p0.x : p1.x, (k + 1) & 63);
        const float wa = __uint_as_float(__builtin_amdgcn_readlane(__float_as_uint(k < 64 ? w0 : w1), k & 63)), wb = __uint_as_float(__builtin_amdgcn_readlane(__float_as_uint(k < 64 ? w0 : w1), (k + 1) & 63));
        const u32x4 a0 = *(const u32x4*)(VT + (size_t)ea * 2048), a1 = *(const u32x4*)(VT + (size_t)ea * 2048 + 16);
        const u32x4 b0 = *(const u32x4*)(VT + (size_t)eb * 2048), b1 = *(const u32x4*)(VT + (size_t)eb * 2048 + 16);
        const unsigned aw[8] = {a0.x, a0.y, a0.z, a0.w, a1.x, a1.y, a1.z, a1.w}, bw[8] = {b0.x, b0.y, b0.z, b0.w, b1.x, b1.y, b1.z, b1.w};
#pragma unroll
        for (int i = 0; i < 8; ++i) {
            const h16x2 va = __builtin_bit_cast(h16x2, aw[i]), vb = __builtin_bit_cast(h16x2, bw[i]);
            acc[2 * i] = __builtin_fmaf((float)va.x, wa, acc[2 * i]); acc[2 * i + 1] = __builtin_fmaf((float)va.y, wa, acc[2 * i + 1]);
            acc[2 * i] = __builtin_fmaf((float)vb.x, wb, acc[2 * i]); acc[2 * i + 1] = __builtin_fmaf((float)vb.y, wb, acc[2 * i + 1]);
        }
    }
    float s = 0.f;
#pragma unroll
    for (int i = 0; i < 16; ++i) { acc[i] = DN_ALPHA * xr[i] + (ABL_NOPEER ? 0.f : acc[i]); s += acc[i]; }
    const float mean = wave_sum(s) * (1.0f / 1024.0f); float s2 = 0.f;
#pragma unroll
    for (int i = 0; i < 16; ++i) { acc[i] -= mean; s2 += acc[i] * acc[i]; }
    const float rstd = 1.0f / sqrtf(wave_sum(s2) * (1.0f / 1024.0f) + LN_EPS);
    const float* g2 = P.in[27] + lane * 16; const float* b2 = P.in[28] + lane * 16;
#pragma unroll
    for (int i = 0; i < 4; ++i) {
        const f32x4 gg = ((const f32x4*)g2)[i], bb = ((const f32x4*)b2)[i]; f32x4 o;
#pragma unroll
        for (int j = 0; j < 4; ++j) o[j] = acc[4 * i + j] * rstd * gg[j] + bb[j];
        ((f32x4*)X1)[i] = o;
    }
}


#define XB_TMO      128
#define XB_XCNT(j)  (256  + 64 * (j))
#define XB_XSUB(j)  (1280 + 64 * (j))
#define XB_XGEN(j)  (2304 + 64 * (j))
#define XB_TOP      3328
#define XB_TOPGEN   3392
#define XCD_BAR_WORDS 3456
#define XB_SPIN_CAP (1u << 24)
__device__ __forceinline__ unsigned xb_ld(unsigned* p)              { return __hip_atomic_load(p, __ATOMIC_RELAXED, __HIP_MEMORY_SCOPE_AGENT); }
__device__ __forceinline__ unsigned xb_add(unsigned* p, unsigned v) { return __hip_atomic_fetch_add(p, v, __ATOMIC_RELAXED, __HIP_MEMORY_SCOPE_AGENT); }
__device__ __forceinline__ unsigned xb_xcc_id() { return (unsigned)__builtin_amdgcn_s_getreg((3 << 11) | 20) & 0xFu; }
#define XB_SPIN(cond, bar) do { unsigned _sp = 0; while (cond) { __builtin_amdgcn_s_sleep(1); \
    if ((++_sp & 255u) == 0u) { if (xb_ld(&(bar)[XB_TMO])) break; if (_sp > XB_SPIN_CAP) { atomicAdd(&(bar)[XB_TMO], 1u); break; } } } } while (0)
struct XcdBarrier { unsigned* bar; unsigned x; volatile LAS unsigned* st; };
__device__ __forceinline__ XcdBarrier xcd_barrier_post(unsigned* bar, volatile LAS unsigned* st) {
    XcdBarrier b; b.bar = bar; b.x = xb_xcc_id(); b.st = st;
    if (threadIdx.x == 0) (void)xb_add(&bar[XB_XCNT(b.x)], 1u);
    return b;
}
__device__ __forceinline__ void xcd_barrier_complete(unsigned* bar, unsigned x, unsigned& nloc, unsigned& nx) {
    const unsigned G = gridDim.x * gridDim.y * gridDim.z;
    unsigned sum, cnt, mine, sp = 0u;
    for (;;) {
        sum = 0u; cnt = 0u; mine = 0u;
#pragma unroll
        for (unsigned j = 0; j < 16; ++j) { const unsigned c = xb_ld(&bar[XB_XCNT(j)]); sum += c; cnt += (c > 0u) ? 1u : 0u; mine = (j == x) ? c : mine; }
        if (sum == G) break;
        __builtin_amdgcn_s_sleep(1);
        if ((++sp & 255u) == 0u) { if (xb_ld(&bar[XB_TMO])) break; if (sp > XB_SPIN_CAP) { atomicAdd(&bar[XB_TMO], 1u); break; } }
    }
    nloc = mine > 0u ? mine : 1u; nx = cnt > 0u ? cnt : 1u;
}
__device__ __forceinline__ void xcd_barrier(const XcdBarrier& b) {
    asm volatile("s_waitcnt vmcnt(0)" ::: "memory");
    __syncthreads();
    if (threadIdx.x == 0) {
        unsigned* bar = b.bar;
        __builtin_amdgcn_s_waitcnt(0);
        unsigned nloc = b.st[0], nx = b.st[1];
        if (nloc == 0u) { xcd_barrier_complete(bar, b.x, nloc, nx); b.st[0] = nloc; b.st[1] = nx; }
        const unsigned old = xb_add(&bar[XB_XSUB(b.x)], 1u);
        const unsigned gen = old / nloc;
        if (old + 1u == (gen + 1u) * nloc) {
            __builtin_amdgcn_fence(__ATOMIC_RELEASE, "agent");
            asm volatile("s_waitcnt vmcnt(0)" ::: "memory");
            const unsigned og = xb_add(&bar[XB_TOP], 1u);
            const unsigned tg = og / nx;
            if (og + 1u == (tg + 1u) * nx) xb_add(&bar[XB_TOPGEN], 1u);
            else XB_SPIN(xb_ld(&bar[XB_TOPGEN]) == tg, bar);
            __builtin_amdgcn_fence(__ATOMIC_ACQUIRE, "agent");
            xb_add(&bar[XB_XGEN(b.x)], 1u);
            asm volatile("s_waitcnt vmcnt(0)" ::: "memory");
        } else {
            XB_SPIN(xb_ld(&bar[XB_XGEN(b.x)]) == gen, bar);
            __builtin_amdgcn_fence(__ATOMIC_ACQUIRE, "agent");
            asm volatile("s_waitcnt vmcnt(0)" ::: "memory");
        }
    }
    __syncthreads();
}

__device__ __forceinline__ int next_item(unsigned* ctr, LAS int* slot) {
    __syncthreads();
    if (threadIdx.x == 0) *slot = (int)atomicAdd(ctr, 1u);
    __syncthreads();
    return __builtin_amdgcn_readfirstlane(*slot);
}


#ifdef CHECK_PEER
__device__ __forceinline__ void check_peer(const Params& P, LAS unsigned char* lds, unsigned* ctl) {
    unsigned char* ws = P.ws;
    const int tid = threadIdx.x;
    const bf16_t* QP = (const bf16_t*)(ws + WS_QP); const bf16_t* SK = (const bf16_t*)(ws + WS_SUBK);
    const u32x2* PK = (const u32x2*)(ws + WS_PK);
    unsigned bad_e = 0, bad_g = 0;
    if (tid < 64) {
        LAS float* sc = (LAS float*)lds + tid * 257;
        LAS float* sv = (LAS float*)(lds + 64 * 257 * 4) + tid * 33;
        LAS int* si = (LAS int*)(lds + 64 * 257 * 4 + 64 * 33 * 4) + tid * 33;
        for (int pair = blockIdx.x * 64 + tid; pair < T_TOK * 8; pair += gridDim.x * 64) {
            const int t = pair >> 3, h = pair & 7;
            for (int c = 0; c < 2; ++c)
                for (int k = 0; k < 128; ++k) {
                    float a = 0.f;
                    for (int d = 0; d < 64; ++d) a += bf2f(QP[(size_t)t * 1024 + h * 128 + c * 64 + d]) * bf2f(SK[((size_t)((h * 2 + c) * 128 + k)) * 64 + d]);
                    sc[c * 128 + k] = a;
                }
            for (int c = 0; c < 2; ++c) {
                float pv = 3.0e38f; int pi = -1;
                for (int r = 0; r < 16; ++r) {
                    float bv = -3.0e38f; int bi = -1;
                    for (int k = 0; k < 128; ++k) { const float v = sc[c * 128 + k]; const bool after = (v < pv) || (v == pv && k > pi); if (after && (v > bv)) { bv = v; bi = k; } }
                    sv[c * 16 + r] = bv; si[c * 16 + r] = bi; pv = bv; pi = bi;
                }
            }
            float pv = 3.0e38f; int pi = -1; float best[16]; int bexp[16];
            float mv = 0.f, sum = 0.f;
            for (int r = 0; r < 16; ++r) {
                float bv = -3.0e38f; int bi = -1;
                for (int f = 0; f < 256; ++f) { const float v = sv[f >> 4] + sv[16 + (f & 15)]; const bool after = (v < pv) || (v == pv && f > pi); if (after && (v > bv)) { bv = v; bi = f; } }
                pv = bv; pi = bi;
                const int e = si[bi >> 4] * 128 + si[16 + (bi & 15)];
                if (r == 0) mv = bv;
                const float ev = expf(bv - mv); sum += ev;
                bool found = false; float gpk = 0.f;
                for (int k = 0; k < 16; ++k) { const u32x2 q = PK[(size_t)pair * 16 + k]; if ((int)q.x == e) { found = true; gpk = __uint_as_float(q.y); } }
                if (!found) ++bad_e;
                sc[r] = ev; sc[16 + r] = found ? gpk : -1.f;
            }
            for (int r = 0; r < 16; ++r) { const float gref = sc[r] / sum, gpk = sc[16 + r]; if (gpk >= 0.f && fabsf(gref - gpk) > 0.02f) ++bad_g; }
        }
    }
    if (bad_e) atomicAdd(ctl + 300, bad_e);
    if (bad_g) atomicAdd(ctl + 301, bad_g);
}
#endif

#ifdef CHECK_PROJ
__device__ __forceinline__ void check_proj(const Params& P, unsigned* ctl) {
    unsigned char* ws = P.ws;
    const float* x = P.in[0]; const float* w = P.in[1]; const float* bi = P.in[2];
    const int gtid = blockIdx.x * 512 + threadIdx.x, NT = gridDim.x * 512;
    unsigned bad[5] = {0, 0, 0, 0, 0};
    const int nrows = 128;
    for (int i = gtid; i < nrows * INC; i += NT) {
        const int col = i % INC, row = (i / INC) * 127 + 5;
        float a = bi[col];
        for (int k = 0; k < 1024; ++k) a += x[(size_t)row * 1024 + k] * w[(size_t)k * INC + col];
        float got, ref; int cat;
        if (col < 512) { const int b = row >> 12, sq = row & 4095, g = col >> 4, hp = col & 15; got = bf2f(((const bf16_t*)(ws + WS_UG))[((size_t)((b * 32 + g) * 4096 + sq)) * 16 + hp]); ref = a; cat = 0; }
        else if (col < 1024) { got = bf2f(((const bf16_t*)(ws + WS_Q))[(size_t)row * 512 + col - 512]); ref = a * 0.125f * LOG2E; cat = 1; }
        else if (col < 1792) { const int idx = (col - 1024) >> 7, cc = (col - 1024) & 127; got = bf2f(((const bf16_t*)(ws + WS_KV))[((size_t)idx * T_TOK + row) * 128 + cc]); ref = a; cat = 2; }
        else if (col < 1816) { got = ((const float*)(ws + WS_GATES))[(size_t)row * 24 + col - 1792]; ref = 1.f / (1.f + expf(-a)); cat = 3; }
        else { got = bf2f(((const bf16_t*)P.out)[(size_t)row * 2048 + col - 1816]); ref = 1.f / (1.f + expf(-a)); cat = 4; }
        if (!(fabsf(got - ref) <= 0.04f + 0.02f * fabsf(ref))) ++bad[cat];
    }
    for (int c = 0; c < 5; ++c) if (bad[c]) atomicAdd(ctl + 300 + c, bad[c]);
}
#endif

#ifdef CHECK_S5
__device__ __forceinline__ void check_s5(const Params& P, LAS unsigned char* lds, unsigned* ctl) {
    unsigned char* ws = P.ws;
    if (blockIdx.x >= 16) return;
    const int tid = threadIdx.x, b = blockIdx.x & 3, g = (blockIdx.x * 7 + 3) & 31;
    const float* a_re = P.in[3]; const float* a_im = P.in[4]; const float* log_dt = P.in[5]; const float* b_re = P.in[6]; const float* b_im = P.in[7]; const float* c_re = P.in[8]; const float* c_im = P.in[9]; const float* dsk = P.in[10];
    LAS float* part = (LAS float*)lds;
    const bf16_t* UGp = (const bf16_t*)(ws + WS_UG) + ((size_t)(b * 32 + g) * 4096) * 16;
    const bf16_t* YG = (const bf16_t*)(ws + WS_YG);
    const int p = tid & 63;
    const float dt = expf(log_dt[g]); const float are = a_re[g * 64 + p], aim = a_im[g * 64 + p];
    const cpx lb = lam_pow(are, aim, dt, 1.0f); const cpx cf = bbar_coef(are, aim, dt);
    float bbr[16], bbi[16], cr[16], ci[16];
    for (int j = 0; j < 16; ++j) { const cpx bb = cmul(cf, cpx{b_re[(g * 64 + p) * 16 + j], b_im[(g * 64 + p) * 16 + j]}); bbr[j] = bb.re; bbi[j] = bb.im; cr[j] = c_re[(g * 16 + j) * 64 + p]; ci[j] = c_im[(g * 16 + j) * 64 + p]; }
    float xr = 0.f, xi = 0.f; unsigned bad = 0;
    for (int sq = 0; sq < 4096; ++sq) {
        float u[16];
        for (int j = 0; j < 16; ++j) u[j] = bf2f(UGp[(size_t)sq * 16 + j]);
        float br = 0.f, bim = 0.f;
        for (int j = 0; j < 16; ++j) { br += bbr[j] * u[j]; bim += bbi[j] * u[j]; }
        const float nr = lb.re * xr - lb.im * xi + br, ni = lb.re * xi + lb.im * xr + bim; xr = nr; xi = ni;
        __syncthreads();
        if (tid < 64) for (int j = 0; j < 16; ++j) part[p * 17 + j] = cr[j] * xr - ci[j] * xi;
        __syncthreads();
        if (tid < 16) {
            float y = 0.f; for (int q = 0; q < 64; ++q) y += part[q * 17 + tid];
            y += dsk[g * 16 + tid] * u[tid];
            const float ref = gelu_tanh(y); const float got = bf2f(YG[((size_t)(b * 4096 + sq)) * 512 + g * 16 + tid]);
            if (!(fabsf(got - ref) <= 0.03f + 0.03f * fabsf(ref))) ++bad;
        }
    }
    if (bad) atomicAdd(ctl + 300, bad);
}
#endif

#ifdef CHECK_ATTN
__device__ __forceinline__ void check_attn(const Params& P, LAS unsigned char* lds, unsigned* ctl) {
    unsigned char* ws = P.ws;
    const int tid = threadIdx.x, lane = tid & 63, r = tid >> 6;
    const bf16_t* Qp = (const bf16_t*)(ws + WS_Q); const bf16_t* KVp = (const bf16_t*)(ws + WS_KV);
    const float* GT = (const float*)(ws + WS_GATES); const bf16_t* Op = (const bf16_t*)(ws + WS_O);
    LAS float* sc = (LAS float*)lds;
    LAS float* impH = sc + 1024;
    LAS int* sel = (LAS int*)(impH + 256);
    unsigned bad = 0, badsel = 0;
    for (int smp = 0; smp < 3; ++smp) {
        const int id = blockIdx.x * 3 + smp;
        const int b = id & 3, g = (id >> 2) & 1;
        int t = (int)(((unsigned)id * 2654435761u) >> 20) & 4095;
        if (id < 16) t = id * 9;
        if (id >= 16 && id < 32) t = 1000 + (id - 16) * 4;
        const size_t rowq = (size_t)b * 4096 + t;
        const int hd = g * 4 + (r & 3);
        const float nslope2 = -exp2f(-(float)(hd + 1)) * LOG2E;
        const float q = r < 4 ? bf2f(Qp[rowq * 512 + hd * 64 + lane]) : 0.f;
        const bf16_t* KC = (const bf16_t*)(ws + WS_KC) + (size_t)(b * 2 + g) * 256 * 64; const bf16_t* VC = (const bf16_t*)(ws + WS_VC) + (size_t)(b * 2 + g) * 256 * 64;
        float tot = 0.f;
        __syncthreads();
        if (r < 4) {
            const int ncmp = t >= 31 ? (t - 31) / 16 + 1 : 0;
            float m = -1e30f;
            for (int c = 0; c < ncmp; ++c) { float s2 = wave_sum(q * bf2f(KC[c * 64 + lane])) + nslope2 * (float)(t - (16 * c + 31)); if (lane == 0) sc[r * 256 + c] = s2; m = fmaxf(m, s2); }
            float l = 0.f;
            for (int c = 0; c < ncmp; ++c) l += exp2f(sc[r * 256 + c] - m);
            float o = 0.f;
            for (int c = 0; c < ncmp; ++c) { const float p = exp2f(sc[r * 256 + c] - m) / l; o += p * bf2f(VC[c * 64 + lane]); }
            tot += GT[rowq * 24 + g * 12 + r * 3 + 0] * o;
            float im = 0.f;
            for (int cc = 4 * lane - 1; cc <= 4 * lane + 3; ++cc) if (cc >= 0 && cc < ncmp) im += exp2f(sc[r * 256 + cc] - m) / l;
            impH[r * 64 + lane] = im;
        }
        __syncthreads();
        if (tid < 64) {
            const int j = tid, cur = t >> 6; const float imp = impH[j] + impH[64 + j] + impH[128 + j] + impH[192 + j];
            const bool valid = j <= cur, forced = (j == 0) || (j == cur) || (j == cur - 1);
            const float key = valid ? imp + (forced ? 1.0e4f : 0.f) : -1e30f;
            sc[j] = key;
        }
        __syncthreads();
        if (tid < 64) {
            const int j = tid; const float key = sc[j]; int cnt = 0;
            for (int jp = 0; jp < 64; ++jp) { const float sj = sc[jp]; cnt += ((sj > key) || (sj == key && jp < j)) ? 1 : 0; }
            sel[j] = (cnt < 16) ? 1 : 0;
        }
        __syncthreads();
        if (r < 4) {
            const bf16_t* Ks = KVp + (size_t)2 * T_TOK * 128; const bf16_t* Vs = KVp + (size_t)3 * T_TOK * 128;
            float m = -1e30f, l = 0.f, o = 0.f;
            for (int j = 0; j < 64; ++j) if (sel[j]) for (int kk = 0; kk < 64; ++kk) { const int kp = 64 * j + kk; if (kp > t) break;
                const float s2 = wave_sum(q * bf2f(Ks[((size_t)b * 4096 + kp) * 128 + g * 64 + lane])) + nslope2 * (float)(t - kp);
                const float mn = fmaxf(m, s2), al = exp2f(m - mn), p = exp2f(s2 - mn); l = l * al + p; o = o * al + p * bf2f(Vs[((size_t)b * 4096 + kp) * 128 + g * 64 + lane]); m = mn; }
            tot += GT[rowq * 24 + g * 12 + r * 3 + 1] * o / fmaxf(l, 1e-30f);
            const bf16_t* Kw = KVp + (size_t)4 * T_TOK * 128; const bf16_t* Vw = KVp + (size_t)5 * T_TOK * 128;
            m = -1e30f; l = 0.f; o = 0.f;
            for (int kp = (t - 511 > 0 ? t - 511 : 0); kp <= t; ++kp) {
                const float s2 = wave_sum(q * bf2f(Kw[((size_t)b * 4096 + kp) * 128 + g * 64 + lane])) + nslope2 * (float)(t - kp);
                const float mn = fmaxf(m, s2), al = exp2f(m - mn), p = exp2f(s2 - mn); l = l * al + p; o = o * al + p * bf2f(Vw[((size_t)b * 4096 + kp) * 128 + g * 64 + lane]); m = mn; }
            tot += GT[rowq * 24 + g * 12 + r * 3 + 2] * o / fmaxf(l, 1e-30f);
            const float got = bf2f(Op[rowq * 512 + hd * 64 + lane]);
            if (!(fabsf(got - tot) <= 0.02f + 0.03f * fabsf(tot))) ++bad;
        }
    }
    if (bad) atomicAdd(ctl + 300, bad);
}
#endif

#ifdef CHECK_CMP
__device__ __forceinline__ void check_cmp(const Params& P, LAS unsigned char* lds, unsigned* ctl) {
    unsigned char* ws = P.ws;
    const int tid = threadIdx.x;
    LAS float* h1 = (LAS float*)lds;
    unsigned bad = 0;
    for (int smp = 0; smp < 4; ++smp) {
        const int id = blockIdx.x * 4 + smp;
        const int kv = id & 1, b = (id >> 1) & 3, g = (id >> 3) & 1; int c = (int)(((unsigned)id * 2654435761u) >> 22) % 255; if (id < 32) c = 254 - (id >> 4);
        const bf16_t* src = (const bf16_t*)(ws + WS_KV) + (size_t)kv * T_TOK * 128;
        const float* pe = P.in[kv ? 16 : 13]; const float* w1 = P.in[kv ? 17 : 14]; const float* w2 = P.in[kv ? 18 : 15];
        const bf16_t* dst = (const bf16_t*)(ws + (kv ? WS_VC : WS_KC));
        __syncthreads();
        if (tid < 128) { float a = 0.f;
            for (int k = 0; k < 2048; ++k) { const int l = k >> 6, d = k & 63; a += (bf2f(src[((size_t)(b * 4096 + 16 * c + l)) * 128 + g * 64 + d]) + pe[k]) * w1[(size_t)k * 128 + tid]; }
            h1[tid] = gelu_tanh(a); }
        __syncthreads();
        if (tid < 64) { float a = 0.f; for (int n = 0; n < 128; ++n) a += h1[n] * w2[n * 64 + tid];
            const float got = bf2f(dst[((size_t)((b * 2 + g) * 256 + c)) * 64 + tid]);
            if (!(fabsf(got - a) <= 0.02f + 0.03f * fabsf(a))) ++bad; }
    }
    if (bad) atomicAdd(ctl + 300, bad);
}
#endif

#ifdef CHECK_X1
#ifndef X1TOL
#define X1TOL 0.03f
#endif
#ifndef X1SRC
#define X1SRC 0
#endif
__device__ __forceinline__ void check_x1(const Params& P, LAS unsigned char* lds, unsigned* ctl, const bf16_t* GMcopy) {
    unsigned char* ws = P.ws;
    const int tid = threadIdx.x; const int row = (int)(((unsigned)blockIdx.x * 2654435761u) >> 18) & 16383;
    LAS float* yg = (LAS float*)lds; LAS float* z = yg + 512; LAS float* o = z + 512; LAS float* m = o + 512; LAS float* rr = m + 1024; LAS float* red = rr + 1024;
    const bf16_t* YG = (const bf16_t*)(ws + WS_YG); const bf16_t* Op = (const bf16_t*)(ws + WS_O);
    const float* wglu = P.in[11]; const float* wups = P.in[12]; const float* wupn = P.in[19]; const float* wout = P.in[20];
    yg[tid] = bf2f(YG[(size_t)row * 512 + tid]); o[tid] = bf2f(Op[(size_t)row * 512 + tid]);
    __syncthreads();
    { float ga = 0.f, gb = 0.f; for (int k = 0; k < 512; ++k) { ga += yg[k] * wglu[(size_t)k * 1024 + tid]; gb += yg[k] * wglu[(size_t)k * 1024 + 512 + tid]; } z[tid] = ga / (1.f + expf(-gb)); }
    __syncthreads();
    if (CHECK_X1 == 2) { const float got = bf2f(((const bf16_t*)(ws + WS_Z))[(size_t)row * 512 + tid]); if (!(fabsf(got - z[tid]) <= 0.02f + 0.03f * fabsf(z[tid]))) atomicAdd(ctl + 300, 1u); return; }
    for (int n = tid; n < 1024; n += 512) { float ya = 0.f, yb = 0.f; for (int k = 0; k < 512; ++k) { ya += z[k] * wups[(size_t)k * 1024 + n]; yb += o[k] * wupn[(size_t)k * 1024 + n]; }
        m[n] = bf2f(GMcopy[(size_t)blockIdx.x * 2048 + n]) * ya + bf2f(GMcopy[(size_t)blockIdx.x * 2048 + 1024 + n]) * yb; }
    __syncthreads();
    if (CHECK_X1 == 3) { for (int n = tid; n < 1024; n += 512) { const float got = bf2f(((const bf16_t*)(ws + WS_MIXIN))[(size_t)row * 1024 + n]); if (!(fabsf(got - m[n]) <= 0.02f + 0.03f * fabsf(m[n]))) atomicAdd(ctl + 300, 1u); } return; }
    for (int n = tid; n < 1024; n += 512) { float a = 0.f; for (int k = 0; k < 1024; ++k) a += m[k] * wout[(size_t)k * 1024 + n]; rr[n] = DN_ALPHA * P.in[0][(size_t)row * 1024 + n] + a; }
    __syncthreads();
    if (CHECK_X1 == 4) { for (int n = tid; n < 1024; n += 512) { const float got = P.out[(size_t)row * 1024 + n]; if (!(fabsf(got - rr[n]) <= 0.03f + 0.03f * fabsf(rr[n]))) atomicAdd(ctl + 300, 1u); } return; }
    float sm = 0.f; for (int n = tid; n < 1024; n += 512) sm += rr[n]; sm = wave_sum(sm); if ((tid & 63) == 0) red[tid >> 6] = sm; __syncthreads();
    float mean = 0.f; for (int i = 0; i < 8; ++i) mean += red[i]; mean *= (1.f / 1024.f); __syncthreads();
    float sq = 0.f; for (int n = tid; n < 1024; n += 512) sq += (rr[n] - mean) * (rr[n] - mean); sq = wave_sum(sq); if ((tid & 63) == 0) red[tid >> 6] = sq; __syncthreads();
    float var = 0.f; for (int i = 0; i < 8; ++i) var += red[i]; var *= (1.f / 1024.f);
    const float rstd = 1.f / sqrtf(var + LN_EPS); unsigned bad = 0;
    for (int n = tid; n < 1024; n += 512) { const float ref = (rr[n] - mean) * rstd * P.in[21][n] + P.in[22][n]; const float got = X1SRC ? bf2f(((const bf16_t*)(ws + WS_X1B))[(size_t)row * 1024 + n]) : P.out[(size_t)row * 1024 + n]; if (!(fabsf(got - ref) <= X1TOL + X1TOL * fabsf(ref))) ++bad; }
    if (bad) atomicAdd(ctl + 300, bad);
}
#endif

#ifdef CHECK_QP
__device__ __forceinline__ void check_qp(const Params& P, LAS unsigned char* lds, unsigned* ctl) {
    const int tid = threadIdx.x; const int row = (int)(((unsigned)blockIdx.x * 2654435761u) >> 18) & 16383;
    LAS float* xs = (LAS float*)lds;
    for (int n = tid; n < 1024; n += 512) xs[n] = P.out[(size_t)row * 1024 + n];
    __syncthreads();
    const float* wq = P.in[23]; const bf16_t* QP = (const bf16_t*)(P.ws + WS_QP);
    for (int n = tid; n < 1024; n += 512) { float a = 0.f; for (int k = 0; k < 1024; ++k) a += xs[k] * wq[(size_t)k * 1024 + n];
        const float got = bf2f(QP[(size_t)row * 1024 + n]); if (!(fabsf(got - a) <= 0.03f + 0.03f * fabsf(a))) atomicAdd(ctl + 300, 1u); }
}
#endif

#ifdef CHECK_P10
__device__ __forceinline__ void check_p10(const Params& P, LAS unsigned char* lds, unsigned* ctl) {
    const int tid = threadIdx.x; const int row = (int)(((unsigned)blockIdx.x * 2654435761u) >> 18) & 16383;
    LAS float* xs = (LAS float*)lds; LAS float* wgt = xs + 1024; LAS float* rr = wgt + 128; LAS float* red = rr + 1024;
    const float* xsave = (const float*)(P.ws + WS_Z) + (size_t)blockIdx.x * 1024;
    for (int n = tid; n < 1024; n += 512) xs[n] = xsave[n];
    __syncthreads();
    const u32x2* pk = (const u32x2*)(P.ws + WS_PK) + (size_t)row * 128;
    const float* ut = P.in[25]; const float* vt = P.in[26];
    if (tid < 128) { const u32x2 q = pk[tid]; float h = 0.f;
#pragma nounroll
        for (int k = 0; k < 1024; ++k) h += ut[(size_t)q.x * 1024 + k] * xs[k]; wgt[tid] = __uint_as_float(q.y) * (ABL_NOH ? 1.f : gelu_tanh(h)); }
    __syncthreads();
    for (int n = tid; n < 1024; n += 512) { float y = 0.f;
#pragma nounroll
        for (int k = 0; k < 128; ++k) y += wgt[k] * vt[(size_t)pk[k].x * 1024 + n]; rr[n] = DN_ALPHA * xs[n] + (ABL_NOPEER ? 0.f : y); }
    __syncthreads();
    float sm = 0.f; for (int n = tid; n < 1024; n += 512) sm += rr[n]; sm = wave_sum(sm); if ((tid & 63) == 0) red[tid >> 6] = sm; __syncthreads();
    float mean = 0.f; for (int i = 0; i < 8; ++i) mean += red[i]; mean *= (1.f / 1024.f); __syncthreads();
    float sq = 0.f; for (int n = tid; n < 1024; n += 512) sq += (rr[n] - mean) * (rr[n] - mean); sq = wave_sum(sq); if ((tid & 63) == 0) red[tid >> 6] = sq; __syncthreads();
    float var = 0.f; for (int i = 0; i < 8; ++i) var += red[i]; var *= (1.f / 1024.f);
    const float rstd = 1.f / sqrtf(var + LN_EPS);
    for (int n = tid; n < 1024; n += 512) { const float ref = (rr[n] - mean) * rstd * P.in[27][n] + P.in[28][n]; const float got = P.out[(size_t)row * 1024 + n]; if (!(fabsf(got - ref) <= 0.03f + 0.03f * fabsf(ref))) atomicAdd(ctl + 300, 1u); }
}
#endif
#ifndef STOP_AFTER
#define STOP_AFTER 99
#endif

#ifndef DG_A
#define DG_A 0
#define DG_B 0
#endif
__device__ __forceinline__ void digest(const Params& P) {
    const int gtid = blockIdx.x * 512 + threadIdx.x, NT = gridDim.x * 512;
    const unsigned short* a = (const unsigned short*)(P.ws + (size_t)(DG_A < 0 ? 0 : DG_A) * MiB); const unsigned short* b = (const unsigned short*)(P.ws + (size_t)DG_B * MiB);
    for (int i = gtid; i < 8 * 1024 * 1024; i += NT) { P.out[i] = (float)a[i]; P.out[8 * 1024 * 1024 + i] = (float)b[i]; }
}
#ifndef NC_A
#define NC_A -1
#define NC_AN 0
#define NC_B -1
#define NC_BN 0
#define NC_C -1
#define NC_CN 0
#endif
__device__ __forceinline__ void nan_probe(const Params& P, unsigned* ctl, const XcdBarrier& bar) {
    const int gtid = blockIdx.x * 512 + threadIdx.x, NT = gridDim.x * 512;
    const int offs[3] = {NC_A, NC_B, NC_C}, szs[3] = {NC_AN, NC_BN, NC_CN};
#pragma unroll
    for (int w = 0; w < 3; ++w) if (offs[w] >= 0) {
        const unsigned short* a = (const unsigned short*)(P.ws + (size_t)offs[w] * KiB); unsigned cnt = 0;
        for (size_t i = gtid; i < (size_t)szs[w] * KiB / 2; i += NT) cnt += ((a[i] & 0x7f80u) == 0x7f80u) ? 1u : 0u;
        if (cnt) atomicAdd(ctl + 300 + w, cnt);
    }
    xcd_barrier(bar);
    float c = 0.f;
#pragma unroll
    for (int w = 0; w < 3; ++w) if (offs[w] >= 0) { if (__hip_atomic_load(ctl + 300 + w, __ATOMIC_RELAXED, __HIP_MEMORY_SCOPE_AGENT) != 0u) c += (float)(1 << w); }
#ifdef NC_COUNT
    c = log2f(1.0f + (float)__hip_atomic_load(ctl + 300, __ATOMIC_RELAXED, __HIP_MEMORY_SCOPE_AGENT));
#endif
    for (int i = gtid; i < T_TOK * DM; i += NT) P.out[i] = c;
}
#define PHASE_END(k) do { if (STOP_AFTER == (k)) { GRID_BAR(); if (NC_A >= 0) nan_probe(P, ctl, bar); else if (DG_A >= 0) digest(P); return; } } while (0)
__global__ void __launch_bounds__(512, 2) hybrid_fwd(Params P) {
    extern __shared__ __attribute__((aligned(16))) unsigned char lds_raw[];
    LAS unsigned char* lds = (LAS unsigned char*)lds_raw;
    LAS int* slot = (LAS int*)(lds + LDS_BYTES - 64);
    cg::grid_group grid = cg::this_grid();
    unsigned char* ws = P.ws;
    unsigned* ctl = (unsigned*)(ws + WS_CTL);
    const int tid = threadIdx.x, lane = tid & 63, wave = __builtin_amdgcn_readfirstlane(tid >> 6);
    const int G = gridDim.x;
    volatile LAS unsigned* MISC = (volatile LAS unsigned*)(lds + LDS_BYTES - 32);
    if (tid < 2) MISC[tid] = 0u;
    __syncthreads();
    const XcdBarrier bar = xcd_barrier_post(ctl + CW_BAR, MISC);
#define GRID_BAR() xcd_barrier(bar)

    p0_prologue(P);
    asm volatile("s_waitcnt vmcnt(0)" ::: "memory");
    grid.sync();
    if (tid == 0) { __builtin_amdgcn_fence(__ATOMIC_ACQUIRE, "agent"); asm volatile("s_waitcnt vmcnt(0)" ::: "memory"); }
    __syncthreads();

    {
        pg8::Gemm g{(const bf16_t*)(ws + WS_XB), (const bf16_t*)(ws + WS_WIN), T_TOK, INCP, 1024};
        pg8::StaticOrder S; S.init(T_TOK, INCP, G, (int)blockIdx.x);
        pg8::Epi8<FInProj> E{FInProj{P.in[2], (bf16_t*)(ws + WS_UG), (bf16_t*)(ws + WS_Q), (bf16_t*)(ws + WS_KV), (float*)(ws + WS_GATES), (bf16_t*)P.out}};
        pg8::gemm_phase(lds, g, S, E);
    }
    GRID_BAR();

#ifdef CHECK_PROJ
    check_proj(P, ctl);
    GRID_BAR();
    { float c = 0.f; for (int k = 0; k < 5; ++k) if (__hip_atomic_load(ctl + 300 + k, __ATOMIC_RELAXED, __HIP_MEMORY_SCOPE_AGENT) != 0u) c += (float)(k < 3 ? (1 << k) : 0);
      if (CHECK_PROJ == 1) { c = 0.f; if (__hip_atomic_load(ctl + 303, __ATOMIC_RELAXED, __HIP_MEMORY_SCOPE_AGENT) != 0u) c += 1.f; if (__hip_atomic_load(ctl + 304, __ATOMIC_RELAXED, __HIP_MEMORY_SCOPE_AGENT) != 0u) c += 2.f; }
      for (int i = blockIdx.x * 512 + tid; i < T_TOK * DM; i += G * 512) P.out[i] = c; }
    return;
#endif
    PHASE_END(1);
    for (;;) { const int it = next_item(ctl + CW_Q2, slot); if (it >= 256) break; compress_item(P, lds, it); }
    GRID_BAR();

#ifdef CHECK_CMP
    check_cmp(P, lds, ctl);
    GRID_BAR();
    { const float c = log2f(1.0f + (float)__hip_atomic_load(ctl + 300, __ATOMIC_RELAXED, __HIP_MEMORY_SCOPE_AGENT));
      for (int i = blockIdx.x * 512 + tid; i < T_TOK * DM; i += G * 512) P.out[i] = c; }
    return;
#endif
    PHASE_END(2);
    for (;;) { const int it = next_item(ctl + CW_Q3, slot); if (it >= 128) break; s5_item(P, lds, it & 31, it >> 5); }
#ifndef SKIP_ATTN
    for (;;) { const int k = next_item(ctl + CW_Q3B, slot); if (k >= 512) break; attn_item(P, lds, (k & 7) >> 1, k & 1, 63 - (k >> 3)); }
#endif
    GRID_BAR();

#ifdef CHECK_ATTN
    check_attn(P, lds, ctl);
    GRID_BAR();
    { const float c = log2f(1.0f + (float)__hip_atomic_load(ctl + 300, __ATOMIC_RELAXED, __HIP_MEMORY_SCOPE_AGENT));
      for (int i = blockIdx.x * 512 + tid; i < T_TOK * DM; i += G * 512) P.out[i] = c; }
    return;
#endif
#ifdef CHECK_S5
    check_s5(P, lds, ctl);
    GRID_BAR();
    { const float c = log2f(1.0f + (float)__hip_atomic_load(ctl + 300, __ATOMIC_RELAXED, __HIP_MEMORY_SCOPE_AGENT));
      for (int i = blockIdx.x * 512 + tid; i < T_TOK * DM; i += G * 512) P.out[i] = c; }
    return;
#endif
    PHASE_END(3);
    {
        pg8::Gemm g{(const bf16_t*)(ws + WS_YG), (const bf16_t*)(ws + WS_WGLU), T_TOK, 1024, 512};
        pg8::StaticOrder S; S.init(T_TOK, 1024, G, (int)blockIdx.x);
        EpiGLU E{(bf16_t*)(ws + WS_Z)};
        pg8::gemm_phase(lds, g, S, E);
    }
    GRID_BAR();

#if defined(CHECK_X1) && CHECK_X1 == 2
    check_x1(P, lds, ctl, (const bf16_t*)(ws + WS_PK));
    GRID_BAR();
    { const float c = log2f(1.0f + (float)__hip_atomic_load(ctl + 300, __ATOMIC_RELAXED, __HIP_MEMORY_SCOPE_AGENT));
      for (int i = blockIdx.x * 512 + tid; i < T_TOK * DM; i += G * 512) P.out[i] = c; }
    return;
#endif
    PHASE_END(4);
    {
        pg8::Gemm g{(const bf16_t*)(ws + WS_Z), (const bf16_t*)(ws + WS_WUPS), T_TOK, 1024, 512};
        pg8::StaticOrder S; S.init(T_TOK, 1024, G, (int)blockIdx.x);
        pg8::Epi8<FUp1> E{FUp1{(const bf16_t*)P.out, (bf16_t*)(ws + WS_M1)}};
        pg8::gemm_phase(lds, g, S, E);
    }
    {
        pg8::Gemm g{(const bf16_t*)(ws + WS_O), (const bf16_t*)(ws + WS_WUPN), T_TOK, 1024, 512};
        pg8::StaticOrder S; S.init(T_TOK, 1024, G, (int)blockIdx.x);
        pg8::Epi8<FUp2> E{FUp2{(const bf16_t*)P.out, (const bf16_t*)(ws + WS_M1), (bf16_t*)(ws + WS_MIXIN)}};
        pg8::gemm_phase(lds, g, S, E);
    }
    GRID_BAR();

#ifdef CHECK_X1
    { const int row = (int)(((unsigned)blockIdx.x * 2654435761u) >> 18) & 16383; bf16_t* dstg = (bf16_t*)(ws + WS_PK); const bf16_t* srcg = (const bf16_t*)P.out;
      for (int i = tid; i < 2048; i += 512) dstg[(size_t)blockIdx.x * 2048 + i] = srcg[(size_t)row * 2048 + i]; }
    GRID_BAR();
#if CHECK_X1 == 3
    check_x1(P, lds, ctl, (const bf16_t*)(ws + WS_PK));
    GRID_BAR();
    { const float c = log2f(1.0f + (float)__hip_atomic_load(ctl + 300, __ATOMIC_RELAXED, __HIP_MEMORY_SCOPE_AGENT));
      for (int i = blockIdx.x * 512 + tid; i < T_TOK * DM; i += G * 512) P.out[i] = c; }
    return;
#endif
#endif
    PHASE_END(5);
    {
        pg8::Gemm g{(const bf16_t*)(ws + WS_MIXIN), (const bf16_t*)(ws + WS_WOUT), T_TOK, 1024, 1024};
        pg8::StaticOrder S; S.init(T_TOK, 1024, G, (int)blockIdx.x);
        pg8::Epi8<FOut> E{FOut{P.in[0], P.out}};
        pg8::gemm_phase(lds, g, S, E);
    }
    GRID_BAR();

#if defined(CHECK_X1) && CHECK_X1 == 4
    check_x1(P, lds, ctl, (const bf16_t*)(ws + WS_PK));
    GRID_BAR();
    { const float c = log2f(1.0f + (float)__hip_atomic_load(ctl + 300, __ATOMIC_RELAXED, __HIP_MEMORY_SCOPE_AGENT));
      for (int i = blockIdx.x * 512 + tid; i < T_TOK * DM; i += G * 512) P.out[i] = c; }
    return;
#endif
    PHASE_END(6);
    {
        const float* g1 = P.in[21]; const float* b1 = P.in[22];
        for (int row = blockIdx.x * 8 + wave; row < T_TOK; row += G * 8) {
            f32x4* xr = (f32x4*)(P.out + (size_t)row * 1024) + lane;
            f32x4 v[4]; float s = 0.f;
#pragma unroll
            for (int j = 0; j < 4; ++j) { v[j] = xr[64 * j]; s += (v[j][0] + v[j][1]) + (v[j][2] + v[j][3]); }
            const float mean = wave_sum(s) * (1.f / 1024.f); float s2 = 0.f;
#pragma unroll
            for (int j = 0; j < 4; ++j) { v[j] = v[j] - mean; s2 += (v[j][0] * v[j][0] + v[j][1] * v[j][1]) + (v[j][2] * v[j][2] + v[j][3] * v[j][3]); }
            const float rstd = 1.f / sqrtf(wave_sum(s2) * (1.f / 1024.f) + LN_EPS);
            u32x2* ob = (u32x2*)((bf16_t*)(ws + WS_X1B) + (size_t)row * 1024) + lane;
#pragma unroll
            for (int j = 0; j < 4; ++j) {
                const f32x4 gg = ((const f32x4*)g1)[64 * j + lane], bb = ((const f32x4*)b1)[64 * j + lane];
                const f32x4 o = v[j] * rstd * gg + bb; xr[64 * j] = o;
                u32x2 pw; pw.x = cvt_pk_bf16(o[0], o[1]); pw.y = cvt_pk_bf16(o[2], o[3]); ob[64 * j] = pw;
            }
        }
    }
    GRID_BAR();

#ifdef CHECK_X1
    check_x1(P, lds, ctl, (const bf16_t*)(ws + WS_PK));
    GRID_BAR();
    { const float c = log2f(1.0f + (float)__hip_atomic_load(ctl + 300, __ATOMIC_RELAXED, __HIP_MEMORY_SCOPE_AGENT));
      for (int i = blockIdx.x * 512 + tid; i < T_TOK * DM; i += G * 512) P.out[i] = c; }
    return;
#endif
    PHASE_END(7);
    {
        pg8::Gemm g{(const bf16_t*)(ws + WS_X1B), (const bf16_t*)(ws + WS_WQ), T_TOK, 1024, 1024};
        pg8::StaticOrder S; S.init(T_TOK, 1024, G, (int)blockIdx.x);
        pg8::Epi8<FQP> E{FQP{(bf16_t*)(ws + WS_QP)}};
        pg8::gemm_phase(lds, g, S, E);
    }
    GRID_BAR();

#ifdef CHECK_QP
    check_qp(P, lds, ctl);
    GRID_BAR();
    { const float c = log2f(1.0f + (float)__hip_atomic_load(ctl + 300, __ATOMIC_RELAXED, __HIP_MEMORY_SCOPE_AGENT));
      for (int i = blockIdx.x * 512 + tid; i < T_TOK * DM; i += G * 512) P.out[i] = c; }
    return;
#endif
    PHASE_END(8);
    for (int it = blockIdx.x * 8 + wave; it < 4096; it += G * 8) peer_score_item(P, lds, it, wave, lane);
    GRID_BAR();

#ifdef CHECK_PEER
    check_peer(P, lds, ctl);
    GRID_BAR();
    { const float c = log2f(1.0f + (float)__hip_atomic_load(ctl + 300 + CHECK_PEER, __ATOMIC_RELAXED, __HIP_MEMORY_SCOPE_AGENT));
      for (int i = blockIdx.x * 512 + tid; i < T_TOK * DM; i += G * 512) P.out[i] = c; }
    return;
#endif
    PHASE_END(9);
#ifdef CHECK_P10
    { const int row = (int)(((unsigned)blockIdx.x * 2654435761u) >> 18) & 16383; float* xsave = (float*)(ws + WS_Z) + (size_t)blockIdx.x * 1024;
      for (int n = tid; n < 1024; n += 512) xsave[n] = P.out[(size_t)row * 1024 + n]; }
    GRID_BAR();
#endif
    for (int tok = blockIdx.x * 8 + wave; tok < T_TOK; tok += G * 8) peer_token(P, tok, lane);
#ifdef CHECK_P10
    GRID_BAR();
    check_p10(P, lds, ctl);
    GRID_BAR();
    { const float c = log2f(1.0f + (float)__hip_atomic_load(ctl + 300, __ATOMIC_RELAXED, __HIP_MEMORY_SCOPE_AGENT));
      for (int i = blockIdx.x * 512 + tid; i < T_TOK * DM; i += G * 512) P.out[i] = c; }
#endif
}

extern "C" void kernel_launch(void* const* d_in, const int* in_sizes, int n_in, void* d_out, int out_size, void* d_ws, size_t ws_size, hipStream_t stream) {
    static int grid_blocks = 0;
    if (grid_blocks == 0) {
        if (n_in != 29 || out_size != T_TOK * DM || ws_size < WS_NEED) { fprintf(stderr, "kernel_launch: unexpected problem shape (n_in %d, out %d, ws %zu)\n", n_in, out_size, ws_size); grid_blocks = -1; return; }
        int dev = 0, cus = 0, per_cu = 0;
        hipGetDevice(&dev);
        hipDeviceGetAttribute(&cus, hipDeviceAttributeMultiprocessorCount, dev);
        hipFuncSetAttribute((const void*)hybrid_fwd, hipFuncAttributeMaxDynamicSharedMemorySize, LDS_BYTES);
        hipOccupancyMaxActiveBlocksPerMultiprocessor(&per_cu, (const void*)hybrid_fwd, 512, LDS_BYTES);
        if (per_cu < 1) { fprintf(stderr, "kernel_launch: occupancy query reports %d blocks per CU\n", per_cu); per_cu = 1; }
        grid_blocks = cus;
    }
    if (grid_blocks < 0) return;
    hipMemsetAsync((char*)d_ws + WS_CTL, 0, CTL_BYTES, stream);
    Params p{};
    for (int i = 0; i < 29; ++i) p.in[i] = (const float*)d_in[i];
    p.out = (float*)d_out; p.ws = (unsigned char*)d_ws;
    void* args[] = {&p};
    hipError_t e = hipLaunchCooperativeKernel((const void*)hybrid_fwd, dim3(grid_blocks), dim3(512), args, LDS_BYTES, stream);
    if (e != hipSuccess) fprintf(stderr, "cooperative launch failed: %s (grid %d)\n", hipGetErrorString(e), grid_blocks);
}
```

```cpp
#define STOP_AFTER 99
#define DG_A -1
#define DG_B 0
#include <hip/hip_runtime.h>
#include <hip/hip_cooperative_groups.h>
#include <cstdio>
namespace cg = cooperative_groups;
#ifndef ABL_NOPEER
#define ABL_NOPEER 0
#endif
#ifndef ABL_NOMIX
#define ABL_NOMIX 0
#endif
#ifndef ABL_NOSSM
#define ABL_NOSSM 0
#endif
#ifndef ABL_NONSA
#define ABL_NONSA 0
#endif
#ifndef ABL_NOCMP
#define ABL_NOCMP 0
#endif
#ifndef ABL_NOSLC
#define ABL_NOSLC 0
#endif
#ifndef ABL_NOWIN
#define ABL_NOWIN 0
#endif
#ifndef ABL_NOH
#define ABL_NOH 0
#endif
#ifndef DUP_PHASE
#define DUP_PHASE -1
#endif

#define LAS __attribute__((address_space(3)))
typedef unsigned short bf16_t;
typedef short bf16x8 __attribute__((ext_vector_type(8)));
typedef short s16x4 __attribute__((ext_vector_type(4)));
typedef float f32x4 __attribute__((ext_vector_type(4)));
typedef float f32x16 __attribute__((ext_vector_type(16)));
typedef unsigned u32x4 __attribute__((ext_vector_type(4)));
typedef unsigned u32x2 __attribute__((ext_vector_type(2)));
typedef _Float16 h16x2 __attribute__((ext_vector_type(2)));

constexpr int T_TOK = 16384, DM = 1024, SEQ = 4096, NBATCH = 4;
constexpr int INC = 3864, INCP = 4096;
constexpr float DN_ALPHA = 1.189207115002721f;
constexpr float LN_EPS = 1e-5f;
constexpr float LOG2E = 1.4426950408889634f;

constexpr size_t MiB = 1u << 20, KiB = 1u << 10;
constexpr size_t WS_CTL = 0;
constexpr size_t CTL_BYTES = 64 * KiB;
constexpr size_t WS_SUBK = 1 * MiB;
constexpr size_t WS_W2K = WS_SUBK + 256 * KiB;
constexpr size_t WS_W2V = WS_W2K + 16 * KiB;
constexpr size_t WS_B1K = WS_W2V + 16 * KiB;
constexpr size_t WS_B1V = WS_B1K + 1 * KiB;
constexpr size_t WS_LAML = WS_B1V + 1 * KiB;
constexpr size_t WS_W1K = 2 * MiB;
constexpr size_t WS_W1V = 2 * MiB + 512 * KiB;
constexpr size_t WS_KTAB = 3 * MiB;
constexpr size_t WS_ETAB = 5 * MiB;
constexpr size_t WS_FTAB = 13 * MiB;
constexpr size_t WS_WGLU = 21 * MiB;
constexpr size_t WS_WUPS = 22 * MiB;
constexpr size_t WS_WUPN = 23 * MiB;
constexpr size_t WS_WOUT = 24 * MiB;
constexpr size_t WS_WQ = 26 * MiB;
constexpr size_t WS_KC = 28 * MiB;
constexpr size_t WS_VC = WS_KC + 256 * KiB;
constexpr size_t WS_GATES = 29 * MiB;
constexpr size_t WS_UTAB = 32 * MiB;
constexpr size_t WS_VTAB = 64 * MiB;
constexpr size_t WS_XB = 96 * MiB;
constexpr size_t WS_Z = 96 * MiB;
constexpr size_t WS_O = 112 * MiB;
constexpr size_t WS_WIN = 128 * MiB;
constexpr size_t WS_UG = 136 * MiB;
constexpr size_t WS_MIXIN = 136 * MiB;
constexpr size_t WS_Q = 152 * MiB;
constexpr size_t WS_KV = 168 * MiB;
constexpr size_t WS_X1B = 168 * MiB;
constexpr size_t WS_YG = 192 * MiB;
constexpr size_t WS_M1 = 208 * MiB;
constexpr size_t WS_QP = 208 * MiB;
constexpr size_t WS_PK = 240 * MiB;
constexpr size_t WS_NEED = 256 * MiB;
constexpr int CW_Q2 = 64, CW_Q3 = 128, CW_Q3B = 192, CW_BAR = 4096;

constexpr int LDS_BYTES = 147456;

struct Params {
    const float* in[29];
    float* out;
    unsigned char* ws;
};

typedef __bf16 bf16v2 __attribute__((ext_vector_type(2)));
__device__ __forceinline__ unsigned cvt_pk_bf16(float lo, float hi) { bf16v2 v; v.x = (__bf16)lo; v.y = (__bf16)hi; return __builtin_bit_cast(unsigned, v); }
__device__ __forceinline__ float bf_lo(unsigned w) { return __uint_as_float(w << 16); }
__device__ __forceinline__ float bf_hi(unsigned w) { return __uint_as_float(w & 0xffff0000u); }
__device__ __forceinline__ float bf2f(bf16_t b) { return __uint_as_float(((unsigned)b) << 16); }
__device__ __forceinline__ bf16_t f2bf(float f) { return (bf16_t)(cvt_pk_bf16(f, 0.f) & 0xffffu); }
__device__ __forceinline__ float fast_exp2(float x) { return __builtin_amdgcn_exp2f(x); }
__device__ __forceinline__ float fast_rcp(float x) { return __builtin_amdgcn_rcpf(x); }
__device__ __forceinline__ float sigmoidf_(float x) { return fast_rcp(1.0f + fast_exp2(-x * LOG2E)); }
__device__ __forceinline__ float gelu_tanh(float x) { const float u = 1.5957691216057308f * x * (1.0f + 0.044715f * x * x); return x * fast_rcp(1.0f + fast_exp2(-u * LOG2E)); }
__device__ __forceinline__ float wave_sum(float v) {
#pragma unroll
    for (int o = 1; o < 64; o <<= 1) v += __shfl_xor(v, o);
    return v;
}
__device__ __forceinline__ unsigned pack_h2(float a, float b) { h16x2 h; h.x = (_Float16)a; h.y = (_Float16)b; return __builtin_bit_cast(unsigned, h); }

namespace pg8 {
constexpr int BM = 256, BK = 64, HALF = 128, HTB = HALF * BK * 2, STAGE_BYTES = 8 * HTB, NXCD = 8, WGM = 8;
__host__ __device__ __forceinline__ int lds_byte(int r, int c) { const int st = (r >> 4) * 2 + (c >> 5), rr = r & 15, cc = c & 31, ob = rr * 64 + cc * 2; return st * 1024 + (ob ^ (((ob >> 9) & 1) << 5)); }
__host__ __device__ __forceinline__ void stage_rc(int b, int& R, int& C) { const int st = b / 1024, sb = b % 1024, swz = sb ^ (((sb >> 9) & 1) << 5); R = (st >> 1) * 16 + swz / 64; C = (st & 1) * 32 + (swz % 64) / 2; }
__host__ __device__ __forceinline__ int perm32(int rho) { const int n = rho >> 4, i = rho & 15; return 8 * (i >> 2) + 4 * n + (i & 3); }
struct Unit { int pm, pn; };
struct Gemm { const bf16_t* A; const bf16_t* Bt; int M, N, K; };
struct StaticOrder {
    int nM, nN, nwg, G, c;
    __device__ void init(int M, int N, int G_, int c_) { nM = M / BM; nN = N / BM; nwg = nM * nN; G = G_; c = c_; }
    __device__ bool next(int i, Unit& u) const {
        const long L = (long)i * G + c; if (L >= nwg) return false;
        int wgid = (int)L; { const int q = nwg / NXCD, r = nwg % NXCD, xcd = wgid % NXCD, off = wgid / NXCD; wgid = (xcd < r ? xcd * (q + 1) : r * (q + 1) + (xcd - r) * q) + off; }
        const int nig = WGM * nN, gid = wgid / nig, fm = gid * WGM, gsz = (nM - fm) < WGM ? (nM - fm) : WGM;
        u.pm = fm + ((wgid % nig) % gsz); u.pn = (wgid % nig) / gsz; return true;
    }
};
template <class Epi>
__device__ __forceinline__ void gemm_phase(LAS unsigned char* lds, const Gemm g, const StaticOrder& S, const Epi& E) {
    const int tid = threadIdx.x, wid = __builtin_amdgcn_readfirstlane(tid >> 6), lane = tid & 63, wr = wid >> 2, wc = wid & 3, fr = lane & 15, fq = lane >> 4;
    const int K = g.K, nt = K / BK;
    unsigned voffA[2], voffB[2];
#pragma unroll
    for (int i = 0; i < 2; ++i) { int R, C; stage_rc(tid * 16 + i * 8192, R, C); const int Rb = (R & ~31) + perm32(R & 31);
        voffA[i] = (unsigned)(R * K + C) * 2u; voffB[i] = (unsigned)(Rb * K + C) * 2u; }
    const size_t kstep = (size_t)(BK * 2);
    const size_t hstep = (size_t)HALF * K * 2;
    const size_t tstep = 2 * hstep;
    const unsigned ldsw = (unsigned)wid * 1024u;
    const int aoff = lds_byte(wr * 64 + fr, fq * 8), boff = lds_byte(wc * 32 + fr, fq * 8);
#define PG8_SA(b, h) (((b) * 2 + (h)) * HTB)
#define PG8_SB(b, h) ((4 + (b) * 2 + (h)) * HTB)
#define PG8_STAGE(bufoff, gbase, voff) do { _Pragma("unroll") for (int _i = 0; _i < 2; ++_i) \
        __builtin_amdgcn_global_load_lds((const unsigned*)((const char*)(gbase) + (voff)[_i]), (LAS unsigned*)(lds + (bufoff) + ldsw + _i * 8192), 16, 0, 0); } while (0)
#define PG8_LDA(dst, b, h) do { _Pragma("unroll") for (int m = 0; m < 4; ++m) _Pragma("unroll") for (int k = 0; k < 2; ++k) dst[m][k] = *(const LAS bf16x8*)(lds + PG8_SA(b, h) + aoff + m * 2048 + k * 1024); } while (0)
#define PG8_LDB(dst, b, h) do { _Pragma("unroll") for (int n = 0; n < 2; ++n) _Pragma("unroll") for (int k = 0; k < 2; ++k) dst[n][k] = *(const LAS bf16x8*)(lds + PG8_SB(b, h) + boff + n * 2048 + k * 1024); } while (0)
#define PG8_MMA(ai, bj, At, Bt) do { __builtin_amdgcn_s_setprio(1); _Pragma("unroll") for (int m = 0; m < 4; ++m) _Pragma("unroll") for (int n = 0; n < 2; ++n) _Pragma("unroll") for (int k = 0; k < 2; ++k) \
        acc[ai][bj][m][n] = __builtin_amdgcn_mfma_f32_16x16x32_bf16(Bt[n][k], At[m][k], acc[ai][bj][m][n], 0, 0, 0); __builtin_amdgcn_s_setprio(0); } while (0)
#define PG8_WAIT_V(n) asm volatile("s_waitcnt vmcnt(" #n ")" ::: "memory")
#define PG8_WAIT_L(n) asm volatile("s_waitcnt lgkmcnt(" #n ")" ::: "memory")
#define PG8_BAR __builtin_amdgcn_s_barrier()
#define PG8_SCHED __builtin_amdgcn_sched_barrier(0)
    Unit cur, nxt; int ui = 0;
    if (!S.next(0, cur)) return;
    f32x4 acc[2][2][4][2];
#pragma unroll
    for (int a = 0; a < 2; ++a)
#pragma unroll
        for (int b = 0; b < 2; ++b)
#pragma unroll
            for (int m = 0; m < 4; ++m)
#pragma unroll
                for (int n = 0; n < 2; ++n) acc[a][b][m][n] = (f32x4){0.f, 0.f, 0.f, 0.f};
    bf16x8 At[4][2], B0[2][2], B1[2][2];
    const char* cA = (const char*)g.A + (size_t)cur.pm * tstep; const char* cB = (const char*)g.Bt + (size_t)cur.pn * tstep;
    PG8_STAGE(PG8_SB(0, 0), cB, voffB); PG8_STAGE(PG8_SA(0, 0), cA, voffA); PG8_STAGE(PG8_SB(0, 1), cB + hstep, voffB); PG8_STAGE(PG8_SA(0, 1), cA + hstep, voffA);
    if (wr == 1) PG8_BAR;
    PG8_WAIT_V(4); PG8_BAR;
    PG8_STAGE(PG8_SB(1, 0), cB + kstep, voffB); PG8_STAGE(PG8_SA(1, 0), cA + kstep, voffA); PG8_STAGE(PG8_SB(1, 1), cB + hstep + kstep, voffB);
    PG8_WAIT_V(6); PG8_BAR;
    for (;;) {
        const bool has_next = S.next(ui + 1, nxt);
        const char* nA = has_next ? (const char*)g.A + (size_t)nxt.pm * tstep : cA; const char* nB = has_next ? (const char*)g.Bt + (size_t)nxt.pn * tstep : cB;
        for (int t = 0; t < nt; t += 2) {
            const bool last = (t == nt - 2);
            const char* a1 = cA + (size_t)(t + 1) * kstep;
            const char* a2 = last ? nA : cA + (size_t)(t + 2) * kstep; const char* b2 = last ? nB : cB + (size_t)(t + 2) * kstep;
            const char* a3 = a2 + kstep; const char* b3 = b2 + kstep;
            PG8_LDB(B0, 0, 0); PG8_SCHED; PG8_LDA(At, 0, 0); PG8_STAGE(PG8_SA(1, 1), a1 + hstep, voffA);
            PG8_WAIT_L(8); PG8_BAR; PG8_WAIT_L(0); PG8_MMA(0, 0, At, B0); PG8_BAR; PG8_SCHED;
            PG8_LDB(B1, 0, 1); PG8_STAGE(PG8_SB(0, 0), b2, voffB);
            PG8_BAR; PG8_WAIT_L(0); PG8_MMA(0, 1, At, B1); PG8_BAR;
            PG8_LDA(At, 0, 1); PG8_STAGE(PG8_SA(0, 0), a2, voffA);
            PG8_BAR; PG8_WAIT_L(0); PG8_MMA(1, 0, At, B0); PG8_BAR; PG8_SCHED;
            PG8_STAGE(PG8_SB(0, 1), b2 + hstep, voffB);
            PG8_WAIT_V(6); PG8_BAR; PG8_MMA(1, 1, At, B1); PG8_BAR;
            PG8_LDB(B0, 1, 0); PG8_SCHED; PG8_LDA(At, 1, 0); PG8_STAGE(PG8_SA(0, 1), a2 + hstep, voffA);
            PG8_WAIT_L(8); PG8_BAR; PG8_WAIT_L(0); PG8_MMA(0, 0, At, B0); PG8_BAR; PG8_SCHED;
            PG8_LDB(B1, 1, 1); PG8_STAGE(PG8_SB(1, 0), b3, voffB);
            PG8_BAR; PG8_WAIT_L(0); PG8_MMA(0, 1, At, B1); PG8_BAR;
            PG8_LDA(At, 1, 1); PG8_STAGE(PG8_SA(1, 0), a3, voffA);
            PG8_BAR; PG8_WAIT_L(0); PG8_MMA(1, 0, At, B0); PG8_BAR; PG8_SCHED;
            PG8_STAGE(PG8_SB(1, 1), b3 + hstep, voffB);
            PG8_WAIT_V(6); PG8_BAR; PG8_MMA(1, 1, At, B1); PG8_BAR;
        }
        E(acc, cur, wr, wc, fr, fq);
        if (!has_next) break;
#pragma unroll
        for (int a = 0; a < 2; ++a)
#pragma unroll
            for (int b = 0; b < 2; ++b)
#pragma unroll
                for (int m = 0; m < 4; ++m)
#pragma unroll
                    for (int n = 0; n < 2; ++n) acc[a][b][m][n] = (f32x4){0.f, 0.f, 0.f, 0.f};
        cur = nxt; cA = nA; cB = nB; ++ui;
    }
    PG8_WAIT_V(0);
    if (wr == 0) PG8_BAR;
    PG8_BAR;
#undef PG8_SA
#undef PG8_SB
#undef PG8_STAGE
#undef PG8_LDA
#undef PG8_LDB
#undef PG8_MMA
#undef PG8_WAIT_V
#undef PG8_WAIT_L
#undef PG8_BAR
#undef PG8_SCHED
}
template <class F> struct Epi8 {
    F f;
    __device__ __forceinline__ void operator()(const f32x4 (&acc)[2][2][4][2], const Unit& u, int wr, int wc, int fr, int fq) const {
        const int row0 = u.pm * BM + wr * 64 + fr, col0 = u.pn * BM + wc * 32 + 8 * fq;
#pragma unroll
        for (int ai = 0; ai < 2; ++ai)
#pragma unroll
            for (int m = 0; m < 4; ++m) {
                const int row = row0 + ai * HALF + m * 16;
#pragma unroll
                for (int bj = 0; bj < 2; ++bj) f(row, col0 + bj * HALF, acc[ai][bj][m][0], acc[ai][bj][m][1]);
            }
    }
};
}

__device__ __forceinline__ u32x4 pack8(const f32x4& a, const f32x4& b) {
    u32x4 w; w.x = cvt_pk_bf16(a[0], a[1]); w.y = cvt_pk_bf16(a[2], a[3]); w.z = cvt_pk_bf16(b[0], b[1]); w.w = cvt_pk_bf16(b[2], b[3]); return w;
}

struct FInProj {
    const float* bias; bf16_t* UG; bf16_t* Q; bf16_t* KV; float* GATES; bf16_t* GM;
    __device__ __forceinline__ void operator()(int row, int col, f32x4 v0, f32x4 v1) const {
        if (col >= INC) return;
        const f32x4 b0 = *(const f32x4*)(bias + col), b1 = *(const f32x4*)(bias + col + 4);
        v0 += b0; v1 += b1;
        if (col < 512) {
            const int b = row >> 12, s = row & 4095, g = col >> 4, hp = col & 15;
            *(u32x4*)(UG + ((size_t)((b * 32 + g) * 4096 + s)) * 16 + hp) = pack8(v0, v1);
        } else if (col < 1024) {
            *(u32x4*)(Q + (size_t)row * 512 + (col - 512)) = pack8(v0 * (0.125f * LOG2E), v1 * (0.125f * LOG2E));
        } else if (col < 1792) {
            const int idx = (col - 1024) >> 7, cc = (col - 1024) & 127;
            *(u32x4*)(KV + ((size_t)idx * T_TOK + row) * 128 + cc) = pack8(v0, v1);
        } else if (col < 1816) {
            f32x4 s0, s1;
#pragma unroll
            for (int j = 0; j < 4; ++j) { s0[j] = sigmoidf_(v0[j]); s1[j] = sigmoidf_(v1[j]); }
            float* gp = GATES + (size_t)row * 24 + (col - 1792);
            *(f32x4*)gp = s0; *(f32x4*)(gp + 4) = s1;
        } else {
            f32x4 s0, s1;
#pragma unroll
            for (int j = 0; j < 4; ++j) { s0[j] = sigmoidf_(v0[j]); s1[j] = sigmoidf_(v1[j]); }
            *(u32x4*)(GM + (size_t)row * 2048 + (col - 1816)) = pack8(s0, s1);
        }
    }
};
struct EpiGLU {
    bf16_t* ZO;
    __device__ __forceinline__ void operator()(const f32x4 (&acc)[2][2][4][2], const pg8::Unit& u, int wr, int wc, int fr, int fq) const {
        const int row0 = u.pm * 256 + wr * 64 + fr, col0 = u.pn * 128 + wc * 32 + 8 * fq;
#pragma unroll
        for (int ai = 0; ai < 2; ++ai)
#pragma unroll
            for (int m = 0; m < 4; ++m) {
                const int row = row0 + ai * 128 + m * 16;
                f32x4 z0, z1;
#pragma unroll
                for (int j = 0; j < 4; ++j) { z0[j] = acc[ai][0][m][0][j] * sigmoidf_(acc[ai][1][m][0][j]); z1[j] = acc[ai][0][m][1][j] * sigmoidf_(acc[ai][1][m][1][j]); }
                *(u32x4*)(ZO + (size_t)row * 512 + col0) = pack8(z0, z1);
            }
    }
};
struct FUp1 {
    const bf16_t* GM; bf16_t* M1;
    __device__ __forceinline__ void operator()(int row, int col, f32x4 v0, f32x4 v1) const {
        const u32x4 g = *(const u32x4*)(GM + (size_t)row * 2048 + col);
        if (ABL_NOSSM) { v0 = (f32x4){0.f, 0.f, 0.f, 0.f}; v1 = v0; }
        v0[0] *= bf_lo(g.x); v0[1] *= bf_hi(g.x); v0[2] *= bf_lo(g.y); v0[3] *= bf_hi(g.y);
        v1[0] *= bf_lo(g.z); v1[1] *= bf_hi(g.z); v1[2] *= bf_lo(g.w); v1[3] *= bf_hi(g.w);
        *(u32x4*)(M1 + (size_t)row * 1024 + col) = pack8(v0, v1);
    }
};
struct FUp2 {
    const bf16_t* GM; const bf16_t* M1; bf16_t* MX;
    __device__ __forceinline__ void operator()(int row, int col, f32x4 v0, f32x4 v1) const {
        const u32x4 g = *(const u32x4*)(GM + (size_t)row * 2048 + 1024 + col);
        const u32x4 a = *(const u32x4*)(M1 + (size_t)row * 1024 + col);
        if (ABL_NONSA) { v0 = (f32x4){0.f, 0.f, 0.f, 0.f}; v1 = v0; }
        v0[0] = v0[0] * bf_lo(g.x) + bf_lo(a.x); v0[1] = v0[1] * bf_hi(g.x) + bf_hi(a.x); v0[2] = v0[2] * bf_lo(g.y) + bf_lo(a.y); v0[3] = v0[3] * bf_hi(g.y) + bf_hi(a.y);
        v1[0] = v1[0] * bf_lo(g.z) + bf_lo(a.z); v1[1] = v1[1] * bf_hi(g.z) + bf_hi(a.z); v1[2] = v1[2] * bf_lo(g.w) + bf_lo(a.w); v1[3] = v1[3] * bf_hi(g.w) + bf_hi(a.w);
        *(u32x4*)(MX + (size_t)row * 1024 + col) = pack8(v0, v1);
    }
};
struct FOut {
    const float* x; float* R;
    __device__ __forceinline__ void operator()(int row, int col, f32x4 v0, f32x4 v1) const {
        const f32x4 x0 = *(const f32x4*)(x + (size_t)row * 1024 + col), x1 = *(const f32x4*)(x + (size_t)row * 1024 + col + 4);
        if (ABL_NOMIX) { v0 = (f32x4){0.f, 0.f, 0.f, 0.f}; v1 = v0; }
        *(f32x4*)(R + (size_t)row * 1024 + col) = x0 * DN_ALPHA + v0;
        *(f32x4*)(R + (size_t)row * 1024 + col + 4) = x1 * DN_ALPHA + v1;
    }
};
struct FQP {
    bf16_t* QP;
    __device__ __forceinline__ void operator()(int row, int col, f32x4 v0, f32x4 v1) const { *(u32x4*)(QP + (size_t)row * 1024 + col) = pack8(v0, v1); }
};

struct cpx { float re, im; };
__device__ __forceinline__ cpx cmul(cpx a, cpx b) { return {a.re * b.re - a.im * b.im, a.re * b.im + a.im * b.re}; }
__device__ __forceinline__ cpx lam_pow(float are, float aim, float dt, float tau) {
    const float er = are * dt * tau, ei = aim * dt * tau; const float m = expf(er); float s, c; sincosf(ei, &s, &c); return {m * c, m * s};
}
__device__ __forceinline__ cpx bbar_coef(float are, float aim, float dt) {
    const float x = are * dt, y = aim * dt; const float ex1 = expm1f(x); float s, c; sincosf(y, &s, &c); const float sh = sinf(0.5f * y);
    const float nr = ex1 * c - 2.f * sh * sh, ni = (ex1 + 1.f) * s;
    const float den = are * are + aim * aim;
    return {(nr * are + ni * aim) / den, (ni * are - nr * aim) / den};
}
template <class CM>
__device__ __forceinline__ void transpose_w(const float* src, int K, int Ns, bf16_t* dst, int Nd, CM cm, int gtid, int NT) {
    const int kch = K / 8; const long total = (long)Nd * kch;
    for (long i = gtid; i < total; i += NT) {
        const int n = (int)(i % Nd), kc = (int)(i / Nd); const int sc = cm(n);
        float v[8];
#pragma unroll
        for (int j = 0; j < 8; ++j) v[j] = sc >= 0 ? src[(size_t)(kc * 8 + j) * Ns + sc] : 0.f;
        u32x4 w; w.x = cvt_pk_bf16(v[0], v[1]); w.y = cvt_pk_bf16(v[2], v[3]); w.z = cvt_pk_bf16(v[4], v[5]); w.w = cvt_pk_bf16(v[6], v[7]);
        *(u32x4*)(dst + (size_t)n * K + kc * 8) = w;
    }
}
__device__ __forceinline__ void p0_prologue(const Params& P) {
    const int gtid = blockIdx.x * 512 + threadIdx.x, NT = gridDim.x * 512;
    unsigned char* ws = P.ws;
    { const f32x4* x4 = (const f32x4*)P.in[0]; u32x4* o = (u32x4*)(ws + WS_XB);
      for (int i = gtid; i < T_TOK * DM / 8; i += NT) { const f32x4 a = x4[2 * i], b = x4[2 * i + 1]; o[i] = pack8(a, b); } }
    { const f32x4* u4 = (const f32x4*)P.in[25]; const f32x4* v4 = (const f32x4*)P.in[26]; u32x4* uo = (u32x4*)(ws + WS_UTAB); u32x4* vo = (u32x4*)(ws + WS_VTAB);
      for (int i = gtid; i < 16384 * 1024 / 8; i += NT) {
          const f32x4 a = u4[2 * i], b = u4[2 * i + 1]; u32x4 w; w.x = pack_h2(a[0], a[1]); w.y = pack_h2(a[2], a[3]); w.z = pack_h2(b[0], b[1]); w.w = pack_h2(b[2], b[3]); uo[i] = w;
          const f32x4 c = v4[2 * i], d = v4[2 * i + 1]; u32x4 z; z.x = pack_h2(c[0], c[1]); z.y = pack_h2(c[2], c[3]); z.z = pack_h2(d[0], d[1]); z.w = pack_h2(d[2], d[3]); vo[i] = z; } }
    transpose_w(P.in[1], 1024, INC, (bf16_t*)(ws + WS_WIN), INCP, [](int n) { return n < INC ? n : -1; }, gtid, NT);
    transpose_w(P.in[11], 512, 1024, (bf16_t*)(ws + WS_WGLU), 1024, [](int R) { const int pn = R >> 8, bj = (R >> 7) & 1, i = R & 127; return bj * 512 + pn * 128 + i; }, gtid, NT);
    transpose_w(P.in[12], 512, 1024, (bf16_t*)(ws + WS_WUPS), 1024, [](int n) { return n; }, gtid, NT);
    transpose_w(P.in[19], 512, 1024, (bf16_t*)(ws + WS_WUPN), 1024, [](int n) { return n; }, gtid, NT);
    transpose_w(P.in[20], 1024, 1024, (bf16_t*)(ws + WS_WOUT), 1024, [](int n) { return n; }, gtid, NT);
    transpose_w(P.in[23], 1024, 1024, (bf16_t*)(ws + WS_WQ), 1024, [](int n) { return n; }, gtid, NT);
    transpose_w(P.in[14], 2048, 128, (bf16_t*)(ws + WS_W1K), 128, [](int n) { return n; }, gtid, NT);
    transpose_w(P.in[17], 2048, 128, (bf16_t*)(ws + WS_W1V), 128, [](int n) { return n; }, gtid, NT);
    transpose_w(P.in[15], 128, 64, (bf16_t*)(ws + WS_W2K), 64, [](int n) { return n; }, gtid, NT);
    transpose_w(P.in[18], 128, 64, (bf16_t*)(ws + WS_W2V), 64, [](int n) { return n; }, gtid, NT);
    { const float* sk = P.in[24]; bf16_t* o = (bf16_t*)(ws + WS_SUBK); for (int i = gtid; i < 8 * 2 * 128 * 64; i += NT) o[i] = f2bf(sk[i]); }
    if (gtid < 256) { const int kv = gtid >> 7, n = gtid & 127; const float* pe = P.in[kv ? 16 : 13]; const float* w1 = P.in[kv ? 17 : 14]; float s = 0.f;
        for (int k = 0; k < 2048; ++k) s += pe[k] * w1[(size_t)k * 128 + n];
        ((float*)(ws + (kv ? WS_B1V : WS_B1K)))[n] = s; }
    const float* a_re = P.in[3]; const float* a_im = P.in[4]; const float* log_dt = P.in[5]; const float* b_re = P.in[6]; const float* b_im = P.in[7]; const float* c_re = P.in[8]; const float* c_im = P.in[9];
    if (gtid < 2048) { const int g = gtid >> 6; const float dt = expf(log_dt[g]); const cpx l = lam_pow(a_re[gtid], a_im[gtid], dt, 64.f); ((float*)(ws + WS_LAML))[2 * gtid] = l.re; ((float*)(ws + WS_LAML))[2 * gtid + 1] = l.im; }
    for (int i = gtid; i < 32 * 65 * 16; i += NT) {
        const int h = i & 15, li = (i >> 4) % 65, g = i / (65 * 16); const int lag = li - 1;
        float acc[16];
#pragma unroll
        for (int j = 0; j < 16; ++j) acc[j] = 0.f;
        if (lag >= 0) {
            const float dt = expf(log_dt[g]);
            for (int p = 0; p < 64; ++p) {
                const float are = a_re[g * 64 + p], aim = a_im[g * 64 + p];
                const cpx lp = lam_pow(are, aim, dt, (float)lag); const cpx cf = bbar_coef(are, aim, dt);
                const cpx C = {c_re[(g * 16 + h) * 64 + p], c_im[(g * 16 + h) * 64 + p]};
                const cpx cl = cmul(cmul(C, lp), cf);
#pragma unroll
                for (int j = 0; j < 16; ++j) { const float br = b_re[(g * 64 + p) * 16 + j], bi = b_im[(g * 64 + p) * 16 + j]; acc[j] += cl.re * br - cl.im * bi; }
            }
        }
        u32x4 w0, w1;
        w0.x = cvt_pk_bf16(acc[0], acc[1]); w0.y = cvt_pk_bf16(acc[2], acc[3]); w0.z = cvt_pk_bf16(acc[4], acc[5]); w0.w = cvt_pk_bf16(acc[6], acc[7]);
        w1.x = cvt_pk_bf16(acc[8], acc[9]); w1.y = cvt_pk_bf16(acc[10], acc[11]); w1.z = cvt_pk_bf16(acc[12], acc[13]); w1.w = cvt_pk_bf16(acc[14], acc[15]);
        u32x4* o = (u32x4*)((bf16_t*)(ws + WS_KTAB) + ((size_t)(g * 65 + li) * 16 + h) * 16); o[0] = w0; o[1] = w1;
    }
    for (int i = gtid; i < 32 * 64 * 64; i += NT) {
        const int s = i & 63, p = (i >> 6) & 63, g = i >> 12; const float dt = expf(log_dt[g]);
        const float are = a_re[g * 64 + p], aim = a_im[g * 64 + p];
        const cpx f = cmul(lam_pow(are, aim, dt, (float)(63 - s)), bbar_coef(are, aim, dt));
        float vr[16], vi[16];
#pragma unroll
        for (int j = 0; j < 16; ++j) { const float br = b_re[(g * 64 + p) * 16 + j], bi = b_im[(g * 64 + p) * 16 + j]; vr[j] = f.re * br - f.im * bi; vi[j] = f.re * bi + f.im * br; }
        bf16_t* er = (bf16_t*)(ws + WS_ETAB) + ((size_t)g * 128 + p) * 1024 + s * 16; bf16_t* ei = er + (size_t)64 * 1024;
        u32x4 w;
        w.x = cvt_pk_bf16(vr[0], vr[1]); w.y = cvt_pk_bf16(vr[2], vr[3]); w.z = cvt_pk_bf16(vr[4], vr[5]); w.w = cvt_pk_bf16(vr[6], vr[7]); ((u32x4*)er)[0] = w;
        w.x = cvt_pk_bf16(vr[8], vr[9]); w.y = cvt_pk_bf16(vr[10], vr[11]); w.z = cvt_pk_bf16(vr[12], vr[13]); w.w = cvt_pk_bf16(vr[14], vr[15]); ((u32x4*)er)[1] = w;
        w.x = cvt_pk_bf16(vi[0], vi[1]); w.y = cvt_pk_bf16(vi[2], vi[3]); w.z = cvt_pk_bf16(vi[4], vi[5]); w.w = cvt_pk_bf16(vi[6], vi[7]); ((u32x4*)ei)[0] = w;
        w.x = cvt_pk_bf16(vi[8], vi[9]); w.y = cvt_pk_bf16(vi[10], vi[11]); w.z = cvt_pk_bf16(vi[12], vi[13]); w.w = cvt_pk_bf16(vi[14], vi[15]); ((u32x4*)ei)[1] = w;
    }
    for (int i = gtid; i < 32 * 64 * 64; i += NT) {
        const int p = i & 63, t = (i >> 6) & 63, g = i >> 12; const float dt = expf(log_dt[g]);
        const cpx lp = lam_pow(a_re[g * 64 + p], a_im[g * 64 + p], dt, (float)(t + 1));
        bf16_t* f = (bf16_t*)(ws + WS_FTAB) + ((size_t)g * 1024 + t * 16) * 128 + p;
        for (int h = 0; h < 16; ++h) { const cpx C = {c_re[(g * 16 + h) * 64 + p], c_im[(g * 16 + h) * 64 + p]}; const cpx cl = cmul(C, lp); f[h * 128] = f2bf(cl.re); f[h * 128 + 64] = f2bf(-cl.im); }
    }
}

__device__ __forceinline__ void compress_item(const Params& P, LAS unsigned char* lds, int item) {
    unsigned char* ws = P.ws;
    const int tid = threadIdx.x, lane = tid & 63, w = __builtin_amdgcn_readfirstlane(tid >> 6), fr = lane & 15, q = lane >> 4;
    const int ct = item & 15, g = (item >> 4) & 1, b = (item >> 5) & 3, kv = item >> 7;
    const bf16_t* src = (const bf16_t*)(ws + WS_KV) + (size_t)(kv ? 1 : 0) * T_TOK * 128;
    const bf16_t* W1T = (const bf16_t*)(ws + (kv ? WS_W1V : WS_W1K));
    const bf16_t* W2T = (const bf16_t*)(ws + (kv ? WS_W2V : WS_W2K));
    const float* bias1 = (const float*)(ws + (kv ? WS_B1V : WS_B1K));
    bf16_t* dst = (bf16_t*)(ws + (kv ? WS_VC : WS_KC));
    const int c = ct * 16 + fr;
    f32x4 acc = {0.f, 0.f, 0.f, 0.f};
    const bf16_t* brow = W1T + (size_t)(16 * w + fr) * 2048 + 8 * q;
#pragma unroll 4
    for (int kk = 0; kk < 64; ++kk) {
        const int l = kk >> 1, d = (kk & 1) * 32 + 8 * q; int tok = 16 * c + l; tok = tok > 4095 ? 4095 : tok;
        const bf16x8 A = *(const bf16x8*)(src + ((size_t)(b * 4096 + tok)) * 128 + g * 64 + d);
        const bf16x8 B = *(const bf16x8*)(brow + kk * 32);
        acc = __builtin_amdgcn_mfma_f32_16x16x32_bf16(A, B, acc, 0, 0, 0);
    }
    LAS bf16_t* H1 = (LAS bf16_t*)lds;
    { const int col = 16 * w + fr; const float bb = bias1[col];
#pragma unroll
      for (int r = 0; r < 4; ++r) H1[(4 * q + r) * 136 + col] = f2bf(gelu_tanh(acc[r] + bb)); }
    __syncthreads();
    if (w < 4) {
        f32x4 a2 = {0.f, 0.f, 0.f, 0.f};
#pragma unroll
        for (int kk = 0; kk < 4; ++kk) {
            const bf16x8 A = *(const LAS bf16x8*)(H1 + fr * 136 + kk * 32 + 8 * q);
            const bf16x8 B = *(const bf16x8*)(W2T + (size_t)(16 * w + fr) * 128 + kk * 32 + 8 * q);
            a2 = __builtin_amdgcn_mfma_f32_16x16x32_bf16(A, B, a2, 0, 0, 0);
        }
#pragma unroll
        for (int r = 0; r < 4; ++r) dst[((size_t)((b * 2 + g) * 256 + ct * 16 + 4 * q + r)) * 64 + 16 * w + fr] = f2bf(a2[r]);
    }
    __syncthreads();
}

constexpr int S5_KT_OFF = 0;
constexpr int S5_UB_OFF = 33280;
constexpr int S5_XE_OFF = S5_UB_OFF + 33024;
constexpr int S5_XIN_OFF = S5_XE_OFF + 8192;
__device__ __forceinline__ void s5_item(const Params& P, LAS unsigned char* lds, int g, int b) {
    unsigned char* ws = P.ws;
    const int tid = threadIdx.x, lane = tid & 63, w = __builtin_amdgcn_readfirstlane(tid >> 6), fr = lane & 15, q = lane >> 4;
    const bf16_t* UGp = (const bf16_t*)(ws + WS_UG) + ((size_t)(b * 32 + g) * 4096) * 16;
    const bf16_t* ET = (const bf16_t*)(ws + WS_ETAB) + (size_t)g * 128 * 1024;
    const bf16_t* FT = (const bf16_t*)(ws + WS_FTAB) + (size_t)g * 1024 * 128;
    bf16_t* YG = (bf16_t*)(ws + WS_YG);
    const float* dsk = P.in[10];
    { const u32x4* src = (const u32x4*)((const bf16_t*)(ws + WS_KTAB) + (size_t)g * 65 * 256);
      for (int i = tid; i < 33280 / 16; i += 512) *(LAS u32x4*)(lds + S5_KT_OFF + i * 16) = src[i]; }
    float st_re = 0.f, st_im = 0.f, lr = 0.f, li = 0.f;
    if (tid < 64) { const float* ll = (const float*)(ws + WS_LAML) + (size_t)(g * 64 + tid) * 2; lr = ll[0]; li = ll[1]; }
    float dval[4];
#pragma unroll
    for (int r = 0; r < 4; ++r) dval[r] = dsk[g * 16 + 4 * q + r];
    LAS float* XE = (LAS float*)(lds + S5_XE_OFF);
    LAS bf16_t* XIN = (LAS bf16_t*)(lds + S5_XIN_OFF);
    for (int batch = 0; batch < 4; ++batch) {
        __syncthreads();
        { const u32x4* src = (const u32x4*)(UGp + (size_t)batch * 1024 * 16);
#pragma unroll
          for (int i = 0; i < 4; ++i) { const int pc = tid + i * 512; *(LAS u32x4*)(lds + S5_UB_OFF + (pc >> 7) * 2064 + (pc & 127) * 16) = src[pc]; } }
        __syncthreads();
        {
            f32x4 acc = {0.f, 0.f, 0.f, 0.f};
            const bf16_t* arow = ET + (size_t)(16 * w + fr) * 1024 + 8 * q;
            const LAS unsigned char* bb = lds + S5_UB_OFF + fr * 2064 + (q >> 1) * 32 + (q & 1) * 16;
#pragma unroll 4
            for (int kk = 0; kk < 32; ++kk) {
                const bf16x8 A = *(const bf16x8*)(arow + kk * 32);
                const bf16x8 B = *(const LAS bf16x8*)(bb + kk * 64);
                acc = __builtin_amdgcn_mfma_f32_16x16x32_bf16(A, B, acc, 0, 0, 0);
            }
#pragma unroll
            for (int r = 0; r < 4; ++r) XE[(16 * w + 4 * q + r) * 16 + fr] = acc[r];
        }
        __syncthreads();
        if (tid < 64) {
            for (int c = 0; c < 16; ++c) {
                XIN[c * 136 + tid] = f2bf(st_re); XIN[c * 136 + 64 + tid] = f2bf(st_im);
                const float xr = XE[tid * 16 + c], xi = XE[(64 + tid) * 16 + c];
                const float nr = lr * st_re - li * st_im + xr, ni = lr * st_im + li * st_re + xi;
                st_re = nr; st_im = ni;
            }
        }
        __syncthreads();
        for (int t = w; t < 64; t += 8) {
            f32x4 acc = {0.f, 0.f, 0.f, 0.f};
            const LAS unsigned char* bb = lds + S5_UB_OFF + fr * 2064 + (q >> 1) * 32 + (q & 1) * 16;
            const LAS unsigned char* ka = lds + S5_KT_OFF + ((t + 1 - (q >> 1)) * 256 + fr * 16 + (q & 1) * 8) * 2;
            const int nk = (t >> 1) + 1;
            for (int kk = 0; kk < nk; ++kk) {
                const bf16x8 A = *(const LAS bf16x8*)(ka - kk * 1024);
                const bf16x8 B = *(const LAS bf16x8*)(bb + kk * 64);
                acc = __builtin_amdgcn_mfma_f32_16x16x32_bf16(A, B, acc, 0, 0, 0);
            }
            const bf16_t* frow = FT + (size_t)(t * 16 + fr) * 128 + 8 * q;
#pragma unroll
            for (int kk = 0; kk < 4; ++kk) {
                const bf16x8 A = *(const bf16x8*)(frow + kk * 32);
                const bf16x8 B = *(const LAS bf16x8*)(XIN + fr * 136 + kk * 32 + 8 * q);
                acc = __builtin_amdgcn_mfma_f32_16x16x32_bf16(A, B, acc, 0, 0, 0);
            }
            const u32x2 uu = *(const LAS u32x2*)(lds + S5_UB_OFF + fr * 2064 + t * 32 + q * 8);
            float y0 = acc[0] + dval[0] * bf_lo(uu.x), y1 = acc[1] + dval[1] * bf_hi(uu.x), y2 = acc[2] + dval[2] * bf_lo(uu.y), y3 = acc[3] + dval[3] * bf_hi(uu.y);
            u32x2 o; o.x = cvt_pk_bf16(gelu_tanh(y0), gelu_tanh(y1)); o.y = cvt_pk_bf16(gelu_tanh(y2), gelu_tanh(y3));
            const int tok = batch * 1024 + fr * 64 + t;
            *(u32x2*)(YG + ((size_t)(b * 4096 + tok)) * 512 + g * 16 + 4 * q) = o;
        }
    }
    __syncthreads();
}

constexpr int AT_K_OFF = 0;
constexpr int AT_V_OFF = 9216;
constexpr int AT_IMP_OFF = 18432;
constexpr int AT_SEL_OFF = AT_IMP_OFF + 65536;
__device__ __forceinline__ void load_tile64(LAS unsigned char* buf, const bf16_t* src, size_t row0, int rowstride, int coloff, int tid) {
    const u32x4 v = *(const u32x4*)(src + (row0 + (tid >> 3)) * rowstride + coloff + (tid & 7) * 8);
    *(LAS u32x4*)(buf + (tid >> 3) * 144 + (tid & 7) * 16) = v;
}
__device__ __forceinline__ void qk_tile(const LAS unsigned char* kbuf, const bf16x8 (&bq)[4], int lane, f32x16 (&st)[2]) {
    const int r = lane & 31, hh = lane >> 5;
#pragma unroll
    for (int kt = 0; kt < 2; ++kt) {
        f32x16 a = {0.f, 0.f, 0.f, 0.f, 0.f, 0.f, 0.f, 0.f, 0.f, 0.f, 0.f, 0.f, 0.f, 0.f, 0.f, 0.f};
#pragma unroll
        for (int ks = 0; ks < 4; ++ks) {
            const bf16x8 kf = *(const LAS bf16x8*)(kbuf + (32 * kt + r) * 144 + (16 * ks + 8 * hh) * 2);
            a = __builtin_amdgcn_mfma_f32_32x32x16_bf16(kf, bq[ks], a, 0, 0, 0);
        }
        st[kt] = a;
    }
}
__device__ __forceinline__ void pv_tile(const LAS unsigned char* vbuf, const f32x16 (&p)[2], int lane, f32x16 (&o)[2]) {
    const int hh = lane >> 5, i = lane & 15, d0 = 16 * ((lane >> 4) & 1), qq = i >> 2, pp = i & 3;
#pragma unroll
    for (int kt = 0; kt < 2; ++kt)
#pragma unroll
        for (int s = 0; s < 2; ++s) {
            u32x4 pw; pw.x = cvt_pk_bf16(p[kt][8 * s + 0], p[kt][8 * s + 1]); pw.y = cvt_pk_bf16(p[kt][8 * s + 2], p[kt][8 * s + 3]);
            pw.z = cvt_pk_bf16(p[kt][8 * s + 4], p[kt][8 * s + 5]); pw.w = cvt_pk_bf16(p[kt][8 * s + 6], p[kt][8 * s + 7]);
            const bf16x8 pb = __builtin_bit_cast(bf16x8, pw);
            const int kb = 32 * kt + 16 * s + 4 * hh;
#pragma unroll
            for (int dt = 0; dt < 2; ++dt) {
                const LAS unsigned char* a0 = vbuf + (kb + qq) * 144 + (32 * dt + d0 + 4 * pp) * 2;
                const s16x4 v0 = __builtin_amdgcn_ds_read_tr16_b64_v4i16((LAS s16x4*)a0);
                const s16x4 v1 = __builtin_amdgcn_ds_read_tr16_b64_v4i16((LAS s16x4*)(a0 + 8 * 144));
                bf16x8 va; va[0] = v0[0]; va[1] = v0[1]; va[2] = v0[2]; va[3] = v0[3]; va[4] = v1[0]; va[5] = v1[1]; va[6] = v1[2]; va[7] = v1[3];
                o[dt] = __builtin_amdgcn_mfma_f32_32x32x16_bf16(va, pb, o[dt], 0, 0, 0);
            }
        }
}
template <bool WIN, int CM>
__device__ __forceinline__ float mask_scores(f32x16 (&st)[2], float fdl, float nslope2) {
    float mx = -3.0e38f;
#pragma unroll
    for (int kt = 0; kt < 2; ++kt)
#pragma unroll
        for (int reg = 0; reg < 16; ++reg) {
            const float distf = fdl - (float)(CM * (32 * kt + (reg & 3) + 8 * (reg >> 2)));
            float s2 = __builtin_fmaf(distf, nslope2, st[kt][reg]);
            if (WIN) { const float d = distf - __builtin_amdgcn_fmed3f(distf, 0.0f, 511.0f); s2 = __builtin_fmaf(-__builtin_fabsf(d), 3.0e38f, s2); }
            else s2 = __builtin_fmaf(__builtin_fminf(distf, 0.0f), 3.0e38f, s2);
            st[kt][reg] = s2; mx = fmaxf(mx, s2);
        }
    return fmaxf(mx, __shfl_xor(mx, 32));
}
template <bool WIN>
__device__ __forceinline__ void online_block(const LAS unsigned char* kbuf, const LAS unsigned char* vbuf, const bf16x8 (&bq)[4], int lane, float fdl, float nslope2,
                                             float& m, float& l, f32x16 (&o)[2]) {
    f32x16 st[2];
    qk_tile(kbuf, bq, lane, st);
    const float mx = mask_scores<WIN, 1>(st, fdl, nslope2);
    const float mn = fmaxf(m, mx), alpha = fast_exp2(m - mn); m = mn;
    float sum = 0.f;
#pragma unroll
    for (int kt = 0; kt < 2; ++kt)
#pragma unroll
        for (int reg = 0; reg < 16; ++reg) { const float pv = fast_exp2(st[kt][reg] - mn); st[kt][reg] = pv; sum += pv; }
    l = l * alpha + sum;
#pragma unroll
    for (int dt = 0; dt < 2; ++dt)
#pragma unroll
        for (int reg = 0; reg < 16; ++reg) o[dt][reg] *= alpha;
    pv_tile(vbuf, st, lane, o);
}
__device__ __forceinline__ void attn_item(const Params& P, LAS unsigned char* lds, int b, int g, int qt) {
    unsigned char* ws = P.ws;
    const int tid = threadIdx.x, lane = tid & 63, w = __builtin_amdgcn_readfirstlane(tid >> 6);
    const int r = w & 3, qhalf = w >> 2, hh = lane >> 5, ql = 32 * qhalf + (lane & 31);
    const int tq = 64 * qt + ql, hd = g * 4 + r;
    const size_t rowq = (size_t)b * 4096 + tq;
    const bf16_t* Qp = (const bf16_t*)(ws + WS_Q);
    const bf16_t* KVp = (const bf16_t*)(ws + WS_KV);
    const bf16_t* KC = (const bf16_t*)(ws + WS_KC) + (size_t)(b * 2 + g) * 256 * 64;
    const bf16_t* VC = (const bf16_t*)(ws + WS_VC) + (size_t)(b * 2 + g) * 256 * 64;
    const float* GT = (const float*)(ws + WS_GATES);
    LAS unsigned char* kbuf = lds + AT_K_OFF; LAS unsigned char* vbuf = lds + AT_V_OFF;
    LAS float* IMP = (LAS float*)(lds + AT_IMP_OFF);
    LAS unsigned long long* SEL = (LAS unsigned long long*)(lds + AT_SEL_OFF);
    bf16x8 bq[4];
#pragma unroll
    for (int ks = 0; ks < 4; ++ks) bq[ks] = *(const bf16x8*)(Qp + rowq * 512 + hd * 64 + 16 * ks + 8 * hh);
    const float nslope2 = -exp2f(-(float)(hd + 1)) * LOG2E;
    const float gc = ABL_NOCMP ? 0.f : GT[rowq * 24 + g * 12 + r * 3 + 0], gs = ABL_NOSLC ? 0.f : GT[rowq * 24 + g * 12 + r * 3 + 1], gw = ABL_NOWIN ? 0.f : GT[rowq * 24 + g * 12 + r * 3 + 2];
    f32x16 tot[2];
#pragma unroll
    for (int dt = 0; dt < 2; ++dt)
#pragma unroll
        for (int reg = 0; reg < 16; ++reg) tot[dt][reg] = 0.f;

    const int ncb = ((4 * qt + 2) >> 6) + 1;
    float m = -1e30f, l = 0.f;
    for (int cb = 0; cb < ncb; ++cb) {
        __syncthreads();
        load_tile64(kbuf, KC, (size_t)cb * 64, 64, 0, tid);
        __syncthreads();
        f32x16 st[2];
        qk_tile(kbuf, bq, lane, st);
        const int dl = tq - 31 - 1024 * cb - 64 * hh;
        const float mx = mask_scores<false, 16>(st, (float)dl, nslope2);
        const float mn = fmaxf(m, mx), alpha = fast_exp2(m - mn); m = mn;
        float sum = 0.f;
#pragma unroll
        for (int kt = 0; kt < 2; ++kt)
#pragma unroll
            for (int reg = 0; reg < 16; ++reg) sum += fast_exp2(st[kt][reg] - mn);
        l = l * alpha + sum;
    }
    {
        const float ltot = l + __shfl_xor(l, 32);
        const float inv = 1.0f / fmaxf(ltot, 1e-30f);
        f32x16 o[2];
#pragma unroll
        for (int dt = 0; dt < 2; ++dt)
#pragma unroll
            for (int reg = 0; reg < 16; ++reg) o[dt][reg] = 0.f;
        float carry = 0.f;
        for (int cb = 0; cb < 4; ++cb) {
            if (cb < ncb) {
                __syncthreads();
                load_tile64(kbuf, KC, (size_t)cb * 64, 64, 0, tid);
                load_tile64(vbuf, VC, (size_t)cb * 64, 64, 0, tid);
                __syncthreads();
                f32x16 st[2];
                qk_tile(kbuf, bq, lane, st);
                const int dl = tq - 31 - 1024 * cb - 64 * hh;
                (void)mask_scores<false, 16>(st, (float)dl, nslope2);
#pragma unroll
                for (int kt = 0; kt < 2; ++kt)
#pragma unroll
                    for (int reg = 0; reg < 16; ++reg) st[kt][reg] = fast_exp2(st[kt][reg] - m) * inv;
                float pv3[2][4];
#pragma unroll
                for (int kt = 0; kt < 2; ++kt)
#pragma unroll
                    for (int i = 0; i < 4; ++i) pv3[kt][i] = __shfl_xor(st[kt][4 * i + 3], 32);
#pragma unroll
                for (int kt = 0; kt < 2; ++kt)
#pragma unroll
                    for (int i = 0; i < 4; ++i) {
                        const float s4 = (st[kt][4 * i] + st[kt][4 * i + 1]) + (st[kt][4 * i + 2] + st[kt][4 * i + 3]);
                        const float prev0 = (i > 0) ? pv3[kt][i > 0 ? i - 1 : 0] : (kt > 0 ? pv3[0][3] : carry);
                        const float prev = hh ? pv3[kt][i] : prev0;
                        IMP[(r * 64 + ql) * 64 + 16 * cb + 8 * kt + 2 * i + hh] = s4 + prev;
                    }
                carry = pv3[1][3];
                pv_tile(vbuf, st, lane, o);
            } else {
#pragma unroll
                for (int kt = 0; kt < 2; ++kt)
#pragma unroll
                    for (int i = 0; i < 4; ++i) {
                        const float prev = (!hh && kt == 0 && i == 0) ? carry : 0.f;
                        IMP[(r * 64 + ql) * 64 + 16 * cb + 8 * kt + 2 * i + hh] = prev;
                    }
                carry = 0.f;
            }
        }
#pragma unroll
        for (int dt = 0; dt < 2; ++dt)
#pragma unroll
            for (int reg = 0; reg < 16; ++reg) tot[dt][reg] = gc * o[dt][reg];
    }
    __syncthreads();
    {
        const int cur = qt, j = lane;
        for (int qi = 0; qi < 8; ++qi) {
            const int qq = 8 * w + qi;
            const float sc = ((IMP[(0 * 64 + qq) * 64 + j] + IMP[(1 * 64 + qq) * 64 + j]) + IMP[(2 * 64 + qq) * 64 + j]) + IMP[(3 * 64 + qq) * 64 + j];
            const bool valid = j <= cur, forced = (j == 0) || (j == cur) || (j == cur - 1);
            const float key = forced ? 3.0e38f : (valid ? sc : -1.0f);
            int cnt = 0;
            for (int jp = 0; jp <= cur; ++jp) {
                const float sj = __uint_as_float(__builtin_amdgcn_readlane(__float_as_uint(key), jp));
                cnt += ((sj > key) || (sj == key && jp < j)) ? 1 : 0;
            }
            const unsigned long long msk = __ballot(valid && cnt < 16);
            if (lane == 0) SEL[qq] = msk;
        }
    }
    __syncthreads();
    const unsigned long long mymask = SEL[ql];
    unsigned long long uni = SEL[lane];
#pragma unroll
    for (int o_ = 1; o_ < 64; o_ <<= 1) uni |= __shfl_xor(uni, o_);
    const unsigned uni_lo = __builtin_amdgcn_readfirstlane((unsigned)uni), uni_hi = __builtin_amdgcn_readfirstlane((unsigned)(uni >> 32));
    {
        float ms = -1e30f, ls = 0.f; f32x16 o[2];
#pragma unroll
        for (int dt = 0; dt < 2; ++dt)
#pragma unroll
            for (int reg = 0; reg < 16; ++reg) o[dt][reg] = 0.f;
        const bf16_t* Ks = KVp + (size_t)2 * T_TOK * 128; const bf16_t* Vs = KVp + (size_t)3 * T_TOK * 128;
        for (int j = 0; j <= qt; ++j) {
            const unsigned bit = j < 32 ? (uni_lo >> j) & 1u : (uni_hi >> (j - 32)) & 1u;
            if (!bit) continue;
            __syncthreads();
            load_tile64(kbuf, Ks, (size_t)b * 4096 + 64 * j, 128, g * 64, tid);
            load_tile64(vbuf, Vs, (size_t)b * 4096 + 64 * j, 128, g * 64, tid);
            __syncthreads();
            const bool ok = (mymask >> j) & 1ull;
            online_block<false>(kbuf, vbuf, bq, lane, ok ? (float)(tq - 64 * j - 4 * hh) : -1.0e6f, nslope2, ms, ls, o);
        }
        const float ltot = ls + __shfl_xor(ls, 32); const float sc = gs / fmaxf(ltot, 1e-30f);
#pragma unroll
        for (int dt = 0; dt < 2; ++dt)
#pragma unroll
            for (int reg = 0; reg < 16; ++reg) tot[dt][reg] += sc * o[dt][reg];
    }
    {
        float mw = -1e30f, lw = 0.f; f32x16 o[2];
#pragma unroll
        for (int dt = 0; dt < 2; ++dt)
#pragma unroll
            for (int reg = 0; reg < 16; ++reg) o[dt][reg] = 0.f;
        const bf16_t* Kw = KVp + (size_t)4 * T_TOK * 128; const bf16_t* Vw = KVp + (size_t)5 * T_TOK * 128;
        const int j0 = qt - 8 > 0 ? qt - 8 : 0;
        for (int j = j0; j <= qt; ++j) {
            __syncthreads();
            load_tile64(kbuf, Kw, (size_t)b * 4096 + 64 * j, 128, g * 64, tid);
            load_tile64(vbuf, Vw, (size_t)b * 4096 + 64 * j, 128, g * 64, tid);
            __syncthreads();
            online_block<true>(kbuf, vbuf, bq, lane, (float)(tq - 64 * j - 4 * hh), nslope2, mw, lw, o);
        }
        const float ltot = lw + __shfl_xor(lw, 32); const float sc = gw / fmaxf(ltot, 1e-30f);
#pragma unroll
        for (int dt = 0; dt < 2; ++dt)
#pragma unroll
            for (int reg = 0; reg < 16; ++reg) tot[dt][reg] += sc * o[dt][reg];
    }
    {
        bf16_t* O = (bf16_t*)(ws + WS_O) + rowq * 512 + hd * 64;
#pragma unroll
        for (int dt = 0; dt < 2; ++dt)
#pragma unroll
            for (int rg = 0; rg < 4; ++rg) {
                u32x2 v; v.x = cvt_pk_bf16(tot[dt][4 * rg], tot[dt][4 * rg + 1]); v.y = cvt_pk_bf16(tot[dt][4 * rg + 2], tot[dt][4 * rg + 3]);
                *(u32x2*)(O + 32 * dt + 8 * rg + 4 * hh) = v;
            }
    }
    __syncthreads();
}

__device__ __forceinline__ unsigned f2ord(float f) { const unsigned u = __float_as_uint(f); return u ^ ((unsigned)((int)u >> 31) | 0x80000000u); }
__device__ __forceinline__ float ord2f(unsigned o) { const unsigned u = (o & 0x80000000u) ? (o ^ 0x80000000u) : ~o; return __uint_as_float(u); }
__device__ __forceinline__ void ins16(unsigned (&L)[16], unsigned x) {
#pragma unroll
    for (int i = 0; i < 16; ++i) { const unsigned hi = L[i] > x ? L[i] : x; x = L[i] > x ? x : L[i]; L[i] = hi; }
}
__device__ __forceinline__ void peer_score_item(const Params& P, LAS unsigned char* lds, int item, int w, int lane) {
    unsigned char* ws = P.ws;
    const int t0 = (item >> 3) * 32, h = item & 7, r = lane & 31, hh = lane >> 5;
    const bf16_t* QP = (const bf16_t*)(ws + WS_QP);
    const bf16_t* SK = (const bf16_t*)(ws + WS_SUBK);
    LAS unsigned char* IDX = lds + w * 1024;
    unsigned Lc[2][16];
#pragma unroll
    for (int c = 0; c < 2; ++c) {
        bf16x8 bq[4];
#pragma unroll
        for (int ks = 0; ks < 4; ++ks) bq[ks] = *(const bf16x8*)(QP + (size_t)(t0 + r) * 1024 + h * 128 + c * 64 + 16 * ks + 8 * hh);
        unsigned L[16];
#pragma unroll
        for (int i = 0; i < 16; ++i) L[i] = 0u;
#pragma unroll
        for (int kt = 0; kt < 4; ++kt) {
            f32x16 a = {0.f, 0.f, 0.f, 0.f, 0.f, 0.f, 0.f, 0.f, 0.f, 0.f, 0.f, 0.f, 0.f, 0.f, 0.f, 0.f};
#pragma unroll
            for (int ks = 0; ks < 4; ++ks) {
                const bf16x8 kf = *(const bf16x8*)(SK + ((size_t)((h * 2 + c) * 128 + 32 * kt + r)) * 64 + 16 * ks + 8 * hh);
                a = __builtin_amdgcn_mfma_f32_32x32x16_bf16(kf, bq[ks], a, 0, 0, 0);
            }
#pragma unroll
            for (int reg = 0; reg < 16; ++reg) {
                const int key0 = 32 * kt + 8 * (reg >> 2) + (reg & 3);
                const unsigned low = (unsigned)(127 ^ key0) ^ (unsigned)(4 * hh);
                ins16(L, (f2ord(a[reg]) & ~127u) | low);
            }
        }
        unsigned tmp[16];
#pragma unroll
        for (int i = 0; i < 16; ++i) tmp[i] = __shfl_xor(L[i], 32);
#pragma unroll
        for (int i = 0; i < 16; ++i) ins16(L, tmp[i]);
#pragma unroll
        for (int i = 0; i < 16; ++i) Lc[c][i] = L[i];
        if (hh == 0) {
#pragma unroll
            for (int i = 0; i < 16; ++i) IDX[(r * 2 + c) * 16 + i] = (unsigned char)(127u - (L[i] & 127u));
        }
    }
    unsigned best[16];
#pragma unroll
    for (int i = 0; i < 16; ++i) best[i] = 0u;
#pragma unroll
    for (int i = 0; i < 16; ++i) {
        const float v0 = ord2f(Lc[0][i] & ~127u);
#pragma unroll
        for (int j = 0; j < 16; ++j) {
            if ((i + 1) * (j + 1) <= 16) {
                const float s = v0 + ord2f(Lc[1][j] & ~127u);
                ins16(best, (f2ord(s) & ~255u) | (unsigned)(255 - (i * 16 + j)));
            }
        }
    }
    const float mv = ord2f(best[0] & ~255u);
    float e[16], sum = 0.f;
#pragma unroll
    for (int k = 0; k < 16; ++k) { e[k] = fast_exp2((ord2f(best[k] & ~255u) - mv) * LOG2E); sum += e[k]; }
    const float inv = 1.0f / sum;
    asm volatile("s_waitcnt lgkmcnt(0)" ::: "memory");
    if (hh == 0) {
        u32x2* out = (u32x2*)(ws + WS_PK) + ((size_t)(t0 + r) * 8 + h) * 16;
#pragma unroll
        for (int k = 0; k < 16; ++k) {
            const unsigned flat = 255u - (best[k] & 255u); const unsigned i = flat >> 4, j = flat & 15u;
            const unsigned e0 = IDX[(r * 2 + 0) * 16 + i], e1 = IDX[(r * 2 + 1) * 16 + j];
            u32x2 v; v.x = e0 * 128u + e1; v.y = __float_as_uint(e[k] * inv); out[k] = v;
        }
    }
}

__device__ __forceinline__ void peer_token(const Params& P, int tok, int lane, float* outbase) {
    unsigned char* ws = P.ws;
    float* X1 = P.out + (size_t)tok * 1024 + lane * 16;
    const f32x4 xa = ((const f32x4*)X1)[0], xb = ((const f32x4*)X1)[1], xc = ((const f32x4*)X1)[2], xd = ((const f32x4*)X1)[3];
    float xr[16] = {xa[0], xa[1], xa[2], xa[3], xb[0], xb[1], xb[2], xb[3], xc[0], xc[1], xc[2], xc[3], xd[0], xd[1], xd[2], xd[3]};
    h16x2 xh[8];
#pragma unroll
    for (int i = 0; i < 8; ++i) { xh[i].x = (_Float16)xr[2 * i]; xh[i].y = (_Float16)xr[2 * i + 1]; }
    const u32x2* pk = (const u32x2*)(ws + WS_PK) + (size_t)tok * 128;
    const u32x2 p0 = pk[lane], p1 = pk[64 + lane];
    const unsigned char* UT = ws + WS_UTAB + lane * 32; const unsigned char* VT = ws + WS_VTAB + lane * 32;
    float h0 = 0.f, h1 = 0.f;
    for (int k = 0; k < 128; k += 2) {
        const unsigned ea = __builtin_amdgcn_readlane(k < 64 ? p0.x : p1.x, k & 63), eb = __builtin_amdgcn_readlane(k < 64 ? p0.x : p1.x, (k + 1) & 63);
        const u32x4 a0 = *(const u32x4*)(UT + (size_t)ea * 2048), a1 = *(const u32x4*)(UT + (size_t)ea * 2048 + 16);
        const u32x4 b0 = *(const u32x4*)(UT + (size_t)eb * 2048), b1 = *(const u32x4*)(UT + (size_t)eb * 2048 + 16);
        float da = 0.f, db = 0.f;
        {
            const unsigned aw[8] = {a0.x, a0.y, a0.z, a0.w, a1.x, a1.y, a1.z, a1.w}, bw[8] = {b0.x, b0.y, b0.z, b0.w, b1.x, b1.y, b1.z, b1.w};
#pragma unroll
            for (int i = 0; i < 8; ++i) {
                const h16x2 va = __builtin_bit_cast(h16x2, aw[i]), vb = __builtin_bit_cast(h16x2, bw[i]);
                da = __builtin_fmaf((float)va.x, xr[2 * i], da); da = __builtin_fmaf((float)va.y, xr[2 * i + 1], da);
                db = __builtin_fmaf((float)vb.x, xr[2 * i], db); db = __builtin_fmaf((float)vb.y, xr[2 * i + 1], db);
            }
        }
        da = wave_sum(da); db = wave_sum(db);
        if (k < 64) { h0 = (lane == k) ? da : h0; h0 = (lane == k + 1) ? db : h0; } else { h1 = (lane == k - 64) ? da : h1; h1 = (lane == k - 63) ? db : h1; }
    }
        const float w0 = __uint_as_float(p0.y) * (ABL_NOH ? 1.f : gelu_tanh(h0)), w1 = __uint_as_float(p1.y) * (ABL_NOH ? 1.f : gelu_tanh(h1));
    float acc[16];
#pragma unroll
    for (int i = 0; i < 16; ++i) acc[i] = 0.f;
    for (int k = 0; k < 128; k += 2) {
        const unsigned ea = __builtin_amdgcn_readlane(k < 64 ? p0.x : p1.x, k & 63), eb = __builtin_amdgcn_readlane(k < 64 ? p0.x : p1.x, (k + 1) & 63);
        const float wa = __uint_as_float(__builtin_amdgcn_readlane(__float_as_uint(k < 64 ? w0 : w1), k & 63)), wb = __uint_as_float(__builtin_amdgcn_readlane(__float_as_uint(k < 64 ? w0 : w1), (k + 1) & 63));
        const u32x4 a0 = *(const u32x4*)(VT + (size_t)ea * 2048), a1 = *(const u32x4*)(VT + (size_t)ea * 2048 + 16);
        const u32x4 b0 = *(const u32x4*)(VT + (size_t)eb * 2048), b1 = *(const u32x4*)(VT + (size_t)eb * 2048 + 16);
        const unsigned aw[8] = {a0.x, a0.y, a0.z, a0.w, a1.x, a1.y, a1.z, a1.w}, bw[8] = {b0.x, b0.y, b0.z, b0.w, b1.x, b1.y, b1.z, b1.w};
#pragma unroll
        for (int i = 0; i < 8; ++i) {
            const h16x2 va = __builtin_bit_cast(h16x2, aw[i]), vb = __builtin_bit_cast(h16x2, bw[i]);
            acc[2 * i] = __builtin_fmaf((float)va.x, wa, acc[2 * i]); acc[2 * i + 1] = __builtin_fmaf((float)va.y, wa, acc[2 * i + 1]);
            acc[2 * i] = __builtin_fmaf((float)vb.x, wb, acc[2 * i]); acc[2 * i + 1] = __builtin_fmaf((float)vb.y, wb, acc[2 * i + 1]);
        }
    }
    float s = 0.f;
#pragma unroll
    for (int i = 0; i < 16; ++i) { acc[i] = DN_ALPHA * xr[i] + (ABL_NOPEER ? 0.f : acc[i]); s += acc[i]; }
    const float mean = wave_sum(s) * (1.0f / 1024.0f); float s2 = 0.f;
#pragma unroll
    for (int i = 0; i < 16; ++i) { acc[i] -= mean; s2 += acc[i] * acc[i]; }
    const float rstd = 1.0f / sqrtf(wave_sum(s2) * (1.0f / 1024.0f) + LN_EPS);
    const float* g2 = P.in[27] + lane * 16; const float* b2 = P.in[28] + lane * 16;
#pragma unroll
    for (int i = 0; i < 4; ++i) {
        const f32x4 gg = ((const f32x4*)g2)[i], bb = ((const f32x4*)b2)[i]; f32x4 o;
#pragma unroll
        for (int j = 0; j < 4; ++j) o[j] = acc[4 * i + j] * rstd * gg[j] + bb[j];
        ((f32x4*)(outbase + (size_t)tok * 1024 + lane * 16))[i] = o;
    }
}


__device__ __forceinline__ float dpp_add(float v, const int ctrl_sel) {
    const int b = __float_as_int(v); int r;
    if (ctrl_sel == 0) r = __builtin_amdgcn_update_dpp(0, b, 0xB1, 0xf, 0xf, false);
    else if (ctrl_sel == 1) r = __builtin_amdgcn_update_dpp(0, b, 0x4E, 0xf, 0xf, false);
    else if (ctrl_sel == 2) r = __builtin_amdgcn_update_dpp(0, b, 0x141, 0xf, 0xf, false);
    else if (ctrl_sel == 3) r = __builtin_amdgcn_update_dpp(0, b, 0x140, 0xf, 0xf, false);
    else if (ctrl_sel == 4) r = __builtin_amdgcn_update_dpp(0, b, 0x142, 0xa, 0xf, false);
    else r = __builtin_amdgcn_update_dpp(0, b, 0x143, 0xc, 0xf, false);
    return v + __int_as_float(r);
}
__device__ __forceinline__ float wave_total(float v) {
    v = dpp_add(v, 0); v = dpp_add(v, 1); v = dpp_add(v, 2); v = dpp_add(v, 3); v = dpp_add(v, 4); v = dpp_add(v, 5);
    return __int_as_float(__builtin_amdgcn_readlane(__float_as_int(v), 63));
}
__device__ __forceinline__ float dot16_h(const u32x4& a0, const u32x4& a1, const h16x2 (&x)[8]) {
    const unsigned aw[8] = {a0.x, a0.y, a0.z, a0.w, a1.x, a1.y, a1.z, a1.w}; float d = 0.f;
#pragma unroll
    for (int i = 0; i < 8; ++i) { const h16x2 va = __builtin_bit_cast(h16x2, aw[i]); d = __builtin_fmaf((float)va.x, (float)x[i].x, d); d = __builtin_fmaf((float)va.y, (float)x[i].y, d); }
    return d;
}
__device__ __forceinline__ void axpy16_h(const u32x4& a0, const u32x4& a1, float w, float (&acc)[16]) {
    const unsigned aw[8] = {a0.x, a0.y, a0.z, a0.w, a1.x, a1.y, a1.z, a1.w};
#pragma unroll
    for (int i = 0; i < 8; ++i) { const h16x2 va = __builtin_bit_cast(h16x2, aw[i]); acc[2 * i] = __builtin_fmaf((float)va.x, w, acc[2 * i]); acc[2 * i + 1] = __builtin_fmaf((float)va.y, w, acc[2 * i + 1]); }
}
__device__ __forceinline__ void peer_round(const Params& P, LAS unsigned char* wl, int tok0, int lane) {
    unsigned char* ws = P.ws;
    LAS u32x2* sorted = (LAS u32x2*)wl;
    LAS unsigned* cnt = (LAS unsigned*)(wl + 4096);
    LAS unsigned* off = (LAS unsigned*)(wl + 4096 + 256);
    LAS unsigned char* xl = wl + 4608;
#pragma unroll
    for (int t = 0; t < 4; ++t) {
        const f32x4* X1 = (const f32x4*)(P.out + (size_t)(tok0 + t) * 1024 + lane * 16);
        const f32x4 v0 = X1[0], v1 = X1[1], v2 = X1[2], v3 = X1[3];
        u32x4 w0, w1; w0.x = pack_h2(v0[0], v0[1]); w0.y = pack_h2(v0[2], v0[3]); w0.z = pack_h2(v1[0], v1[1]); w0.w = pack_h2(v1[2], v1[3]);
        w1.x = pack_h2(v2[0], v2[1]); w1.y = pack_h2(v2[2], v2[3]); w1.z = pack_h2(v3[0], v3[1]); w1.w = pack_h2(v3[2], v3[3]);
        *(LAS u32x4*)(xl + t * 2048 + lane * 32) = w0; *(LAS u32x4*)(xl + t * 2048 + lane * 32 + 16) = w1;
    }
    cnt[lane] = 0u;
    __builtin_amdgcn_fence(__ATOMIC_RELEASE, "wavefront"); __builtin_amdgcn_wave_barrier();
    const u32x2* pk = (const u32x2*)(ws + WS_PK) + (size_t)tok0 * 128;
    u32x2 pv[8]; unsigned pos[8];
#pragma unroll
    for (int m = 0; m < 8; ++m) { pv[m] = pk[m * 64 + lane]; pos[m] = __hip_atomic_fetch_add(&cnt[pv[m].x >> 8], 1u, __ATOMIC_RELAXED, __HIP_MEMORY_SCOPE_WAVEFRONT); }
    __builtin_amdgcn_fence(__ATOMIC_ACQ_REL, "wavefront"); __builtin_amdgcn_wave_barrier();
    {
        const unsigned c = cnt[lane]; unsigned sfx = c;
#pragma unroll
        for (int o = 1; o < 64; o <<= 1) { const unsigned t = __shfl_up(sfx, o); if (lane >= o) sfx += t; }
        off[lane] = sfx - c;
    }
    __builtin_amdgcn_fence(__ATOMIC_ACQ_REL, "wavefront"); __builtin_amdgcn_wave_barrier();
#pragma unroll
    for (int m = 0; m < 8; ++m) { const unsigned dst = off[pv[m].x >> 8] + pos[m]; u32x2 e; e.x = pv[m].x | ((unsigned)(m >> 1) << 14); e.y = pv[m].y; sorted[dst] = e; }
    __builtin_amdgcn_fence(__ATOMIC_ACQ_REL, "wavefront"); __builtin_amdgcn_wave_barrier();
    const unsigned char* UT = ws + WS_UTAB + lane * 32; const unsigned char* VT = ws + WS_VTAB + lane * 32;
#pragma nounroll
    for (int b = 0; b < 8; ++b) {
        const u32x2 sp = sorted[b * 64 + lane];
        float hv = 0.f;
#pragma nounroll
        for (int k = 0; k < 64; k += 4) {
            unsigned ev[4]; u32x4 a0[4], a1[4];
#pragma unroll
            for (int j = 0; j < 4; ++j) { ev[j] = (unsigned)__builtin_amdgcn_readlane((int)sp.x, k + j); const unsigned char* row = UT + (size_t)(ev[j] & 0x3fffu) * 2048; a0[j] = *(const u32x4*)row; a1[j] = *(const u32x4*)(row + 16); }
            float pt[4];
#pragma unroll
            for (int j = 0; j < 4; ++j) {
                const unsigned tau = ev[j] >> 14;
                const u32x4 x0 = *(const LAS u32x4*)(xl + tau * 2048 + lane * 32), x1 = *(const LAS u32x4*)(xl + tau * 2048 + lane * 32 + 16);
                const unsigned xw[8] = {x0.x, x0.y, x0.z, x0.w, x1.x, x1.y, x1.z, x1.w};
                h16x2 xs[8];
#pragma unroll
                for (int i = 0; i < 8; ++i) xs[i] = __builtin_bit_cast(h16x2, xw[i]);
                pt[j] = dot16_h(a0[j], a1[j], xs);
            }
#pragma unroll
            for (int j = 0; j < 4; ++j) { const float tot = wave_total(pt[j]); hv = (lane == k + j) ? tot : hv; }
        }
        u32x2 nw = sp; nw.y = __float_as_uint(__uint_as_float(sp.y) * gelu_tanh(hv)); sorted[b * 64 + lane] = nw;
    }
    __builtin_amdgcn_fence(__ATOMIC_ACQ_REL, "wavefront"); __builtin_amdgcn_wave_barrier();
    float acc[4][16];
#pragma unroll
    for (int t = 0; t < 4; ++t)
#pragma unroll
        for (int i = 0; i < 16; ++i) acc[t][i] = 0.f;
#pragma nounroll
    for (int b = 0; b < 8; ++b) {
        const u32x2 sp = sorted[b * 64 + lane];
#pragma nounroll
        for (int k = 0; k < 64; k += 4) {
            unsigned ev[4]; float wv[4]; u32x4 a0[4], a1[4];
#pragma unroll
            for (int j = 0; j < 4; ++j) { ev[j] = (unsigned)__builtin_amdgcn_readlane((int)sp.x, k + j); wv[j] = __uint_as_float((unsigned)__builtin_amdgcn_readlane((int)sp.y, k + j));
                const unsigned char* row = VT + (size_t)(ev[j] & 0x3fffu) * 2048; a0[j] = *(const u32x4*)row; a1[j] = *(const u32x4*)(row + 16); }
#pragma unroll
            for (int j = 0; j < 4; ++j) {
                const unsigned tau = ev[j] >> 14;
                const float w0 = tau == 0u ? wv[j] : 0.f, w1 = tau == 1u ? wv[j] : 0.f, w2 = tau == 2u ? wv[j] : 0.f, w3 = tau == 3u ? wv[j] : 0.f;
                const unsigned aw[8] = {a0[j].x, a0[j].y, a0[j].z, a0[j].w, a1[j].x, a1[j].y, a1[j].z, a1[j].w};
#pragma unroll
                for (int i = 0; i < 8; ++i) {
                    const h16x2 va = __builtin_bit_cast(h16x2, aw[i]); const float vx = (float)va.x, vy = (float)va.y;
                    acc[0][2 * i] = __builtin_fmaf(vx, w0, acc[0][2 * i]); acc[0][2 * i + 1] = __builtin_fmaf(vy, w0, acc[0][2 * i + 1]);
                    acc[1][2 * i] = __builtin_fmaf(vx, w1, acc[1][2 * i]); acc[1][2 * i + 1] = __builtin_fmaf(vy, w1, acc[1][2 * i + 1]);
                    acc[2][2 * i] = __builtin_fmaf(vx, w2, acc[2][2 * i]); acc[2][2 * i + 1] = __builtin_fmaf(vy, w2, acc[2][2 * i + 1]);
                    acc[3][2 * i] = __builtin_fmaf(vx, w3, acc[3][2 * i]); acc[3][2 * i + 1] = __builtin_fmaf(vy, w3, acc[3][2 * i + 1]);
                }
            }
        }
    }
    const float* g2 = P.in[27] + lane * 16; const float* b2 = P.in[28] + lane * 16;
#pragma unroll
    for (int t = 0; t < 4; ++t) {
        float* X1 = P.out + (size_t)(tok0 + t) * 1024 + lane * 16;
        float s = 0.f;
#pragma unroll
        for (int i = 0; i < 4; ++i) { const f32x4 v = ((const f32x4*)X1)[i];
#pragma unroll
            for (int j = 0; j < 4; ++j) { acc[t][4 * i + j] = DN_ALPHA * v[j] + (ABL_NOPEER ? 0.f : acc[t][4 * i + j]); s += acc[t][4 * i + j]; } }
        const float mean = wave_total(s) * (1.0f / 1024.0f); float s2 = 0.f;
#pragma unroll
        for (int i = 0; i < 16; ++i) { acc[t][i] -= mean; s2 += acc[t][i] * acc[t][i]; }
        const float rstd = 1.0f / sqrtf(wave_total(s2) * (1.0f / 1024.0f) + LN_EPS);
#pragma unroll
        for (int i = 0; i < 4; ++i) {
            const f32x4 gg = ((const f32x4*)g2)[i], bb = ((const f32x4*)b2)[i]; f32x4 o;
#pragma unroll
            for (int j = 0; j < 4; ++j) o[j] = acc[t][4 * i + j] * rstd * gg[j] + bb[j];
            ((f32x4*)X1)[i] = o;
        }
    }
}

#define XB_TMO      128
#define XB_XCNT(j)  (256  + 64 * (j))
#define XB_XSUB(j)  (1280 + 64 * (j))
#define XB_XGEN(j)  (2304 + 64 * (j))
#define XB_TOP      3328
#define XB_TOPGEN   3392
#define XCD_BAR_WORDS 3456
#define XB_SPIN_CAP (1u << 24)
__device__ __forceinline__ unsigned xb_ld(unsigned* p)              { return __hip_atomic_load(p, __ATOMIC_RELAXED, __HIP_MEMORY_SCOPE_AGENT); }
__device__ __forceinline__ unsigned xb_add(unsigned* p, unsigned v) { return __hip_atomic_fetch_add(p, v, __ATOMIC_RELAXED, __HIP_MEMORY_SCOPE_AGENT); }
__device__ __forceinline__ unsigned xb_xcc_id() { return (unsigned)__builtin_amdgcn_s_getreg((3 << 11) | 20) & 0xFu; }
#define XB_SPIN(cond, bar) do { unsigned _sp = 0; while (cond) { __builtin_amdgcn_s_sleep(1); \
    if ((++_sp & 255u) == 0u) { if (xb_ld(&(bar)[XB_TMO])) break; if (_sp > XB_SPIN_CAP) { atomicAdd(&(bar)[XB_TMO], 1u); break; } } } } while (0)
struct XcdBarrier { unsigned* bar; unsigned x; volatile LAS unsigned* st; };
__device__ __forceinline__ XcdBarrier xcd_barrier_post(unsigned* bar, volatile LAS unsigned* st) {
    XcdBarrier b; b.bar = bar; b.x = xb_xcc_id(); b.st = st;
    if (threadIdx.x == 0) (void)xb_add(&bar[XB_XCNT(b.x)], 1u);
    return b;
}
__device__ __forceinline__ void xcd_barrier_complete(unsigned* bar, unsigned x, unsigned& nloc, unsigned& nx) {
    const unsigned G = gridDim.x * gridDim.y * gridDim.z;
    unsigned sum, cnt, mine, sp = 0u;
    for (;;) {
        sum = 0u; cnt = 0u; mine = 0u;
#pragma unroll
        for (unsigned j = 0; j < 16; ++j) { const unsigned c = xb_ld(&bar[XB_XCNT(j)]); sum += c; cnt += (c > 0u) ? 1u : 0u; mine = (j == x) ? c : mine; }
        if (sum == G) break;
        __builtin_amdgcn_s_sleep(1);
        if ((++sp & 255u) == 0u) { if (xb_ld(&bar[XB_TMO])) break; if (sp > XB_SPIN_CAP) { atomicAdd(&bar[XB_TMO], 1u); break; } }
    }
    nloc = mine > 0u ? mine : 1u; nx = cnt > 0u ? cnt : 1u;
}
__device__ __forceinline__ void xcd_barrier(const XcdBarrier& b) {
    asm volatile("s_waitcnt vmcnt(0)" ::: "memory");
    __syncthreads();
    if (threadIdx.x == 0) {
        unsigned* bar = b.bar;
        __builtin_amdgcn_s_waitcnt(0);
        unsigned nloc = b.st[0], nx = b.st[1];
        if (nloc == 0u) { xcd_barrier_complete(bar, b.x, nloc, nx); b.st[0] = nloc; b.st[1] = nx; }
        const unsigned old = xb_add(&bar[XB_XSUB(b.x)], 1u);
        const unsigned gen = old / nloc;
        if (old + 1u == (gen + 1u) * nloc) {
            __builtin_amdgcn_fence(__ATOMIC_RELEASE, "agent");
            asm volatile("s_waitcnt vmcnt(0)" ::: "memory");
            const unsigned og = xb_add(&bar[XB_TOP], 1u);
            const unsigned tg = og / nx;
            if (og + 1u == (tg + 1u) * nx) xb_add(&bar[XB_TOPGEN], 1u);
            else XB_SPIN(xb_ld(&bar[XB_TOPGEN]) == tg, bar);
            __builtin_amdgcn_fence(__ATOMIC_ACQUIRE, "agent");
            xb_add(&bar[XB_XGEN(b.x)], 1u);
            asm volatile("s_waitcnt vmcnt(0)" ::: "memory");
        } else {
            XB_SPIN(xb_ld(&bar[XB_XGEN(b.x)]) == gen, bar);
            __builtin_amdgcn_fence(__ATOMIC_ACQUIRE, "agent");
            asm volatile("s_waitcnt vmcnt(0)" ::: "memory");
        }
    }
    __syncthreads();
}

__device__ __forceinline__ int next_item(unsigned* ctr, LAS int* slot) {
    __syncthreads();
    if (threadIdx.x == 0) *slot = (int)atomicAdd(ctr, 1u);
    __syncthreads();
    return __builtin_amdgcn_readfirstlane(*slot);
}


#ifdef CHECK_PEER
__device__ __forceinline__ void check_peer(const Params& P, LAS unsigned char* lds, unsigned* ctl) {
    unsigned char* ws = P.ws;
    const int tid = threadIdx.x;
    const bf16_t* QP = (const bf16_t*)(ws + WS_QP); const bf16_t* SK = (const bf16_t*)(ws + WS_SUBK);
    const u32x2* PK = (const u32x2*)(ws + WS_PK);
    unsigned bad_e = 0, bad_g = 0;
    if (tid < 64) {
        LAS float* sc = (LAS float*)lds + tid * 257;
        LAS float* sv = (LAS float*)(lds + 64 * 257 * 4) + tid * 33;
        LAS int* si = (LAS int*)(lds + 64 * 257 * 4 + 64 * 33 * 4) + tid * 33;
        for (int pair = blockIdx.x * 64 + tid; pair < T_TOK * 8; pair += gridDim.x * 64) {
            const int t = pair >> 3, h = pair & 7;
            for (int c = 0; c < 2; ++c)
                for (int k = 0; k < 128; ++k) {
                    float a = 0.f;
                    for (int d = 0; d < 64; ++d) a += bf2f(QP[(size_t)t * 1024 + h * 128 + c * 64 + d]) * bf2f(SK[((size_t)((h * 2 + c) * 128 + k)) * 64 + d]);
                    sc[c * 128 + k] = a;
                }
            for (int c = 0; c < 2; ++c) {
                float pv = 3.0e38f; int pi = -1;
                for (int r = 0; r < 16; ++r) {
                    float bv = -3.0e38f; int bi = -1;
                    for (int k = 0; k < 128; ++k) { const float v = sc[c * 128 + k]; const bool after = (v < pv) || (v == pv && k > pi); if (after && (v > bv)) { bv = v; bi = k; } }
                    sv[c * 16 + r] = bv; si[c * 16 + r] = bi; pv = bv; pi = bi;
                }
            }
            float pv = 3.0e38f; int pi = -1; float best[16]; int bexp[16];
            float mv = 0.f, sum = 0.f;
            for (int r = 0; r < 16; ++r) {
                float bv = -3.0e38f; int bi = -1;
                for (int f = 0; f < 256; ++f) { const float v = sv[f >> 4] + sv[16 + (f & 15)]; const bool after = (v < pv) || (v == pv && f > pi); if (after && (v > bv)) { bv = v; bi = f; } }
                pv = bv; pi = bi;
                const int e = si[bi >> 4] * 128 + si[16 + (bi & 15)];
                if (r == 0) mv = bv;
                const float ev = expf(bv - mv); sum += ev;
                bool found = false; float gpk = 0.f;
                for (int k = 0; k < 16; ++k) { const u32x2 q = PK[(size_t)pair * 16 + k]; if ((int)q.x == e) { found = true; gpk = __uint_as_float(q.y); } }
                if (!found) ++bad_e;
                sc[r] = ev; sc[16 + r] = found ? gpk : -1.f;
            }
            for (int r = 0; r < 16; ++r) { const float gref = sc[r] / sum, gpk = sc[16 + r]; if (gpk >= 0.f && fabsf(gref - gpk) > 0.02f) ++bad_g; }
        }
    }
    if (bad_e) atomicAdd(ctl + 300, bad_e);
    if (bad_g) atomicAdd(ctl + 301, bad_g);
}
#endif

#ifdef CHECK_PROJ
__device__ __forceinline__ void check_proj(const Params& P, unsigned* ctl) {
    unsigned char* ws = P.ws;
    const float* x = P.in[0]; const float* w = P.in[1]; const float* bi = P.in[2];
    const int gtid = blockIdx.x * 512 + threadIdx.x, NT = gridDim.x * 512;
    unsigned bad[5] = {0, 0, 0, 0, 0};
    const int nrows = 128;
    for (int i = gtid; i < nrows * INC; i += NT) {
        const int col = i % INC, row = (i / INC) * 127 + 5;
        float a = bi[col];
        for (int k = 0; k < 1024; ++k) a += x[(size_t)row * 1024 + k] * w[(size_t)k * INC + col];
        float got, ref; int cat;
        if (col < 512) { const int b = row >> 12, sq = row & 4095, g = col >> 4, hp = col & 15; got = bf2f(((const bf16_t*)(ws + WS_UG))[((size_t)((b * 32 + g) * 4096 + sq)) * 16 + hp]); ref = a; cat = 0; }
        else if (col < 1024) { got = bf2f(((const bf16_t*)(ws + WS_Q))[(size_t)row * 512 + col - 512]); ref = a * 0.125f * LOG2E; cat = 1; }
        else if (col < 1792) { const int idx = (col - 1024) >> 7, cc = (col - 1024) & 127; got = bf2f(((const bf16_t*)(ws + WS_KV))[((size_t)idx * T_TOK + row) * 128 + cc]); ref = a; cat = 2; }
        else if (col < 1816) { got = ((const float*)(ws + WS_GATES))[(size_t)row * 24 + col - 1792]; ref = 1.f / (1.f + expf(-a)); cat = 3; }
        else { got = bf2f(((const bf16_t*)P.out)[(size_t)row * 2048 + col - 1816]); ref = 1.f / (1.f + expf(-a)); cat = 4; }
        if (!(fabsf(got - ref) <= 0.04f + 0.02f * fabsf(ref))) ++bad[cat];
    }
    for (int c = 0; c < 5; ++c) if (bad[c]) atomicAdd(ctl + 300 + c, bad[c]);
}
#endif

#ifdef CHECK_S5
__device__ __forceinline__ void check_s5(const Params& P, LAS unsigned char* lds, unsigned* ctl) {
    unsigned char* ws = P.ws;
    if (blockIdx.x >= 16) return;
    const int tid = threadIdx.x, b = blockIdx.x & 3, g = (blockIdx.x * 7 + 3) & 31;
    const float* a_re = P.in[3]; const float* a_im = P.in[4]; const float* log_dt = P.in[5]; const float* b_re = P.in[6]; const float* b_im = P.in[7]; const float* c_re = P.in[8]; const float* c_im = P.in[9]; const float* dsk = P.in[10];
    LAS float* part = (LAS float*)lds;
    const bf16_t* UGp = (const bf16_t*)(ws + WS_UG) + ((size_t)(b * 32 + g) * 4096) * 16;
    const bf16_t* YG = (const bf16_t*)(ws + WS_YG);
    const int p = tid & 63;
    const float dt = expf(log_dt[g]); const float are = a_re[g * 64 + p], aim = a_im[g * 64 + p];
    const cpx lb = lam_pow(are, aim, dt, 1.0f); const cpx cf = bbar_coef(are, aim, dt);
    float bbr[16], bbi[16], cr[16], ci[16];
    for (int j = 0; j < 16; ++j) { const cpx bb = cmul(cf, cpx{b_re[(g * 64 + p) * 16 + j], b_im[(g * 64 + p) * 16 + j]}); bbr[j] = bb.re; bbi[j] = bb.im; cr[j] = c_re[(g * 16 + j) * 64 + p]; ci[j] = c_im[(g * 16 + j) * 64 + p]; }
    float xr = 0.f, xi = 0.f; unsigned bad = 0;
    for (int sq = 0; sq < 4096; ++sq) {
        float u[16];
        for (int j = 0; j < 16; ++j) u[j] = bf2f(UGp[(size_t)sq * 16 + j]);
        float br = 0.f, bim = 0.f;
        for (int j = 0; j < 16; ++j) { br += bbr[j] * u[j]; bim += bbi[j] * u[j]; }
        const float nr = lb.re * xr - lb.im * xi + br, ni = lb.re * xi + lb.im * xr + bim; xr = nr; xi = ni;
        __syncthreads();
        if (tid < 64) for (int j = 0; j < 16; ++j) part[p * 17 + j] = cr[j] * xr - ci[j] * xi;
        __syncthreads();
        if (tid < 16) {
            float y = 0.f; for (int q = 0; q < 64; ++q) y += part[q * 17 + tid];
            y += dsk[g * 16 + tid] * u[tid];
            const float ref = gelu_tanh(y); const float got = bf2f(YG[((size_t)(b * 4096 + sq)) * 512 + g * 16 + tid]);
            if (!(fabsf(got - ref) <= 0.03f + 0.03f * fabsf(ref))) ++bad;
        }
    }
    if (bad) atomicAdd(ctl + 300, bad);
}
#endif

#ifdef CHECK_ATTN
__device__ __forceinline__ void check_attn(const Params& P, LAS unsigned char* lds, unsigned* ctl) {
    unsigned char* ws = P.ws;
    const int tid = threadIdx.x, lane = tid & 63, r = tid >> 6;
    const bf16_t* Qp = (const bf16_t*)(ws + WS_Q); const bf16_t* KVp = (const bf16_t*)(ws + WS_KV);
    const float* GT = (const float*)(ws + WS_GATES); const bf16_t* Op = (const bf16_t*)(ws + WS_O);
    LAS float* sc = (LAS float*)lds;
    LAS float* impH = sc + 1024;
    LAS int* sel = (LAS int*)(impH + 256);
    unsigned bad = 0, badsel = 0;
    for (int smp = 0; smp < 3; ++smp) {
        const int id = blockIdx.x * 3 + smp;
        const int b = id & 3, g = (id >> 2) & 1;
        int t = (int)(((unsigned)id * 2654435761u) >> 20) & 4095;
        if (id < 16) t = id * 9;
        if (id >= 16 && id < 32) t = 1000 + (id - 16) * 4;
        const size_t rowq = (size_t)b * 4096 + t;
        const int hd = g * 4 + (r & 3);
        const float nslope2 = -exp2f(-(float)(hd + 1)) * LOG2E;
        const float q = r < 4 ? bf2f(Qp[rowq * 512 + hd * 64 + lane]) : 0.f;
        const bf16_t* KC = (const bf16_t*)(ws + WS_KC) + (size_t)(b * 2 + g) * 256 * 64; const bf16_t* VC = (const bf16_t*)(ws + WS_VC) + (size_t)(b * 2 + g) * 256 * 64;
        float tot = 0.f;
        __syncthreads();
        if (r < 4) {
            const int ncmp = t >= 31 ? (t - 31) / 16 + 1 : 0;
            float m = -1e30f;
            for (int c = 0; c < ncmp; ++c) { float s2 = wave_sum(q * bf2f(KC[c * 64 + lane])) + nslope2 * (float)(t - (16 * c + 31)); if (lane == 0) sc[r * 256 + c] = s2; m = fmaxf(m, s2); }
            float l = 0.f;
            for (int c = 0; c < ncmp; ++c) l += exp2f(sc[r * 256 + c] - m);
            float o = 0.f;
            for (int c = 0; c < ncmp; ++c) { const float p = exp2f(sc[r * 256 + c] - m) / l; o += p * bf2f(VC[c * 64 + lane]); }
            tot += GT[rowq * 24 + g * 12 + r * 3 + 0] * o;
            float im = 0.f;
            for (int cc = 4 * lane - 1; cc <= 4 * lane + 3; ++cc) if (cc >= 0 && cc < ncmp) im += exp2f(sc[r * 256 + cc] - m) / l;
            impH[r * 64 + lane] = im;
        }
        __syncthreads();
        if (tid < 64) {
            const int j = tid, cur = t >> 6; const float imp = impH[j] + impH[64 + j] + impH[128 + j] + impH[192 + j];
            const bool valid = j <= cur, forced = (j == 0) || (j == cur) || (j == cur - 1);
            const float key = valid ? imp + (forced ? 1.0e4f : 0.f) : -1e30f;
            sc[j] = key;
        }
        __syncthreads();
        if (tid < 64) {
            const int j = tid; const float key = sc[j]; int cnt = 0;
            for (int jp = 0; jp < 64; ++jp) { const float sj = sc[jp]; cnt += ((sj > key) || (sj == key && jp < j)) ? 1 : 0; }
            sel[j] = (cnt < 16) ? 1 : 0;
        }
        __syncthreads();
        if (r < 4) {
            const bf16_t* Ks = KVp + (size_t)2 * T_TOK * 128; const bf16_t* Vs = KVp + (size_t)3 * T_TOK * 128;
            float m = -1e30f, l = 0.f, o = 0.f;
            for (int j = 0; j < 64; ++j) if (sel[j]) for (int kk = 0; kk < 64; ++kk) { const int kp = 64 * j + kk; if (kp > t) break;
                const float s2 = wave_sum(q * bf2f(Ks[((size_t)b * 4096 + kp) * 128 + g * 64 + lane])) + nslope2 * (float)(t - kp);
                const float mn = fmaxf(m, s2), al = exp2f(m - mn), p = exp2f(s2 - mn); l = l * al + p; o = o * al + p * bf2f(Vs[((size_t)b * 4096 + kp) * 128 + g * 64 + lane]); m = mn; }
            tot += GT[rowq * 24 + g * 12 + r * 3 + 1] * o / fmaxf(l, 1e-30f);
            const bf16_t* Kw = KVp + (size_t)4 * T_TOK * 128; const bf16_t* Vw = KVp + (size_t)5 * T_TOK * 128;
            m = -1e30f; l = 0.f; o = 0.f;
            for (int kp = (t - 511 > 0 ? t - 511 : 0); kp <= t; ++kp) {
                const float s2 = wave_sum(q * bf2f(Kw[((size_t)b * 4096 + kp) * 128 + g * 64 + lane])) + nslope2 * (float)(t - kp);
                const float mn = fmaxf(m, s2), al = exp2f(m - mn), p = exp2f(s2 - mn); l = l * al + p; o = o * al + p * bf2f(Vw[((size_t)b * 4096 + kp) * 128 + g * 64 + lane]); m = mn; }
            tot += GT[rowq * 24 + g * 12 + r * 3 + 2] * o / fmaxf(l, 1e-30f);
            const float got = bf2f(Op[rowq * 512 + hd * 64 + lane]);
            if (!(fabsf(got - tot) <= 0.02f + 0.03f * fabsf(tot))) ++bad;
        }
    }
    if (bad) atomicAdd(ctl + 300, bad);
}
#endif

#ifdef CHECK_CMP
__device__ __forceinline__ void check_cmp(const Params& P, LAS unsigned char* lds, unsigned* ctl) {
    unsigned char* ws = P.ws;
    const int tid = threadIdx.x;
    LAS float* h1 = (LAS float*)lds;
    unsigned bad = 0;
    for (int smp = 0; smp < 4; ++smp) {
        const int id = blockIdx.x * 4 + smp;
        const int kv = id & 1, b = (id >> 1) & 3, g = (id >> 3) & 1; int c = (int)(((unsigned)id * 2654435761u) >> 22) % 255; if (id < 32) c = 254 - (id >> 4);
        const bf16_t* src = (const bf16_t*)(ws + WS_KV) + (size_t)kv * T_TOK * 128;
        const float* pe = P.in[kv ? 16 : 13]; const float* w1 = P.in[kv ? 17 : 14]; const float* w2 = P.in[kv ? 18 : 15];
        const bf16_t* dst = (const bf16_t*)(ws + (kv ? WS_VC : WS_KC));
        __syncthreads();
        if (tid < 128) { float a = 0.f;
            for (int k = 0; k < 2048; ++k) { const int l = k >> 6, d = k & 63; a += (bf2f(src[((size_t)(b * 4096 + 16 * c + l)) * 128 + g * 64 + d]) + pe[k]) * w1[(size_t)k * 128 + tid]; }
            h1[tid] = gelu_tanh(a); }
        __syncthreads();
        if (tid < 64) { float a = 0.f; for (int n = 0; n < 128; ++n) a += h1[n] * w2[n * 64 + tid];
            const float got = bf2f(dst[((size_t)((b * 2 + g) * 256 + c)) * 64 + tid]);
            if (!(fabsf(got - a) <= 0.02f + 0.03f * fabsf(a))) ++bad; }
    }
    if (bad) atomicAdd(ctl + 300, bad);
}
#endif

#ifdef CHECK_X1
#ifndef X1TOL
#define X1TOL 0.03f
#endif
#ifndef X1SRC
#define X1SRC 0
#endif
__device__ __forceinline__ void check_x1(const Params& P, LAS unsigned char* lds, unsigned* ctl, const bf16_t* GMcopy) {
    unsigned char* ws = P.ws;
    const int tid = threadIdx.x; const int row = (int)(((unsigned)blockIdx.x * 2654435761u) >> 18) & 16383;
    LAS float* yg = (LAS float*)lds; LAS float* z = yg + 512; LAS float* o = z + 512; LAS float* m = o + 512; LAS float* rr = m + 1024; LAS float* red = rr + 1024;
    const bf16_t* YG = (const bf16_t*)(ws + WS_YG); const bf16_t* Op = (const bf16_t*)(ws + WS_O);
    const float* wglu = P.in[11]; const float* wups = P.in[12]; const float* wupn = P.in[19]; const float* wout = P.in[20];
    yg[tid] = bf2f(YG[(size_t)row * 512 + tid]); o[tid] = bf2f(Op[(size_t)row * 512 + tid]);
    __syncthreads();
    { float ga = 0.f, gb = 0.f; for (int k = 0; k < 512; ++k) { ga += yg[k] * wglu[(size_t)k * 1024 + tid]; gb += yg[k] * wglu[(size_t)k * 1024 + 512 + tid]; } z[tid] = ga / (1.f + expf(-gb)); }
    __syncthreads();
    if (CHECK_X1 == 2) { const float got = bf2f(((const bf16_t*)(ws + WS_Z))[(size_t)row * 512 + tid]); if (!(fabsf(got - z[tid]) <= 0.02f + 0.03f * fabsf(z[tid]))) atomicAdd(ctl + 300, 1u); return; }
    for (int n = tid; n < 1024; n += 512) { float ya = 0.f, yb = 0.f; for (int k = 0; k < 512; ++k) { ya += z[k] * wups[(size_t)k * 1024 + n]; yb += o[k] * wupn[(size_t)k * 1024 + n]; }
        m[n] = bf2f(GMcopy[(size_t)blockIdx.x * 2048 + n]) * ya + bf2f(GMcopy[(size_t)blockIdx.x * 2048 + 1024 + n]) * yb; }
    __syncthreads();
    if (CHECK_X1 == 3) { for (int n = tid; n < 1024; n += 512) { const float got = bf2f(((const bf16_t*)(ws + WS_MIXIN))[(size_t)row * 1024 + n]); if (!(fabsf(got - m[n]) <= 0.02f + 0.03f * fabsf(m[n]))) atomicAdd(ctl + 300, 1u); } return; }
    for (int n = tid; n < 1024; n += 512) { float a = 0.f; for (int k = 0; k < 1024; ++k) a += m[k] * wout[(size_t)k * 1024 + n]; rr[n] = DN_ALPHA * P.in[0][(size_t)row * 1024 + n] + a; }
    __syncthreads();
    if (CHECK_X1 == 4) { for (int n = tid; n < 1024; n += 512) { const float got = P.out[(size_t)row * 1024 + n]; if (!(fabsf(got - rr[n]) <= 0.03f + 0.03f * fabsf(rr[n]))) atomicAdd(ctl + 300, 1u); } return; }
    float sm = 0.f; for (int n = tid; n < 1024; n += 512) sm += rr[n]; sm = wave_sum(sm); if ((tid & 63) == 0) red[tid >> 6] = sm; __syncthreads();
    float mean = 0.f; for (int i = 0; i < 8; ++i) mean += red[i]; mean *= (1.f / 1024.f); __syncthreads();
    float sq = 0.f; for (int n = tid; n < 1024; n += 512) sq += (rr[n] - mean) * (rr[n] - mean); sq = wave_sum(sq); if ((tid & 63) == 0) red[tid >> 6] = sq; __syncthreads();
    float var = 0.f; for (int i = 0; i < 8; ++i) var += red[i]; var *= (1.f / 1024.f);
    const float rstd = 1.f / sqrtf(var + LN_EPS); unsigned bad = 0;
    for (int n = tid; n < 1024; n += 512) { const float ref = (rr[n] - mean) * rstd * P.in[21][n] + P.in[22][n]; const float got = X1SRC ? bf2f(((const bf16_t*)(ws + WS_X1B))[(size_t)row * 1024 + n]) : P.out[(size_t)row * 1024 + n]; if (!(fabsf(got - ref) <= X1TOL + X1TOL * fabsf(ref))) ++bad; }
    if (bad) atomicAdd(ctl + 300, bad);
}
#endif

#ifdef CHECK_QP
__device__ __forceinline__ void check_qp(const Params& P, LAS unsigned char* lds, unsigned* ctl) {
    const int tid = threadIdx.x; const int row = (int)(((unsigned)blockIdx.x * 2654435761u) >> 18) & 16383;
    LAS float* xs = (LAS float*)lds;
    for (int n = tid; n < 1024; n += 512) xs[n] = P.out[(size_t)row * 1024 + n];
    __syncthreads();
    const float* wq = P.in[23]; const bf16_t* QP = (const bf16_t*)(P.ws + WS_QP);
    for (int n = tid; n < 1024; n += 512) { float a = 0.f; for (int k = 0; k < 1024; ++k) a += xs[k] * wq[(size_t)k * 1024 + n];
        const float got = bf2f(QP[(size_t)row * 1024 + n]); if (!(fabsf(got - a) <= 0.03f + 0.03f * fabsf(a))) atomicAdd(ctl + 300, 1u); }
}
#endif

#ifdef CHECK_P10
__device__ __forceinline__ void check_p10(const Params& P, LAS unsigned char* lds, unsigned* ctl) {
    const int tid = threadIdx.x; const int row = (int)(((unsigned)blockIdx.x * 2654435761u) >> 18) & 16383;
    LAS float* xs = (LAS float*)lds; LAS float* wgt = xs + 1024; LAS float* rr = wgt + 128; LAS float* red = rr + 1024;
    const float* xsave = (const float*)(P.ws + WS_Z) + (size_t)blockIdx.x * 1024;
    for (int n = tid; n < 1024; n += 512) xs[n] = xsave[n];
    __syncthreads();
    const u32x2* pk = (const u32x2*)(P.ws + WS_PK) + (size_t)row * 128;
    const float* ut = P.in[25]; const float* vt = P.in[26];
    if (tid < 128) { const u32x2 q = pk[tid]; float h = 0.f;
#pragma nounroll
        for (int k = 0; k < 1024; ++k) h += ut[(size_t)q.x * 1024 + k] * xs[k]; wgt[tid] = __uint_as_float(q.y) * (ABL_NOH ? 1.f : gelu_tanh(h)); }
    __syncthreads();
    for (int n = tid; n < 1024; n += 512) { float y = 0.f;
#pragma nounroll
        for (int k = 0; k < 128; ++k) y += wgt[k] * vt[(size_t)pk[k].x * 1024 + n]; rr[n] = DN_ALPHA * xs[n] + (ABL_NOPEER ? 0.f : y); }
    __syncthreads();
    float sm = 0.f; for (int n = tid; n < 1024; n += 512) sm += rr[n]; sm = wave_sum(sm); if ((tid & 63) == 0) red[tid >> 6] = sm; __syncthreads();
    float mean = 0.f; for (int i = 0; i < 8; ++i) mean += red[i]; mean *= (1.f / 1024.f); __syncthreads();
    float sq = 0.f; for (int n = tid; n < 1024; n += 512) sq += (rr[n] - mean) * (rr[n] - mean); sq = wave_sum(sq); if ((tid & 63) == 0) red[tid >> 6] = sq; __syncthreads();
    float var = 0.f; for (int i = 0; i < 8; ++i) var += red[i]; var *= (1.f / 1024.f);
    const float rstd = 1.f / sqrtf(var + LN_EPS);
    for (int n = tid; n < 1024; n += 512) { const float ref = (rr[n] - mean) * rstd * P.in[27][n] + P.in[28][n]; const float got = P.out[(size_t)row * 1024 + n]; if (!(fabsf(got - ref) <= 0.03f + 0.03f * fabsf(ref))) atomicAdd(ctl + 300, 1u); }
}
#endif
#ifndef STOP_AFTER
#define STOP_AFTER 99
#endif

#ifndef DG_A
#define DG_A 0
#define DG_B 0
#endif
__device__ __forceinline__ void digest(const Params& P) {
    const int gtid = blockIdx.x * 512 + threadIdx.x, NT = gridDim.x * 512;
    const unsigned short* a = (const unsigned short*)(P.ws + (size_t)(DG_A < 0 ? 0 : DG_A) * MiB); const unsigned short* b = (const unsigned short*)(P.ws + (size_t)DG_B * MiB);
    for (int i = gtid; i < 8 * 1024 * 1024; i += NT) { P.out[i] = (float)a[i]; P.out[8 * 1024 * 1024 + i] = (float)b[i]; }
}
#ifndef NC_A
#define NC_A -1
#define NC_AN 0
#define NC_B -1
#define NC_BN 0
#define NC_C -1
#define NC_CN 0
#endif
__device__ __forceinline__ void nan_probe(const Params& P, unsigned* ctl, const XcdBarrier& bar) {
    const int gtid = blockIdx.x * 512 + threadIdx.x, NT = gridDim.x * 512;
    const int offs[3] = {NC_A, NC_B, NC_C}, szs[3] = {NC_AN, NC_BN, NC_CN};
#pragma unroll
    for (int w = 0; w < 3; ++w) if (offs[w] >= 0) {
        const unsigned short* a = (const unsigned short*)(P.ws + (size_t)offs[w] * KiB); unsigned cnt = 0;
        for (size_t i = gtid; i < (size_t)szs[w] * KiB / 2; i += NT) cnt += ((a[i] & 0x7f80u) == 0x7f80u) ? 1u : 0u;
        if (cnt) atomicAdd(ctl + 300 + w, cnt);
    }
    xcd_barrier(bar);
    float c = 0.f;
#pragma unroll
    for (int w = 0; w < 3; ++w) if (offs[w] >= 0) { if (__hip_atomic_load(ctl + 300 + w, __ATOMIC_RELAXED, __HIP_MEMORY_SCOPE_AGENT) != 0u) c += (float)(1 << w); }
#ifdef NC_COUNT
    c = log2f(1.0f + (float)__hip_atomic_load(ctl + 300, __ATOMIC_RELAXED, __HIP_MEMORY_SCOPE_AGENT));
#endif
    for (int i = gtid; i < T_TOK * DM; i += NT) P.out[i] = c;
}
#define PHASE_END(k) do { if (STOP_AFTER == (k)) { GRID_BAR(); if (NC_A >= 0) nan_probe(P, ctl, bar); else if (DG_A >= 0) digest(P); return; } } while (0)
__global__ void __launch_bounds__(512, 2) hybrid_fwd(Params P) {
    extern __shared__ __attribute__((aligned(16))) unsigned char lds_raw[];
    LAS unsigned char* lds = (LAS unsigned char*)lds_raw;
    LAS int* slot = (LAS int*)(lds + LDS_BYTES - 64);
    cg::grid_group grid = cg::this_grid();
    unsigned char* ws = P.ws;
    unsigned* ctl = (unsigned*)(ws + WS_CTL);
    const int tid = threadIdx.x, lane = tid & 63, wave = __builtin_amdgcn_readfirstlane(tid >> 6);
    const int G = gridDim.x;
    volatile LAS unsigned* MISC = (volatile LAS unsigned*)(lds + LDS_BYTES - 32);
    if (tid < 2) MISC[tid] = 0u;
    __syncthreads();
    const XcdBarrier bar = xcd_barrier_post(ctl + CW_BAR, MISC);
#define GRID_BAR() xcd_barrier(bar)

    p0_prologue(P);
#if DUP_PHASE == 0
    p0_prologue(P);
#endif
    asm volatile("s_waitcnt vmcnt(0)" ::: "memory");
    grid.sync();
    if (tid == 0) { __builtin_amdgcn_fence(__ATOMIC_ACQUIRE, "agent"); asm volatile("s_waitcnt vmcnt(0)" ::: "memory"); }
    __syncthreads();

    {
        pg8::Gemm g{(const bf16_t*)(ws + WS_XB), (const bf16_t*)(ws + WS_WIN), T_TOK, INCP, 1024};
        pg8::StaticOrder S; S.init(T_TOK, INCP, G, (int)blockIdx.x);
        pg8::Epi8<FInProj> E{FInProj{P.in[2], (bf16_t*)(ws + WS_UG), (bf16_t*)(ws + WS_Q), (bf16_t*)(ws + WS_KV), (float*)(ws + WS_GATES), (bf16_t*)P.out}};
        pg8::gemm_phase(lds, g, S, E);
    }
    GRID_BAR();

#ifdef CHECK_PROJ
    check_proj(P, ctl);
    GRID_BAR();
    { float c = 0.f; for (int k = 0; k < 5; ++k) if (__hip_atomic_load(ctl + 300 + k, __ATOMIC_RELAXED, __HIP_MEMORY_SCOPE_AGENT) != 0u) c += (float)(k < 3 ? (1 << k) : 0);
      if (CHECK_PROJ == 1) { c = 0.f; if (__hip_atomic_load(ctl + 303, __ATOMIC_RELAXED, __HIP_MEMORY_SCOPE_AGENT) != 0u) c += 1.f; if (__hip_atomic_load(ctl + 304, __ATOMIC_RELAXED, __HIP_MEMORY_SCOPE_AGENT) != 0u) c += 2.f; }
      for (int i = blockIdx.x * 512 + tid; i < T_TOK * DM; i += G * 512) P.out[i] = c; }
    return;
#endif
    PHASE_END(1);
    for (;;) { const int it = next_item(ctl + CW_Q2, slot); if (it >= 256) break; compress_item(P, lds, it); }
    GRID_BAR();

#ifdef CHECK_CMP
    check_cmp(P, lds, ctl);
    GRID_BAR();
    { const float c = log2f(1.0f + (float)__hip_atomic_load(ctl + 300, __ATOMIC_RELAXED, __HIP_MEMORY_SCOPE_AGENT));
      for (int i = blockIdx.x * 512 + tid; i < T_TOK * DM; i += G * 512) P.out[i] = c; }
    return;
#endif
    PHASE_END(2);
#if DUP_PHASE == 3
    for (;;) { const int it = next_item(ctl + 256, slot); if (it >= 128) break; s5_item(P, lds, it & 31, it >> 5); }
    for (;;) { const int k = next_item(ctl + 320, slot); if (k >= 512) break; attn_item(P, lds, (k & 7) >> 1, k & 1, 63 - (k >> 3)); }
    GRID_BAR();
#endif
#if DUP_PHASE == 32
    for (;;) { const int k = next_item(ctl + 320, slot); if (k >= 512) break; attn_item(P, lds, (k & 7) >> 1, k & 1, 63 - (k >> 3)); }
    GRID_BAR();
#endif
#if DUP_PHASE == 31
    for (;;) { const int it = next_item(ctl + 256, slot); if (it >= 128) break; s5_item(P, lds, it & 31, it >> 5); }
    GRID_BAR();
#endif
    for (;;) { const int it = next_item(ctl + CW_Q3, slot); if (it >= 128) break; s5_item(P, lds, it & 31, it >> 5); }
#ifndef SKIP_ATTN
    for (;;) { const int k = next_item(ctl + CW_Q3B, slot); if (k >= 512) break; attn_item(P, lds, (k & 7) >> 1, k & 1, 63 - (k >> 3)); }
#endif
    GRID_BAR();

#ifdef CHECK_ATTN
    check_attn(P, lds, ctl);
    GRID_BAR();
    { const float c = log2f(1.0f + (float)__hip_atomic_load(ctl + 300, __ATOMIC_RELAXED, __HIP_MEMORY_SCOPE_AGENT));
      for (int i = blockIdx.x * 512 + tid; i < T_TOK * DM; i += G * 512) P.out[i] = c; }
    return;
#endif
#ifdef CHECK_S5
    check_s5(P, lds, ctl);
    GRID_BAR();
    { const float c = log2f(1.0f + (float)__hip_atomic_load(ctl + 300, __ATOMIC_RELAXED, __HIP_MEMORY_SCOPE_AGENT));
      for (int i = blockIdx.x * 512 + tid; i < T_TOK * DM; i += G * 512) P.out[i] = c; }
    return;
#endif
    PHASE_END(3);
    {
        pg8::Gemm g{(const bf16_t*)(ws + WS_YG), (const bf16_t*)(ws + WS_WGLU), T_TOK, 1024, 512};
        pg8::StaticOrder S; S.init(T_TOK, 1024, G, (int)blockIdx.x);
        EpiGLU E{(bf16_t*)(ws + WS_Z)};
        pg8::gemm_phase(lds, g, S, E);
    }
    GRID_BAR();

#if defined(CHECK_X1) && CHECK_X1 == 2
    check_x1(P, lds, ctl, (const bf16_t*)(ws + WS_PK));
    GRID_BAR();
    { const float c = log2f(1.0f + (float)__hip_atomic_load(ctl + 300, __ATOMIC_RELAXED, __HIP_MEMORY_SCOPE_AGENT));
      for (int i = blockIdx.x * 512 + tid; i < T_TOK * DM; i += G * 512) P.out[i] = c; }
    return;
#endif
    PHASE_END(4);
    {
        pg8::Gemm g{(const bf16_t*)(ws + WS_Z), (const bf16_t*)(ws + WS_WUPS), T_TOK, 1024, 512};
        pg8::StaticOrder S; S.init(T_TOK, 1024, G, (int)blockIdx.x);
        pg8::Epi8<FUp1> E{FUp1{(const bf16_t*)P.out, (bf16_t*)(ws + WS_M1)}};
        pg8::gemm_phase(lds, g, S, E);
    }
    {
        pg8::Gemm g{(const bf16_t*)(ws + WS_O), (const bf16_t*)(ws + WS_WUPN), T_TOK, 1024, 512};
        pg8::StaticOrder S; S.init(T_TOK, 1024, G, (int)blockIdx.x);
        pg8::Epi8<FUp2> E{FUp2{(const bf16_t*)P.out, (const bf16_t*)(ws + WS_M1), (bf16_t*)(ws + WS_MIXIN)}};
        pg8::gemm_phase(lds, g, S, E);
    }
    GRID_BAR();

#ifdef CHECK_X1
    { const int row = (int)(((unsigned)blockIdx.x * 2654435761u) >> 18) & 16383; bf16_t* dstg = (bf16_t*)(ws + WS_PK); const bf16_t* srcg = (const bf16_t*)P.out;
      for (int i = tid; i < 2048; i += 512) dstg[(size_t)blockIdx.x * 2048 + i] = srcg[(size_t)row * 2048 + i]; }
    GRID_BAR();
#if CHECK_X1 == 3
    check_x1(P, lds, ctl, (const bf16_t*)(ws + WS_PK));
    GRID_BAR();
    { const float c = log2f(1.0f + (float)__hip_atomic_load(ctl + 300, __ATOMIC_RELAXED, __HIP_MEMORY_SCOPE_AGENT));
      for (int i = blockIdx.x * 512 + tid; i < T_TOK * DM; i += G * 512) P.out[i] = c; }
    return;
#endif
#endif
    PHASE_END(5);
    {
        pg8::Gemm g{(const bf16_t*)(ws + WS_MIXIN), (const bf16_t*)(ws + WS_WOUT), T_TOK, 1024, 1024};
        pg8::StaticOrder S; S.init(T_TOK, 1024, G, (int)blockIdx.x);
        pg8::Epi8<FOut> E{FOut{P.in[0], P.out}};
        pg8::gemm_phase(lds, g, S, E);
    }
    GRID_BAR();

#if defined(CHECK_X1) && CHECK_X1 == 4
    check_x1(P, lds, ctl, (const bf16_t*)(ws + WS_PK));
    GRID_BAR();
    { const float c = log2f(1.0f + (float)__hip_atomic_load(ctl + 300, __ATOMIC_RELAXED, __HIP_MEMORY_SCOPE_AGENT));
      for (int i = blockIdx.x * 512 + tid; i < T_TOK * DM; i += G * 512) P.out[i] = c; }
    return;
#endif
    PHASE_END(6);
    {
        const float* g1 = P.in[21]; const float* b1 = P.in[22];
        for (int row = blockIdx.x * 8 + wave; row < T_TOK; row += G * 8) {
            f32x4* xr = (f32x4*)(P.out + (size_t)row * 1024) + lane;
            f32x4 v[4]; float s = 0.f;
#pragma unroll
            for (int j = 0; j < 4; ++j) { v[j] = xr[64 * j]; s += (v[j][0] + v[j][1]) + (v[j][2] + v[j][3]); }
            const float mean = wave_sum(s) * (1.f / 1024.f); float s2 = 0.f;
#pragma unroll
            for (int j = 0; j < 4; ++j) { v[j] = v[j] - mean; s2 += (v[j][0] * v[j][0] + v[j][1] * v[j][1]) + (v[j][2] * v[j][2] + v[j][3] * v[j][3]); }
            const float rstd = 1.f / sqrtf(wave_sum(s2) * (1.f / 1024.f) + LN_EPS);
            u32x2* ob = (u32x2*)((bf16_t*)(ws + WS_X1B) + (size_t)row * 1024) + lane;
#pragma unroll
            for (int j = 0; j < 4; ++j) {
                const f32x4 gg = ((const f32x4*)g1)[64 * j + lane], bb = ((const f32x4*)b1)[64 * j + lane];
                const f32x4 o = v[j] * rstd * gg + bb; xr[64 * j] = o;
                u32x2 pw; pw.x = cvt_pk_bf16(o[0], o[1]); pw.y = cvt_pk_bf16(o[2], o[3]); ob[64 * j] = pw;
            }
        }
    }
    GRID_BAR();

#ifdef CHECK_X1
    check_x1(P, lds, ctl, (const bf16_t*)(ws + WS_PK));
    GRID_BAR();
    { const float c = log2f(1.0f + (float)__hip_atomic_load(ctl + 300, __ATOMIC_RELAXED, __HIP_MEMORY_SCOPE_AGENT));
      for (int i = blockIdx.x * 512 + tid; i < T_TOK * DM; i += G * 512) P.out[i] = c; }
    return;
#endif
    PHASE_END(7);
    {
        pg8::Gemm g{(const bf16_t*)(ws + WS_X1B), (const bf16_t*)(ws + WS_WQ), T_TOK, 1024, 1024};
        pg8::StaticOrder S; S.init(T_TOK, 1024, G, (int)blockIdx.x);
        pg8::Epi8<FQP> E{FQP{(bf16_t*)(ws + WS_QP)}};
        pg8::gemm_phase(lds, g, S, E);
    }
    GRID_BAR();

#ifdef CHECK_QP
    check_qp(P, lds, ctl);
    GRID_BAR();
    { const float c = log2f(1.0f + (float)__hip_atomic_load(ctl + 300, __ATOMIC_RELAXED, __HIP_MEMORY_SCOPE_AGENT));
      for (int i = blockIdx.x * 512 + tid; i < T_TOK * DM; i += G * 512) P.out[i] = c; }
    return;
#endif
    PHASE_END(8);
#if DUP_PHASE == 9
    for (int it = blockIdx.x * 8 + wave; it < 4096; it += G * 8) peer_score_item(P, lds, it, wave, lane);
    GRID_BAR();
#endif
    for (int it = blockIdx.x * 8 + wave; it < 4096; it += G * 8) peer_score_item(P, lds, it, wave, lane);
    GRID_BAR();

#ifdef CHECK_PEER
    check_peer(P, lds, ctl);
    GRID_BAR();
    { const float c = log2f(1.0f + (float)__hip_atomic_load(ctl + 300 + CHECK_PEER, __ATOMIC_RELAXED, __HIP_MEMORY_SCOPE_AGENT));
      for (int i = blockIdx.x * 512 + tid; i < T_TOK * DM; i += G * 512) P.out[i] = c; }
    return;
#endif
    PHASE_END(9);
#ifdef CHECK_P10
    { const int row = (int)(((unsigned)blockIdx.x * 2654435761u) >> 18) & 16383; float* xsave = (float*)(ws + WS_Z) + (size_t)blockIdx.x * 1024;
      for (int n = tid; n < 1024; n += 512) xsave[n] = P.out[(size_t)row * 1024 + n]; }
    GRID_BAR();
#endif
#if DUP_PHASE == 10
    for (int tok = blockIdx.x * 8 + wave; tok < T_TOK; tok += G * 8) peer_token(P, tok, lane, (float*)(ws + WS_Z));
    GRID_BAR();
#endif
#ifdef P10_OLD
    for (int tok = blockIdx.x * 8 + wave; tok < T_TOK; tok += G * 8) peer_token(P, tok, lane, P.out);
#else
    for (int tq = (blockIdx.x * 8 + wave) * 4; tq < T_TOK; tq += G * 8 * 4) peer_round(P, lds + wave * 12800, tq, lane);
#endif
#ifdef CHECK_P10
    GRID_BAR();
    check_p10(P, lds, ctl);
    GRID_BAR();
    { const float c = log2f(1.0f + (float)__hip_atomic_load(ctl + 300, __ATOMIC_RELAXED, __HIP_MEMORY_SCOPE_AGENT));
      for (int i = blockIdx.x * 512 + tid; i < T_TOK * DM; i += G * 512) P.out[i] = c; }
#endif
}

extern "C" void kernel_launch(void* const* d_in, const int* in_sizes, int n_in, void* d_out, int out_size, void* d_ws, size_t ws_size, hipStream_t stream) {
    static int grid_blocks = 0;
    if (grid_blocks == 0) {
        if (n_in != 29 || out_size != T_TOK * DM || ws_size < WS_NEED) { fprintf(stderr, "kernel_launch: unexpected problem shape (n_in %d, out %d, ws %zu)\n", n_in, out_size, ws_size); grid_blocks = -1; return; }
        int dev = 0, cus = 0, per_cu = 0;
        hipGetDevice(&dev);
        hipDeviceGetAttribute(&cus, hipDeviceAttributeMultiprocessorCount, dev);
        hipFuncSetAttribute((const void*)hybrid_fwd, hipFuncAttributeMaxDynamicSharedMemorySize, LDS_BYTES);
        hipOccupancyMaxActiveBlocksPerMultiprocessor(&per_cu, (const void*)hybrid_fwd, 512, LDS_BYTES);
        if (per_cu < 1) { fprintf(stderr, "kernel_launch: occupancy query reports %d blocks per CU\n", per_cu); per_cu = 1; }
        grid_blocks = cus;
    }
    if (grid_blocks < 0) return;
    hipMemsetAsync((char*)d_ws + WS_CTL, 0, CTL_BYTES, stream);
    Params p{};
    for (int i = 0; i < 29; ++i) p.in[i] = (const float*)d_in[i];
    p.out = (float*)d_out; p.ws = (unsigned char*)d_ws;
    void* args[] = {&p};
    hipError_t e = hipLaunchCooperativeKernel((const void*)hybrid_fwd, dim3(grid_blocks), dim3(512), args, LDS_BYTES, stream);
    if (e != hipSuccess) fprintf(stderr, "cooperative launch failed: %s (grid %d)\n", hipGetErrorString(e), grid_blocks);
}
```

```cpp
#define STOP_AFTER 99
#define DG_A -1
#define DG_B 0
#include <hip/hip_runtime.h>
#include <hip/hip_cooperative_groups.h>
#include <cstdio>
namespace cg = cooperative_groups;
#ifndef ABL_NOPEER
#define ABL_NOPEER 0
#endif
#ifndef ABL_NOMIX
#define ABL_NOMIX 0
#endif
#ifndef ABL_NOSSM
#define ABL_NOSSM 0
#endif
#ifndef ABL_NONSA
#define ABL_NONSA 0
#endif
#ifndef ABL_NOCMP
#define ABL_NOCMP 0
#endif
#ifndef ABL_NOSLC
#define ABL_NOSLC 0
#endif
#ifndef ABL_NOWIN
#define ABL_NOWIN 0
#endif
#ifndef ABL_NOH
#define ABL_NOH 0
#endif
#ifndef DUP_PHASE
#define DUP_PHASE -1
#endif

#define LAS __attribute__((address_space(3)))
typedef unsigned short bf16_t;
typedef short bf16x8 __attribute__((ext_vector_type(8)));
typedef short s16x4 __attribute__((ext_vector_type(4)));
typedef float f32x4 __attribute__((ext_vector_type(4)));
typedef float f32x16 __attribute__((ext_vector_type(16)));
typedef unsigned u32x4 __attribute__((ext_vector_type(4)));
typedef unsigned u32x2 __attribute__((ext_vector_type(2)));
typedef _Float16 h16x2 __attribute__((ext_vector_type(2)));

constexpr int T_TOK = 16384, DM = 1024, SEQ = 4096, NBATCH = 4;
constexpr int INC = 3864, INCP = 4096;
constexpr float DN_ALPHA = 1.189207115002721f;
constexpr float LN_EPS = 1e-5f;
constexpr float LOG2E = 1.4426950408889634f;

constexpr size_t MiB = 1u << 20, KiB = 1u << 10;
constexpr size_t WS_CTL = 0;
constexpr size_t CTL_BYTES = 64 * KiB;
constexpr size_t WS_SUBK = 1 * MiB;
constexpr size_t WS_W2K = WS_SUBK + 256 * KiB;
constexpr size_t WS_W2V = WS_W2K + 16 * KiB;
constexpr size_t WS_B1K = WS_W2V + 16 * KiB;
constexpr size_t WS_B1V = WS_B1K + 1 * KiB;
constexpr size_t WS_LAML = WS_B1V + 1 * KiB;
constexpr size_t WS_CF = WS_LAML + 16 * KiB;
constexpr size_t WS_LP = 30 * MiB + 512 * KiB;
constexpr size_t WS_W1K = 2 * MiB;
constexpr size_t WS_W1V = 2 * MiB + 512 * KiB;
constexpr size_t WS_KTAB = 3 * MiB;
constexpr size_t WS_ETAB = 5 * MiB;
constexpr size_t WS_FTAB = 13 * MiB;
constexpr size_t WS_WGLU = 21 * MiB;
constexpr size_t WS_WUPS = 22 * MiB;
constexpr size_t WS_WUPN = 23 * MiB;
constexpr size_t WS_WOUT = 24 * MiB;
constexpr size_t WS_WQ = 26 * MiB;
constexpr size_t WS_KC = 28 * MiB;
constexpr size_t WS_VC = WS_KC + 256 * KiB;
constexpr size_t WS_GATES = 29 * MiB;
constexpr size_t WS_UTAB = 32 * MiB;
constexpr size_t WS_VTAB = 48 * MiB;
constexpr size_t WS_XB = 96 * MiB;
constexpr size_t WS_Z = 96 * MiB;
constexpr size_t WS_O = 112 * MiB;
constexpr size_t WS_WIN = 128 * MiB;
constexpr size_t WS_UG = 136 * MiB;
constexpr size_t WS_MIXIN = 136 * MiB;
constexpr size_t WS_Q = 152 * MiB;
constexpr size_t WS_KV = 168 * MiB;
constexpr size_t WS_X1B = 168 * MiB;
constexpr size_t WS_YG = 192 * MiB;
constexpr size_t WS_M1 = 208 * MiB;
constexpr size_t WS_QP = 208 * MiB;
constexpr size_t WS_PK = 240 * MiB;
constexpr size_t WS_NEED = 256 * MiB;
constexpr int CW_Q2 = 64, CW_Q3 = 128, CW_Q3B = 192, CW_BAR = 4096;

constexpr int LDS_BYTES = 147456;

struct Params {
    const float* in[29];
    float* out;
    unsigned char* ws;
};

typedef __bf16 bf16v2 __attribute__((ext_vector_type(2)));
__device__ __forceinline__ unsigned cvt_pk_bf16(float lo, float hi) { bf16v2 v; v.x = (__bf16)lo; v.y = (__bf16)hi; return __builtin_bit_cast(unsigned, v); }
__device__ __forceinline__ float bf_lo(unsigned w) { return __uint_as_float(w << 16); }
__device__ __forceinline__ float bf_hi(unsigned w) { return __uint_as_float(w & 0xffff0000u); }
__device__ __forceinline__ float bf2f(bf16_t b) { return __uint_as_float(((unsigned)b) << 16); }
__device__ __forceinline__ bf16_t f2bf(float f) { return (bf16_t)(cvt_pk_bf16(f, 0.f) & 0xffffu); }
__device__ __forceinline__ float fast_exp2(float x) { return __builtin_amdgcn_exp2f(x); }
__device__ __forceinline__ float fast_rcp(float x) { return __builtin_amdgcn_rcpf(x); }
__device__ __forceinline__ float sigmoidf_(float x) { return fast_rcp(1.0f + fast_exp2(-x * LOG2E)); }
__device__ __forceinline__ float gelu_tanh(float x) { const float u = 1.5957691216057308f * x * (1.0f + 0.044715f * x * x); return x * fast_rcp(1.0f + fast_exp2(-u * LOG2E)); }
__device__ __forceinline__ float wave_sum(float v) {
#pragma unroll
    for (int o = 1; o < 64; o <<= 1) v += __shfl_xor(v, o);
    return v;
}
__device__ __forceinline__ unsigned pack_h2(float a, float b) { h16x2 h; h.x = (_Float16)a; h.y = (_Float16)b; return __builtin_bit_cast(unsigned, h); }

namespace pg8 {
constexpr int BM = 256, BK = 64, HALF = 128, HTB = HALF * BK * 2, STAGE_BYTES = 8 * HTB, NXCD = 8, WGM = 8;
__host__ __device__ __forceinline__ int lds_byte(int r, int c) { const int st = (r >> 4) * 2 + (c >> 5), rr = r & 15, cc = c & 31, ob = rr * 64 + cc * 2; return st * 1024 + (ob ^ (((ob >> 9) & 1) << 5)); }
__host__ __device__ __forceinline__ void stage_rc(int b, int& R, int& C) { const int st = b / 1024, sb = b % 1024, swz = sb ^ (((sb >> 9) & 1) << 5); R = (st >> 1) * 16 + swz / 64; C = (st & 1) * 32 + (swz % 64) / 2; }
__host__ __device__ __forceinline__ int perm32(int rho) { const int n = rho >> 4, i = rho & 15; return 8 * (i >> 2) + 4 * n + (i & 3); }
struct Unit { int pm, pn; };
struct Gemm { const bf16_t* A; const bf16_t* Bt; int M, N, K; };
struct StaticOrder {
    int nM, nN, nwg, G, c;
    __device__ void init(int M, int N, int G_, int c_) { nM = M / BM; nN = N / BM; nwg = nM * nN; G = G_; c = c_; }
    __device__ bool next(int i, Unit& u) const {
        const long L = (long)i * G + c; if (L >= nwg) return false;
        int wgid = (int)L; { const int q = nwg / NXCD, r = nwg % NXCD, xcd = wgid % NXCD, off = wgid / NXCD; wgid = (xcd < r ? xcd * (q + 1) : r * (q + 1) + (xcd - r) * q) + off; }
        const int nig = WGM * nN, gid = wgid / nig, fm = gid * WGM, gsz = (nM - fm) < WGM ? (nM - fm) : WGM;
        u.pm = fm + ((wgid % nig) % gsz); u.pn = (wgid % nig) / gsz; return true;
    }
};
template <class Epi>
__device__ __forceinline__ void gemm_phase(LAS unsigned char* lds, const Gemm g, const StaticOrder& S, const Epi& E) {
    const int tid = threadIdx.x, wid = __builtin_amdgcn_readfirstlane(tid >> 6), lane = tid & 63, wr = wid >> 2, wc = wid & 3, fr = lane & 15, fq = lane >> 4;
    const int K = g.K, nt = K / BK;
    unsigned voffA[2], voffB[2];
#pragma unroll
    for (int i = 0; i < 2; ++i) { int R, C; stage_rc(tid * 16 + i * 8192, R, C); const int Rb = (R & ~31) + perm32(R & 31);
        voffA[i] = (unsigned)(R * K + C) * 2u; voffB[i] = (unsigned)(Rb * K + C) * 2u; }
    const size_t kstep = (size_t)(BK * 2);
    const size_t hstep = (size_t)HALF * K * 2;
    const size_t tstep = 2 * hstep;
    const unsigned ldsw = (unsigned)wid * 1024u;
    const int aoff = lds_byte(wr * 64 + fr, fq * 8), boff = lds_byte(wc * 32 + fr, fq * 8);
#define PG8_SA(b, h) (((b) * 2 + (h)) * HTB)
#define PG8_SB(b, h) ((4 + (b) * 2 + (h)) * HTB)
#define PG8_STAGE(bufoff, gbase, voff) do { _Pragma("unroll") for (int _i = 0; _i < 2; ++_i) \
        __builtin_amdgcn_global_load_lds((const unsigned*)((const char*)(gbase) + (voff)[_i]), (LAS unsigned*)(lds + (bufoff) + ldsw + _i * 8192), 16, 0, 0); } while (0)
#define PG8_LDA(dst, b, h) do { _Pragma("unroll") for (int m = 0; m < 4; ++m) _Pragma("unroll") for (int k = 0; k < 2; ++k) dst[m][k] = *(const LAS bf16x8*)(lds + PG8_SA(b, h) + aoff + m * 2048 + k * 1024); } while (0)
#define PG8_LDB(dst, b, h) do { _Pragma("unroll") for (int n = 0; n < 2; ++n) _Pragma("unroll") for (int k = 0; k < 2; ++k) dst[n][k] = *(const LAS bf16x8*)(lds + PG8_SB(b, h) + boff + n * 2048 + k * 1024); } while (0)
#define PG8_MMA(ai, bj, At, Bt) do { __builtin_amdgcn_s_setprio(1); _Pragma("unroll") for (int m = 0; m < 4; ++m) _Pragma("unroll") for (int n = 0; n < 2; ++n) _Pragma("unroll") for (int k = 0; k < 2; ++k) \
        acc[ai][bj][m][n] = __builtin_amdgcn_mfma_f32_16x16x32_bf16(Bt[n][k], At[m][k], acc[ai][bj][m][n], 0, 0, 0); __builtin_amdgcn_s_setprio(0); } while (0)
#define PG8_WAIT_V(n) asm volatile("s_waitcnt vmcnt(" #n ")" ::: "memory")
#define PG8_WAIT_L(n) asm volatile("s_waitcnt lgkmcnt(" #n ")" ::: "memory")
#define PG8_BAR __builtin_amdgcn_s_barrier()
#define PG8_SCHED __builtin_amdgcn_sched_barrier(0)
    Unit cur, nxt; int ui = 0;
    if (!S.next(0, cur)) return;
    f32x4 acc[2][2][4][2];
#pragma unroll
    for (int a = 0; a < 2; ++a)
#pragma unroll
        for (int b = 0; b < 2; ++b)
#pragma unroll
            for (int m = 0; m < 4; ++m)
#pragma unroll
                for (int n = 0; n < 2; ++n) acc[a][b][m][n] = (f32x4){0.f, 0.f, 0.f, 0.f};
    bf16x8 At[4][2], B0[2][2], B1[2][2];
    const char* cA = (const char*)g.A + (size_t)cur.pm * tstep; const char* cB = (const char*)g.Bt + (size_t)cur.pn * tstep;
    PG8_STAGE(PG8_SB(0, 0), cB, voffB); PG8_STAGE(PG8_SA(0, 0), cA, voffA); PG8_STAGE(PG8_SB(0, 1), cB + hstep, voffB); PG8_STAGE(PG8_SA(0, 1), cA + hstep, voffA);
    if (wr == 1) PG8_BAR;
    PG8_WAIT_V(4); PG8_BAR;
    PG8_STAGE(PG8_SB(1, 0), cB + kstep, voffB); PG8_STAGE(PG8_SA(1, 0), cA + kstep, voffA); PG8_STAGE(PG8_SB(1, 1), cB + hstep + kstep, voffB);
    PG8_WAIT_V(6); PG8_BAR;
    for (;;) {
        const bool has_next = S.next(ui + 1, nxt);
        const char* nA = has_next ? (const char*)g.A + (size_t)nxt.pm * tstep : cA; const char* nB = has_next ? (const char*)g.Bt + (size_t)nxt.pn * tstep : cB;
        for (int t = 0; t < nt; t += 2) {
            const bool last = (t == nt - 2);
            const char* a1 = cA + (size_t)(t + 1) * kstep;
            const char* a2 = last ? nA : cA + (size_t)(t + 2) * kstep; const char* b2 = last ? nB : cB + (size_t)(t + 2) * kstep;
            const char* a3 = a2 + kstep; const char* b3 = b2 + kstep;
            PG8_LDB(B0, 0, 0); PG8_SCHED; PG8_LDA(At, 0, 0); PG8_STAGE(PG8_SA(1, 1), a1 + hstep, voffA);
            PG8_WAIT_L(8); PG8_BAR; PG8_WAIT_L(0); PG8_MMA(0, 0, At, B0); PG8_BAR; PG8_SCHED;
            PG8_LDB(B1, 0, 1); PG8_STAGE(PG8_SB(0, 0), b2, voffB);
            PG8_BAR; PG8_WAIT_L(0); PG8_MMA(0, 1, At, B1); PG8_BAR;
            PG8_LDA(At, 0, 1); PG8_STAGE(PG8_SA(0, 0), a2, voffA);
            PG8_BAR; PG8_WAIT_L(0); PG8_MMA(1, 0, At, B0); PG8_BAR; PG8_SCHED;
            PG8_STAGE(PG8_SB(0, 1), b2 + hstep, voffB);
            PG8_WAIT_V(6); PG8_BAR; PG8_MMA(1, 1, At, B1); PG8_BAR;
            PG8_LDB(B0, 1, 0); PG8_SCHED; PG8_LDA(At, 1, 0); PG8_STAGE(PG8_SA(0, 1), a2 + hstep, voffA);
            PG8_WAIT_L(8); PG8_BAR; PG8_WAIT_L(0); PG8_MMA(0, 0, At, B0); PG8_BAR; PG8_SCHED;
            PG8_LDB(B1, 1, 1); PG8_STAGE(PG8_SB(1, 0), b3, voffB);
            PG8_BAR; PG8_WAIT_L(0); PG8_MMA(0, 1, At, B1); PG8_BAR;
            PG8_LDA(At, 1, 1); PG8_STAGE(PG8_SA(1, 0), a3, voffA);
            PG8_BAR; PG8_WAIT_L(0); PG8_MMA(1, 0, At, B0); PG8_BAR; PG8_SCHED;
            PG8_STAGE(PG8_SB(1, 1), b3 + hstep, voffB);
            PG8_WAIT_V(6); PG8_BAR; PG8_MMA(1, 1, At, B1); PG8_BAR;
        }
        E(acc, cur, wr, wc, fr, fq);
        if (!has_next) break;
#pragma unroll
        for (int a = 0; a < 2; ++a)
#pragma unroll
            for (int b = 0; b < 2; ++b)
#pragma unroll
                for (int m = 0; m < 4; ++m)
#pragma unroll
                    for (int n = 0; n < 2; ++n) acc[a][b][m][n] = (f32x4){0.f, 0.f, 0.f, 0.f};
        cur = nxt; cA = nA; cB = nB; ++ui;
    }
    PG8_WAIT_V(0);
    if (wr == 0) PG8_BAR;
    PG8_BAR;
#undef PG8_SA
#undef PG8_SB
#undef PG8_STAGE
#undef PG8_LDA
#undef PG8_LDB
#undef PG8_MMA
#undef PG8_WAIT_V
#undef PG8_WAIT_L
#undef PG8_BAR
#undef PG8_SCHED
}
template <class F> struct Epi8 {
    F f;
    __device__ __forceinline__ void operator()(const f32x4 (&acc)[2][2][4][2], const Unit& u, int wr, int wc, int fr, int fq) const {
        const int row0 = u.pm * BM + wr * 64 + fr, col0 = u.pn * BM + wc * 32 + 8 * fq;
#pragma unroll
        for (int ai = 0; ai < 2; ++ai)
#pragma unroll
            for (int m = 0; m < 4; ++m) {
                const int row = row0 + ai * HALF + m * 16;
#pragma unroll
                for (int bj = 0; bj < 2; ++bj) f(row, col0 + bj * HALF, acc[ai][bj][m][0], acc[ai][bj][m][1]);
            }
    }
};
}

__device__ __forceinline__ u32x4 pack8(const f32x4& a, const f32x4& b) {
    u32x4 w; w.x = cvt_pk_bf16(a[0], a[1]); w.y = cvt_pk_bf16(a[2], a[3]); w.z = cvt_pk_bf16(b[0], b[1]); w.w = cvt_pk_bf16(b[2], b[3]); return w;
}

struct FInProj {
    const float* bias; bf16_t* UG; bf16_t* Q; bf16_t* KV; float* GATES; bf16_t* GM;
    __device__ __forceinline__ void operator()(int row, int col, f32x4 v0, f32x4 v1) const {
        if (col >= INC) return;
        const f32x4 b0 = *(const f32x4*)(bias + col), b1 = *(const f32x4*)(bias + col + 4);
        v0 += b0; v1 += b1;
        if (col < 512) {
            const int b = row >> 12, s = row & 4095, g = col >> 4, hp = col & 15;
            *(u32x4*)(UG + ((size_t)((b * 32 + g) * 4096 + s)) * 16 + hp) = pack8(v0, v1);
        } else if (col < 1024) {
            *(u32x4*)(Q + (size_t)row * 512 + (col - 512)) = pack8(v0 * (0.125f * LOG2E), v1 * (0.125f * LOG2E));
        } else if (col < 1792) {
            const int idx = (col - 1024) >> 7, cc = (col - 1024) & 127;
            *(u32x4*)(KV + ((size_t)idx * T_TOK + row) * 128 + cc) = pack8(v0, v1);
        } else if (col < 1816) {
            f32x4 s0, s1;
#pragma unroll
            for (int j = 0; j < 4; ++j) { s0[j] = sigmoidf_(v0[j]); s1[j] = sigmoidf_(v1[j]); }
            float* gp = GATES + (size_t)row * 24 + (col - 1792);
            *(f32x4*)gp = s0; *(f32x4*)(gp + 4) = s1;
        } else {
            f32x4 s0, s1;
#pragma unroll
            for (int j = 0; j < 4; ++j) { s0[j] = sigmoidf_(v0[j]); s1[j] = sigmoidf_(v1[j]); }
            *(u32x4*)(GM + (size_t)row * 2048 + (col - 1816)) = pack8(s0, s1);
        }
    }
};
struct EpiGLU {
    bf16_t* ZO;
    __device__ __forceinline__ void operator()(const f32x4 (&acc)[2][2][4][2], const pg8::Unit& u, int wr, int wc, int fr, int fq) const {
        const int row0 = u.pm * 256 + wr * 64 + fr, col0 = u.pn * 128 + wc * 32 + 8 * fq;
#pragma unroll
        for (int ai = 0; ai < 2; ++ai)
#pragma unroll
            for (int m = 0; m < 4; ++m) {
                const int row = row0 + ai * 128 + m * 16;
                f32x4 z0, z1;
#pragma unroll
                for (int j = 0; j < 4; ++j) { z0[j] = acc[ai][0][m][0][j] * sigmoidf_(acc[ai][1][m][0][j]); z1[j] = acc[ai][0][m][1][j] * sigmoidf_(acc[ai][1][m][1][j]); }
                *(u32x4*)(ZO + (size_t)row * 512 + col0) = pack8(z0, z1);
            }
    }
};
struct FUp1 {
    const bf16_t* GM; bf16_t* M1;
    __device__ __forceinline__ void operator()(int row, int col, f32x4 v0, f32x4 v1) const {
        const u32x4 g = *(const u32x4*)(GM + (size_t)row * 2048 + col);
        if (ABL_NOSSM) { v0 = (f32x4){0.f, 0.f, 0.f, 0.f}; v1 = v0; }
        v0[0] *= bf_lo(g.x); v0[1] *= bf_hi(g.x); v0[2] *= bf_lo(g.y); v0[3] *= bf_hi(g.y);
        v1[0] *= bf_lo(g.z); v1[1] *= bf_hi(g.z); v1[2] *= bf_lo(g.w); v1[3] *= bf_hi(g.w);
        *(u32x4*)(M1 + (size_t)row * 1024 + col) = pack8(v0, v1);
    }
};
struct FUp2 {
    const bf16_t* GM; const bf16_t* M1; bf16_t* MX;
    __device__ __forceinline__ void operator()(int row, int col, f32x4 v0, f32x4 v1) const {
        const u32x4 g = *(const u32x4*)(GM + (size_t)row * 2048 + 1024 + col);
        const u32x4 a = *(const u32x4*)(M1 + (size_t)row * 1024 + col);
        if (ABL_NONSA) { v0 = (f32x4){0.f, 0.f, 0.f, 0.f}; v1 = v0; }
        v0[0] = v0[0] * bf_lo(g.x) + bf_lo(a.x); v0[1] = v0[1] * bf_hi(g.x) + bf_hi(a.x); v0[2] = v0[2] * bf_lo(g.y) + bf_lo(a.y); v0[3] = v0[3] * bf_hi(g.y) + bf_hi(a.y);
        v1[0] = v1[0] * bf_lo(g.z) + bf_lo(a.z); v1[1] = v1[1] * bf_hi(g.z) + bf_hi(a.z); v1[2] = v1[2] * bf_lo(g.w) + bf_lo(a.w); v1[3] = v1[3] * bf_hi(g.w) + bf_hi(a.w);
        *(u32x4*)(MX + (size_t)row * 1024 + col) = pack8(v0, v1);
    }
};
struct FOut {
    const float* x; float* R;
    __device__ __forceinline__ void operator()(int row, int col, f32x4 v0, f32x4 v1) const {
        const f32x4 x0 = *(const f32x4*)(x + (size_t)row * 1024 + col), x1 = *(const f32x4*)(x + (size_t)row * 1024 + col + 4);
        if (ABL_NOMIX) { v0 = (f32x4){0.f, 0.f, 0.f, 0.f}; v1 = v0; }
        *(f32x4*)(R + (size_t)row * 1024 + col) = x0 * DN_ALPHA + v0;
        *(f32x4*)(R + (size_t)row * 1024 + col + 4) = x1 * DN_ALPHA + v1;
    }
};
struct FQP {
    bf16_t* QP;
    __device__ __forceinline__ void operator()(int row, int col, f32x4 v0, f32x4 v1) const { *(u32x4*)(QP + (size_t)row * 1024 + col) = pack8(v0, v1); }
};

struct cpx { float re, im; };
__device__ __forceinline__ cpx cmul(cpx a, cpx b) { return {a.re * b.re - a.im * b.im, a.re * b.im + a.im * b.re}; }
__device__ __forceinline__ cpx lam_pow(float are, float aim, float dt, float tau) {
    const float er = are * dt * tau, ei = aim * dt * tau; const float m = expf(er); float s, c; sincosf(ei, &s, &c); return {m * c, m * s};
}
__device__ __forceinline__ cpx bbar_coef(float are, float aim, float dt) {
    const float x = are * dt, y = aim * dt; const float ex1 = expm1f(x); float s, c; sincosf(y, &s, &c); const float sh = sinf(0.5f * y);
    const float nr = ex1 * c - 2.f * sh * sh, ni = (ex1 + 1.f) * s;
    const float den = are * are + aim * aim;
    return {(nr * are + ni * aim) / den, (ni * are - nr * aim) / den};
}
template <class CM>
__device__ __forceinline__ void transpose_w(const float* src, int K, int Ns, bf16_t* dst, int Nd, CM cm, int gtid, int NT) {
    const int kch = K / 8; const long total = (long)Nd * kch;
    for (long i = gtid; i < total; i += NT) {
        const int n = (int)(i % Nd), kc = (int)(i / Nd); const int sc = cm(n);
        float v[8];
#pragma unroll
        for (int j = 0; j < 8; ++j) v[j] = sc >= 0 ? src[(size_t)(kc * 8 + j) * Ns + sc] : 0.f;
        u32x4 w; w.x = cvt_pk_bf16(v[0], v[1]); w.y = cvt_pk_bf16(v[2], v[3]); w.z = cvt_pk_bf16(v[4], v[5]); w.w = cvt_pk_bf16(v[6], v[7]);
        *(u32x4*)(dst + (size_t)n * K + kc * 8) = w;
    }
}
__device__ __forceinline__ void p0_prologue(const Params& P, LAS unsigned char* lds) {
    const int gtid = blockIdx.x * 512 + threadIdx.x, NT = gridDim.x * 512;
    unsigned char* ws = P.ws;
    { const f32x4* x4 = (const f32x4*)P.in[0]; u32x4* o = (u32x4*)(ws + WS_XB);
      for (int i = gtid; i < T_TOK * DM / 8; i += NT) { const f32x4 a = x4[2 * i], b = x4[2 * i + 1]; o[i] = pack8(a, b); } }
    { const f32x4* u4 = (const f32x4*)P.in[25]; const f32x4* v4 = (const f32x4*)P.in[26]; u32x4* uo = (u32x4*)(ws + WS_UTAB); u32x4* vo = (u32x4*)(ws + WS_VTAB);
      for (int i = gtid; i < 16384 * 1024 / 16; i += NT) {
          u32x4 w, z;
#pragma unroll
          for (int q = 0; q < 4; ++q) {
              const f32x4 a = u4[4 * i + q] * 64.0f, c = v4[4 * i + q] * 8.0f;
              int t = __builtin_amdgcn_cvt_pk_fp8_f32(a[0], a[1], 0, false); t = __builtin_amdgcn_cvt_pk_fp8_f32(a[2], a[3], t, true); w[q] = (unsigned)t;
              int r = __builtin_amdgcn_cvt_pk_fp8_f32(c[0], c[1], 0, false); r = __builtin_amdgcn_cvt_pk_fp8_f32(c[2], c[3], r, true); z[q] = (unsigned)r;
          }
          uo[i] = w; vo[i] = z; } }
    {
        LAS float* scr = (LAS float*)(lds + (threadIdx.x >> 6) * 8448);
        const int lane = threadIdx.x & 63, gw = gtid >> 6, NGW = NT >> 6;
        const float* srcs[10] = {P.in[1], P.in[11], P.in[12], P.in[19], P.in[20], P.in[23], P.in[14], P.in[17], P.in[15], P.in[18]};
        const size_t dsts[10] = {WS_WIN, WS_WGLU, WS_WUPS, WS_WUPN, WS_WOUT, WS_WQ, WS_W1K, WS_W1V, WS_W2K, WS_W2V};
        const int Ks[10] = {1024, 512, 512, 512, 1024, 1024, 2048, 2048, 128, 128};
        const int Ns[10] = {INC, 1024, 1024, 1024, 1024, 1024, 128, 128, 64, 64};
        int base = 0;
#pragma unroll
        for (int mtx = 0; mtx < 10; ++mtx) {
            const int K = Ks[mtx], N = Ns[mtx], nblk = (N + 31) / 32, nitems = (K / 64) * nblk;
            const float* W = srcs[mtx]; bf16_t* WT = (bf16_t*)(ws + dsts[mtx]);
            for (int it = gw - base; it < nitems; it += NGW) {
                if (it < 0) continue;
                const int kb = it / nblk, nb = it % nblk, k0 = 64 * kb, n0 = 32 * nb;
                const bool nok = (n0 + (lane & 31)) < N;
#pragma unroll 8
                for (int i = 0; i < 32; ++i) { const int kk = 2 * i + (lane >> 5); scr[kk * 33 + (lane & 31)] = nok ? W[(size_t)(k0 + kk) * N + n0 + (lane & 31)] : 0.f; }
                asm volatile("s_waitcnt lgkmcnt(0)" ::: "memory");
                int r0 = n0;
                if (mtx == 1) { const int bj = n0 >> 9, pn = (n0 >> 7) & 3, i0 = n0 & 127; r0 = 256 * pn + 128 * bj + i0; }
                const int c = lane & 7;
#pragma unroll
                for (int j = 0; j < 4; ++j) { const int n = (lane >> 3) + 8 * j; const LAS float* sp = scr + (8 * c) * 33 + n;
                    u32x4 o; o.x = cvt_pk_bf16(sp[0 * 33], sp[1 * 33]); o.y = cvt_pk_bf16(sp[2 * 33], sp[3 * 33]); o.z = cvt_pk_bf16(sp[4 * 33], sp[5 * 33]); o.w = cvt_pk_bf16(sp[6 * 33], sp[7 * 33]);
                    *(u32x4*)(WT + (size_t)(r0 + n) * K + k0 + 8 * c) = o; }
                asm volatile("s_waitcnt lgkmcnt(0)" ::: "memory");
            }
            base = (base + nitems) % NGW;
        }
        { u32x4* z = (u32x4*)((bf16_t*)(ws + WS_WIN) + (size_t)3872 * 1024); const u32x4 zero = {0u, 0u, 0u, 0u}; for (int i = gtid; i < 224 * 1024 / 8; i += NT) z[i] = zero; }
    }
    { const float* sk = P.in[24]; bf16_t* o = (bf16_t*)(ws + WS_SUBK); for (int i = gtid; i < 8 * 2 * 128 * 64; i += NT) o[i] = f2bf(sk[i]); }
    { const int gw = gtid >> 6, ln = gtid & 63;
      if (gw < 256) { const int kv = gw >> 7, n = gw & 127; const float* pe = P.in[kv ? 16 : 13]; const float* w1 = P.in[kv ? 17 : 14]; float s = 0.f;
        for (int k = ln; k < 2048; k += 64) s += pe[k] * w1[(size_t)k * 128 + n];
        s = wave_sum(s);
        if (ln == 0) ((float*)(ws + (kv ? WS_B1V : WS_B1K)))[n] = s; } }
    const float* a_re = P.in[3]; const float* a_im = P.in[4]; const float* log_dt = P.in[5]; const float* b_re = P.in[6]; const float* b_im = P.in[7]; const float* c_re = P.in[8]; const float* c_im = P.in[9];
    for (int i = gtid; i < 32 * 64 * 65; i += NT) {
        const int lag = i % 65, gp = i / 65, g = gp >> 6; const float dt = expf(log_dt[g]);
        const cpx l = lam_pow(a_re[gp], a_im[gp], dt, (float)lag);
        ((float*)(ws + WS_LP))[2 * i] = l.re; ((float*)(ws + WS_LP))[2 * i + 1] = l.im;
        if (lag == 64) { ((float*)(ws + WS_LAML))[2 * gp] = l.re; ((float*)(ws + WS_LAML))[2 * gp + 1] = l.im; }
        if (lag == 0) { const cpx cf = bbar_coef(a_re[gp], a_im[gp], dt); ((float*)(ws + WS_CF))[2 * gp] = cf.re; ((float*)(ws + WS_CF))[2 * gp + 1] = cf.im; }
    }
}
__device__ __forceinline__ void s5_tables(const Params& P) {
    const int gtid = blockIdx.x * 512 + threadIdx.x, NT = gridDim.x * 512;
    unsigned char* ws = P.ws;
    const float* b_re = P.in[6]; const float* b_im = P.in[7]; const float* c_re = P.in[8]; const float* c_im = P.in[9];
    const float* LP = (const float*)(ws + WS_LP); const float* CF = (const float*)(ws + WS_CF);
    for (int i = gtid; i < 32 * 65 * 16; i += NT) {
        const int h = i & 15, li = (i >> 4) % 65, g = i / (65 * 16); const int lag = li - 1;
        float acc[16];
#pragma unroll
        for (int j = 0; j < 16; ++j) acc[j] = 0.f;
        if (lag >= 0) {
            for (int p = 0; p < 64; ++p) {
                const int gp = g * 64 + p;
                const cpx lp = {LP[2 * (gp * 65 + lag)], LP[2 * (gp * 65 + lag) + 1]}; const cpx cf = {CF[2 * gp], CF[2 * gp + 1]};
                const cpx C = {c_re[(g * 16 + h) * 64 + p], c_im[(g * 16 + h) * 64 + p]};
                const cpx cl = cmul(cmul(C, lp), cf);
#pragma unroll
                for (int j = 0; j < 16; ++j) { const float br = b_re[gp * 16 + j], bi = b_im[gp * 16 + j]; acc[j] += cl.re * br - cl.im * bi; }
            }
        }
        u32x4 w0, w1;
        w0.x = cvt_pk_bf16(acc[0], acc[1]); w0.y = cvt_pk_bf16(acc[2], acc[3]); w0.z = cvt_pk_bf16(acc[4], acc[5]); w0.w = cvt_pk_bf16(acc[6], acc[7]);
        w1.x = cvt_pk_bf16(acc[8], acc[9]); w1.y = cvt_pk_bf16(acc[10], acc[11]); w1.z = cvt_pk_bf16(acc[12], acc[13]); w1.w = cvt_pk_bf16(acc[14], acc[15]);
        u32x4* o = (u32x4*)((bf16_t*)(ws + WS_KTAB) + ((size_t)(g * 65 + li) * 16 + h) * 16); o[0] = w0; o[1] = w1;
    }
    for (int i = gtid; i < 32 * 64 * 64; i += NT) {
        const int sq = i & 63, p = (i >> 6) & 63, g = i >> 12, gp = g * 64 + p;
        const cpx lp = {LP[2 * (gp * 65 + 63 - sq)], LP[2 * (gp * 65 + 63 - sq) + 1]}; const cpx cf = {CF[2 * gp], CF[2 * gp + 1]};
        const cpx f = cmul(lp, cf);
        float vr[16], vi[16];
#pragma unroll
        for (int j = 0; j < 16; ++j) { const float br = b_re[gp * 16 + j], bi = b_im[gp * 16 + j]; vr[j] = f.re * br - f.im * bi; vi[j] = f.re * bi + f.im * br; }
        bf16_t* er = (bf16_t*)(ws + WS_ETAB) + ((size_t)g * 128 + p) * 1024 + sq * 16; bf16_t* ei = er + (size_t)64 * 1024;
        u32x4 w;
        w.x = cvt_pk_bf16(vr[0], vr[1]); w.y = cvt_pk_bf16(vr[2], vr[3]); w.z = cvt_pk_bf16(vr[4], vr[5]); w.w = cvt_pk_bf16(vr[6], vr[7]); ((u32x4*)er)[0] = w;
        w.x = cvt_pk_bf16(vr[8], vr[9]); w.y = cvt_pk_bf16(vr[10], vr[11]); w.z = cvt_pk_bf16(vr[12], vr[13]); w.w = cvt_pk_bf16(vr[14], vr[15]); ((u32x4*)er)[1] = w;
        w.x = cvt_pk_bf16(vi[0], vi[1]); w.y = cvt_pk_bf16(vi[2], vi[3]); w.z = cvt_pk_bf16(vi[4], vi[5]); w.w = cvt_pk_bf16(vi[6], vi[7]); ((u32x4*)ei)[0] = w;
        w.x = cvt_pk_bf16(vi[8], vi[9]); w.y = cvt_pk_bf16(vi[10], vi[11]); w.z = cvt_pk_bf16(vi[12], vi[13]); w.w = cvt_pk_bf16(vi[14], vi[15]); ((u32x4*)ei)[1] = w;
    }
    for (int i = gtid; i < 32 * 64 * 16 * 2; i += NT) {
        const int half = i & 1, h = (i >> 1) & 15, t = (i >> 5) & 63, g = i >> 11;
        bf16_t* f = (bf16_t*)(ws + WS_FTAB) + ((size_t)g * 1024 + t * 16 + h) * 128 + half * 64;
#pragma unroll
        for (int p8 = 0; p8 < 8; ++p8) {
            float v[8];
#pragma unroll
            for (int j = 0; j < 8; ++j) { const int p = p8 * 8 + j, gp = g * 64 + p; const cpx lp = {LP[2 * (gp * 65 + t + 1)], LP[2 * (gp * 65 + t + 1) + 1]};
                const cpx C = {c_re[(g * 16 + h) * 64 + p], c_im[(g * 16 + h) * 64 + p]}; const cpx cl = cmul(C, lp); v[j] = half ? -cl.im : cl.re; }
            u32x4 w; w.x = cvt_pk_bf16(v[0], v[1]); w.y = cvt_pk_bf16(v[2], v[3]); w.z = cvt_pk_bf16(v[4], v[5]); w.w = cvt_pk_bf16(v[6], v[7]);
            ((u32x4*)f)[p8] = w;
        }
    }
}

__device__ __forceinline__ void compress_item(const Params& P, LAS unsigned char* lds, int item) {
    unsigned char* ws = P.ws;
    const int tid = threadIdx.x, lane = tid & 63, w = __builtin_amdgcn_readfirstlane(tid >> 6), fr = lane & 15, q = lane >> 4;
    const int ct = item & 15, g = (item >> 4) & 1, b = (item >> 5) & 3, kv = item >> 7;
    const bf16_t* src = (const bf16_t*)(ws + WS_KV) + (size_t)(kv ? 1 : 0) * T_TOK * 128;
    const bf16_t* W1T = (const bf16_t*)(ws + (kv ? WS_W1V : WS_W1K));
    const bf16_t* W2T = (const bf16_t*)(ws + (kv ? WS_W2V : WS_W2K));
    const float* bias1 = (const float*)(ws + (kv ? WS_B1V : WS_B1K));
    bf16_t* dst = (bf16_t*)(ws + (kv ? WS_VC : WS_KC));
    const int c = ct * 16 + fr;
    f32x4 acc = {0.f, 0.f, 0.f, 0.f};
    const bf16_t* brow = W1T + (size_t)(16 * w + fr) * 2048 + 8 * q;
#pragma unroll 4
    for (int kk = 0; kk < 64; ++kk) {
        const int l = kk >> 1, d = (kk & 1) * 32 + 8 * q; int tok = 16 * c + l; tok = tok > 4095 ? 4095 : tok;
        const bf16x8 A = *(const bf16x8*)(src + ((size_t)(b * 4096 + tok)) * 128 + g * 64 + d);
        const bf16x8 B = *(const bf16x8*)(brow + kk * 32);
        acc = __builtin_amdgcn_mfma_f32_16x16x32_bf16(A, B, acc, 0, 0, 0);
    }
    LAS bf16_t* H1 = (LAS bf16_t*)lds;
    { const int col = 16 * w + fr; const float bb = bias1[col];
#pragma unroll
      for (int r = 0; r < 4; ++r) H1[(4 * q + r) * 136 + col] = f2bf(gelu_tanh(acc[r] + bb)); }
    __syncthreads();
    if (w < 4) {
        f32x4 a2 = {0.f, 0.f, 0.f, 0.f};
#pragma unroll
        for (int kk = 0; kk < 4; ++kk) {
            const bf16x8 A = *(const LAS bf16x8*)(H1 + fr * 136 + kk * 32 + 8 * q);
            const bf16x8 B = *(const bf16x8*)(W2T + (size_t)(16 * w + fr) * 128 + kk * 32 + 8 * q);
            a2 = __builtin_amdgcn_mfma_f32_16x16x32_bf16(A, B, a2, 0, 0, 0);
        }
#pragma unroll
        for (int r = 0; r < 4; ++r) dst[((size_t)((b * 2 + g) * 256 + ct * 16 + 4 * q + r)) * 64 + 16 * w + fr] = f2bf(a2[r]);
    }
    __syncthreads();
}

constexpr int S5_KT_OFF = 0;
constexpr int S5_UB_OFF = 33280;
constexpr int S5_XE_OFF = S5_UB_OFF + 33024;
constexpr int S5_XIN_OFF = S5_XE_OFF + 8192;
__device__ __forceinline__ void s5_item(const Params& P, LAS unsigned char* lds, int g, int b) {
    unsigned char* ws = P.ws;
    const int tid = threadIdx.x, lane = tid & 63, w = __builtin_amdgcn_readfirstlane(tid >> 6), fr = lane & 15, q = lane >> 4;
    const bf16_t* UGp = (const bf16_t*)(ws + WS_UG) + ((size_t)(b * 32 + g) * 4096) * 16;
    const bf16_t* ET = (const bf16_t*)(ws + WS_ETAB) + (size_t)g * 128 * 1024;
    const bf16_t* FT = (const bf16_t*)(ws + WS_FTAB) + (size_t)g * 1024 * 128;
    bf16_t* YG = (bf16_t*)(ws + WS_YG);
    const float* dsk = P.in[10];
    { const u32x4* src = (const u32x4*)((const bf16_t*)(ws + WS_KTAB) + (size_t)g * 65 * 256);
      for (int i = tid; i < 33280 / 16; i += 512) *(LAS u32x4*)(lds + S5_KT_OFF + i * 16) = src[i]; }
    float st_re = 0.f, st_im = 0.f, lr = 0.f, li = 0.f;
    if (tid < 64) { const float* ll = (const float*)(ws + WS_LAML) + (size_t)(g * 64 + tid) * 2; lr = ll[0]; li = ll[1]; }
    float dval[4];
#pragma unroll
    for (int r = 0; r < 4; ++r) dval[r] = dsk[g * 16 + 4 * q + r];
    LAS float* XE = (LAS float*)(lds + S5_XE_OFF);
    LAS bf16_t* XIN = (LAS bf16_t*)(lds + S5_XIN_OFF);
    for (int batch = 0; batch < 4; ++batch) {
        __syncthreads();
        { const u32x4* src = (const u32x4*)(UGp + (size_t)batch * 1024 * 16);
#pragma unroll
          for (int i = 0; i < 4; ++i) { const int pc = tid + i * 512; *(LAS u32x4*)(lds + S5_UB_OFF + (pc >> 7) * 2064 + (pc & 127) * 16) = src[pc]; } }
        __syncthreads();
        {
            f32x4 acc = {0.f, 0.f, 0.f, 0.f};
            const bf16_t* arow = ET + (size_t)(16 * w + fr) * 1024 + 8 * q;
            const LAS unsigned char* bb = lds + S5_UB_OFF + fr * 2064 + (q >> 1) * 32 + (q & 1) * 16;
#pragma unroll 4
            for (int kk = 0; kk < 32; ++kk) {
                const bf16x8 A = *(const bf16x8*)(arow + kk * 32);
                const bf16x8 B = *(const LAS bf16x8*)(bb + kk * 64);
                acc = __builtin_amdgcn_mfma_f32_16x16x32_bf16(A, B, acc, 0, 0, 0);
            }
#pragma unroll
            for (int r = 0; r < 4; ++r) XE[(16 * w + 4 * q + r) * 16 + fr] = acc[r];
        }
        __syncthreads();
        if (tid < 64) {
            for (int c = 0; c < 16; ++c) {
                XIN[c * 136 + tid] = f2bf(st_re); XIN[c * 136 + 64 + tid] = f2bf(st_im);
                const float xr = XE[tid * 16 + c], xi = XE[(64 + tid) * 16 + c];
                const float nr = lr * st_re - li * st_im + xr, ni = lr * st_im + li * st_re + xi;
                st_re = nr; st_im = ni;
            }
        }
        __syncthreads();
        for (int t = w; t < 64; t += 8) {
            f32x4 acc = {0.f, 0.f, 0.f, 0.f};
            const LAS unsigned char* bb = lds + S5_UB_OFF + fr * 2064 + (q >> 1) * 32 + (q & 1) * 16;
            const LAS unsigned char* ka = lds + S5_KT_OFF + ((t + 1 - (q >> 1)) * 256 + fr * 16 + (q & 1) * 8) * 2;
            const int nk = (t >> 1) + 1;
            for (int kk = 0; kk < nk; ++kk) {
                const bf16x8 A = *(const LAS bf16x8*)(ka - kk * 1024);
                const bf16x8 B = *(const LAS bf16x8*)(bb + kk * 64);
                acc = __builtin_amdgcn_mfma_f32_16x16x32_bf16(A, B, acc, 0, 0, 0);
            }
            const bf16_t* frow = FT + (size_t)(t * 16 + fr) * 128 + 8 * q;
#pragma unroll
            for (int kk = 0; kk < 4; ++kk) {
                const bf16x8 A = *(const bf16x8*)(frow + kk * 32);
                const bf16x8 B = *(const LAS bf16x8*)(XIN + fr * 136 + kk * 32 + 8 * q);
                acc = __builtin_amdgcn_mfma_f32_16x16x32_bf16(A, B, acc, 0, 0, 0);
            }
            const u32x2 uu = *(const LAS u32x2*)(lds + S5_UB_OFF + fr * 2064 + t * 32 + q * 8);
            float y0 = acc[0] + dval[0] * bf_lo(uu.x), y1 = acc[1] + dval[1] * bf_hi(uu.x), y2 = acc[2] + dval[2] * bf_lo(uu.y), y3 = acc[3] + dval[3] * bf_hi(uu.y);
            u32x2 o; o.x = cvt_pk_bf16(gelu_tanh(y0), gelu_tanh(y1)); o.y = cvt_pk_bf16(gelu_tanh(y2), gelu_tanh(y3));
            const int tok = batch * 1024 + fr * 64 + t;
            *(u32x2*)(YG + ((size_t)(b * 4096 + tok)) * 512 + g * 16 + 4 * q) = o;
        }
    }
    __syncthreads();
}

constexpr int AT_K_OFF = 0;
constexpr int AT_V_OFF = 9216;
constexpr int AT_IMP_OFF = 18432;
constexpr int AT_SEL_OFF = AT_IMP_OFF + 65536;
__device__ __forceinline__ void load_tile64(LAS unsigned char* buf, const bf16_t* src, size_t row0, int rowstride, int coloff, int tid) {
    const u32x4 v = *(const u32x4*)(src + (row0 + (tid >> 3)) * rowstride + coloff + (tid & 7) * 8);
    *(LAS u32x4*)(buf + (tid >> 3) * 144 + (tid & 7) * 16) = v;
}
__device__ __forceinline__ void qk_tile(const LAS unsigned char* kbuf, const bf16x8 (&bq)[4], int lane, f32x16 (&st)[2]) {
    const int r = lane & 31, hh = lane >> 5;
#pragma unroll
    for (int kt = 0; kt < 2; ++kt) {
        f32x16 a = {0.f, 0.f, 0.f, 0.f, 0.f, 0.f, 0.f, 0.f, 0.f, 0.f, 0.f, 0.f, 0.f, 0.f, 0.f, 0.f};
#pragma unroll
        for (int ks = 0; ks < 4; ++ks) {
            const bf16x8 kf = *(const LAS bf16x8*)(kbuf + (32 * kt + r) * 144 + (16 * ks + 8 * hh) * 2);
            a = __builtin_amdgcn_mfma_f32_32x32x16_bf16(kf, bq[ks], a, 0, 0, 0);
        }
        st[kt] = a;
    }
}
__device__ __forceinline__ void pv_tile(const LAS unsigned char* vbuf, const f32x16 (&p)[2], int lane, f32x16 (&o)[2]) {
    const int hh = lane >> 5, i = lane & 15, d0 = 16 * ((lane >> 4) & 1), qq = i >> 2, pp = i & 3;
#pragma unroll
    for (int kt = 0; kt < 2; ++kt)
#pragma unroll
        for (int s = 0; s < 2; ++s) {
            u32x4 pw; pw.x = cvt_pk_bf16(p[kt][8 * s + 0], p[kt][8 * s + 1]); pw.y = cvt_pk_bf16(p[kt][8 * s + 2], p[kt][8 * s + 3]);
            pw.z = cvt_pk_bf16(p[kt][8 * s + 4], p[kt][8 * s + 5]); pw.w = cvt_pk_bf16(p[kt][8 * s + 6], p[kt][8 * s + 7]);
            const bf16x8 pb = __builtin_bit_cast(bf16x8, pw);
            const int kb = 32 * kt + 16 * s + 4 * hh;
#pragma unroll
            for (int dt = 0; dt < 2; ++dt) {
                const LAS unsigned char* a0 = vbuf + (kb + qq) * 144 + (32 * dt + d0 + 4 * pp) * 2;
                const s16x4 v0 = __builtin_amdgcn_ds_read_tr16_b64_v4i16((LAS s16x4*)a0);
                const s16x4 v1 = __builtin_amdgcn_ds_read_tr16_b64_v4i16((LAS s16x4*)(a0 + 8 * 144));
                bf16x8 va; va[0] = v0[0]; va[1] = v0[1]; va[2] = v0[2]; va[3] = v0[3]; va[4] = v1[0]; va[5] = v1[1]; va[6] = v1[2]; va[7] = v1[3];
                o[dt] = __builtin_amdgcn_mfma_f32_32x32x16_bf16(va, pb, o[dt], 0, 0, 0);
            }
        }
}
template <bool WIN, int CM>
__device__ __forceinline__ float mask_scores(f32x16 (&st)[2], float fdl, float nslope2) {
    float mx = -3.0e38f;
#pragma unroll
    for (int kt = 0; kt < 2; ++kt)
#pragma unroll
        for (int reg = 0; reg < 16; ++reg) {
            const float distf = fdl - (float)(CM * (32 * kt + (reg & 3) + 8 * (reg >> 2)));
            float s2 = __builtin_fmaf(distf, nslope2, st[kt][reg]);
            if (WIN) { const float d = distf - __builtin_amdgcn_fmed3f(distf, 0.0f, 511.0f); s2 = __builtin_fmaf(-__builtin_fabsf(d), 3.0e38f, s2); }
            else s2 = __builtin_fmaf(__builtin_fminf(distf, 0.0f), 3.0e38f, s2);
            st[kt][reg] = s2; mx = fmaxf(mx, s2);
        }
    return fmaxf(mx, __shfl_xor(mx, 32));
}
template <bool WIN>
__device__ __forceinline__ void online_block(const LAS unsigned char* kbuf, const LAS unsigned char* vbuf, const bf16x8 (&bq)[4], int lane, float fdl, float nslope2,
                                             float& m, float& l, f32x16 (&o)[2]) {
    f32x16 st[2];
    qk_tile(kbuf, bq, lane, st);
    const float mx = mask_scores<WIN, 1>(st, fdl, nslope2);
    const float mn = fmaxf(m, mx), alpha = fast_exp2(m - mn); m = mn;
    float sum = 0.f;
#pragma unroll
    for (int kt = 0; kt < 2; ++kt)
#pragma unroll
        for (int reg = 0; reg < 16; ++reg) { const float pv = fast_exp2(st[kt][reg] - mn); st[kt][reg] = pv; sum += pv; }
    l = l * alpha + sum;
#pragma unroll
    for (int dt = 0; dt < 2; ++dt)
#pragma unroll
        for (int reg = 0; reg < 16; ++reg) o[dt][reg] *= alpha;
    pv_tile(vbuf, st, lane, o);
}
__device__ __forceinline__ void attn_item(const Params& P, LAS unsigned char* lds, int b, int g, int qt) {
    unsigned char* ws = P.ws;
    const int tid = threadIdx.x, lane = tid & 63, w = __builtin_amdgcn_readfirstlane(tid >> 6);
    const int r = w & 3, qhalf = w >> 2, hh = lane >> 5, ql = 32 * qhalf + (lane & 31);
    const int tq = 64 * qt + ql, hd = g * 4 + r;
    const size_t rowq = (size_t)b * 4096 + tq;
    const bf16_t* Qp = (const bf16_t*)(ws + WS_Q);
    const bf16_t* KVp = (const bf16_t*)(ws + WS_KV);
    const bf16_t* KC = (const bf16_t*)(ws + WS_KC) + (size_t)(b * 2 + g) * 256 * 64;
    const bf16_t* VC = (const bf16_t*)(ws + WS_VC) + (size_t)(b * 2 + g) * 256 * 64;
    const float* GT = (const float*)(ws + WS_GATES);
    LAS unsigned char* kbuf = lds + AT_K_OFF; LAS unsigned char* vbuf = lds + AT_V_OFF;
    LAS float* IMP = (LAS float*)(lds + AT_IMP_OFF);
    LAS unsigned long long* SEL = (LAS unsigned long long*)(lds + AT_SEL_OFF);
    bf16x8 bq[4];
#pragma unroll
    for (int ks = 0; ks < 4; ++ks) bq[ks] = *(const bf16x8*)(Qp + rowq * 512 + hd * 64 + 16 * ks + 8 * hh);
    const float nslope2 = -exp2f(-(float)(hd + 1)) * LOG2E;
    const float gc = ABL_NOCMP ? 0.f : GT[rowq * 24 + g * 12 + r * 3 + 0], gs = ABL_NOSLC ? 0.f : GT[rowq * 24 + g * 12 + r * 3 + 1], gw = ABL_NOWIN ? 0.f : GT[rowq * 24 + g * 12 + r * 3 + 2];
    f32x16 tot[2];
#pragma unroll
    for (int dt = 0; dt < 2; ++dt)
#pragma unroll
        for (int reg = 0; reg < 16; ++reg) tot[dt][reg] = 0.f;

    const int ncb = ((4 * qt + 2) >> 6) + 1;
    float m = -1e30f, l = 0.f;
    for (int cb = 0; cb < ncb; ++cb) {
        __syncthreads();
        load_tile64(kbuf, KC, (size_t)cb * 64, 64, 0, tid);
        __syncthreads();
        f32x16 st[2];
        qk_tile(kbuf, bq, lane, st);
        const int dl = tq - 31 - 1024 * cb - 64 * hh;
        const float mx = mask_scores<false, 16>(st, (float)dl, nslope2);
        const float mn = fmaxf(m, mx), alpha = fast_exp2(m - mn); m = mn;
        float sum = 0.f;
#pragma unroll
        for (int kt = 0; kt < 2; ++kt)
#pragma unroll
            for (int reg = 0; reg < 16; ++reg) sum += fast_exp2(st[kt][reg] - mn);
        l = l * alpha + sum;
    }
    {
        const float ltot = l + __shfl_xor(l, 32);
        const float inv = 1.0f / fmaxf(ltot, 1e-30f);
        f32x16 o[2];
#pragma unroll
        for (int dt = 0; dt < 2; ++dt)
#pragma unroll
            for (int reg = 0; reg < 16; ++reg) o[dt][reg] = 0.f;
        float carry = 0.f;
        for (int cb = 0; cb < 4; ++cb) {
            if (cb < ncb) {
                __syncthreads();
                load_tile64(kbuf, KC, (size_t)cb * 64, 64, 0, tid);
                load_tile64(vbuf, VC, (size_t)cb * 64, 64, 0, tid);
                __syncthreads();
                f32x16 st[2];
                qk_tile(kbuf, bq, lane, st);
                const int dl = tq - 31 - 1024 * cb - 64 * hh;
                (void)mask_scores<false, 16>(st, (float)dl, nslope2);
#pragma unroll
                for (int kt = 0; kt < 2; ++kt)
#pragma unroll
                    for (int reg = 0; reg < 16; ++reg) st[kt][reg] = fast_exp2(st[kt][reg] - m) * inv;
                float pv3[2][4];
#pragma unroll
                for (int kt = 0; kt < 2; ++kt)
#pragma unroll
                    for (int i = 0; i < 4; ++i) pv3[kt][i] = __shfl_xor(st[kt][4 * i + 3], 32);
#pragma unroll
                for (int kt = 0; kt < 2; ++kt)
#pragma unroll
                    for (int i = 0; i < 4; ++i) {
                        const float s4 = (st[kt][4 * i] + st[kt][4 * i + 1]) + (st[kt][4 * i + 2] + st[kt][4 * i + 3]);
                        const float prev0 = (i > 0) ? pv3[kt][i > 0 ? i - 1 : 0] : (kt > 0 ? pv3[0][3] : carry);
                        const float prev = hh ? pv3[kt][i] : prev0;
                        IMP[(r * 64 + ql) * 64 + 16 * cb + 8 * kt + 2 * i + hh] = s4 + prev;
                    }
                carry = pv3[1][3];
                pv_tile(vbuf, st, lane, o);
            } else {
#pragma unroll
                for (int kt = 0; kt < 2; ++kt)
#pragma unroll
                    for (int i = 0; i < 4; ++i) {
                        const float prev = (!hh && kt == 0 && i == 0) ? carry : 0.f;
                        IMP[(r * 64 + ql) * 64 + 16 * cb + 8 * kt + 2 * i + hh] = prev;
                    }
                carry = 0.f;
            }
        }
#pragma unroll
        for (int dt = 0; dt < 2; ++dt)
#pragma unroll
            for (int reg = 0; reg < 16; ++reg) tot[dt][reg] = gc * o[dt][reg];
    }
    __syncthreads();
    {
        const int cur = qt, j = lane;
        for (int qi = 0; qi < 8; ++qi) {
            const int qq = 8 * w + qi;
            const float sc = ((IMP[(0 * 64 + qq) * 64 + j] + IMP[(1 * 64 + qq) * 64 + j]) + IMP[(2 * 64 + qq) * 64 + j]) + IMP[(3 * 64 + qq) * 64 + j];
            const bool valid = j <= cur, forced = (j == 0) || (j == cur) || (j == cur - 1);
            const float key = forced ? 3.0e38f : (valid ? sc : -1.0f);
            int cnt = 0;
            for (int jp = 0; jp <= cur; ++jp) {
                const float sj = __uint_as_float(__builtin_amdgcn_readlane(__float_as_uint(key), jp));
                cnt += ((sj > key) || (sj == key && jp < j)) ? 1 : 0;
            }
            const unsigned long long msk = __ballot(valid && cnt < 16);
            if (lane == 0) SEL[qq] = msk;
        }
    }
    __syncthreads();
    const unsigned long long mymask = SEL[ql];
    unsigned long long uni = SEL[lane];
#pragma unroll
    for (int o_ = 1; o_ < 64; o_ <<= 1) uni |= __shfl_xor(uni, o_);
    const unsigned uni_lo = __builtin_amdgcn_readfirstlane((unsigned)uni), uni_hi = __builtin_amdgcn_readfirstlane((unsigned)(uni >> 32));
    {
        float ms = -1e30f, ls = 0.f; f32x16 o[2];
#pragma unroll
        for (int dt = 0; dt < 2; ++dt)
#pragma unroll
            for (int reg = 0; reg < 16; ++reg) o[dt][reg] = 0.f;
        const bf16_t* Ks = KVp + (size_t)2 * T_TOK * 128; const bf16_t* Vs = KVp + (size_t)3 * T_TOK * 128;
        for (int j = 0; j <= qt; ++j) {
            const unsigned bit = j < 32 ? (uni_lo >> j) & 1u : (uni_hi >> (j - 32)) & 1u;
            if (!bit) continue;
            __syncthreads();
            load_tile64(kbuf, Ks, (size_t)b * 4096 + 64 * j, 128, g * 64, tid);
            load_tile64(vbuf, Vs, (size_t)b * 4096 + 64 * j, 128, g * 64, tid);
            __syncthreads();
            const bool ok = (mymask >> j) & 1ull;
            online_block<false>(kbuf, vbuf, bq, lane, ok ? (float)(tq - 64 * j - 4 * hh) : -1.0e6f, nslope2, ms, ls, o);
        }
        const float ltot = ls + __shfl_xor(ls, 32); const float sc = gs / fmaxf(ltot, 1e-30f);
#pragma unroll
        for (int dt = 0; dt < 2; ++dt)
#pragma unroll
            for (int reg = 0; reg < 16; ++reg) tot[dt][reg] += sc * o[dt][reg];
    }
    {
        float mw = -1e30f, lw = 0.f; f32x16 o[2];
#pragma unroll
        for (int dt = 0; dt < 2; ++dt)
#pragma unroll
            for (int reg = 0; reg < 16; ++reg) o[dt][reg] = 0.f;
        const bf16_t* Kw = KVp + (size_t)4 * T_TOK * 128; const bf16_t* Vw = KVp + (size_t)5 * T_TOK * 128;
        const int j0 = qt - 8 > 0 ? qt - 8 : 0;
        for (int j = j0; j <= qt; ++j) {
            __syncthreads();
            load_tile64(kbuf, Kw, (size_t)b * 4096 + 64 * j, 128, g * 64, tid);
            load_tile64(vbuf, Vw, (size_t)b * 4096 + 64 * j, 128, g * 64, tid);
            __syncthreads();
            online_block<true>(kbuf, vbuf, bq, lane, (float)(tq - 64 * j - 4 * hh), nslope2, mw, lw, o);
        }
        const float ltot = lw + __shfl_xor(lw, 32); const float sc = gw / fmaxf(ltot, 1e-30f);
#pragma unroll
        for (int dt = 0; dt < 2; ++dt)
#pragma unroll
            for (int reg = 0; reg < 16; ++reg) tot[dt][reg] += sc * o[dt][reg];
    }
    {
        bf16_t* O = (bf16_t*)(ws + WS_O) + rowq * 512 + hd * 64;
#pragma unroll
        for (int dt = 0; dt < 2; ++dt)
#pragma unroll
            for (int rg = 0; rg < 4; ++rg) {
                u32x2 v; v.x = cvt_pk_bf16(tot[dt][4 * rg], tot[dt][4 * rg + 1]); v.y = cvt_pk_bf16(tot[dt][4 * rg + 2], tot[dt][4 * rg + 3]);
                *(u32x2*)(O + 32 * dt + 8 * rg + 4 * hh) = v;
            }
    }
    __syncthreads();
}

__device__ __forceinline__ unsigned f2ord(float f) { const unsigned u = __float_as_uint(f); return u ^ ((unsigned)((int)u >> 31) | 0x80000000u); }
__device__ __forceinline__ float ord2f(unsigned o) { const unsigned u = (o & 0x80000000u) ? (o ^ 0x80000000u) : ~o; return __uint_as_float(u); }
__device__ __forceinline__ void ins16(unsigned (&L)[16], unsigned x) {
#pragma unroll
    for (int i = 0; i < 16; ++i) { const unsigned hi = L[i] > x ? L[i] : x; x = L[i] > x ? x : L[i]; L[i] = hi; }
}
__device__ __forceinline__ void peer_score_item(const Params& P, LAS unsigned char* lds, int item, int w, int lane) {
    unsigned char* ws = P.ws;
    const int t0 = (item >> 3) * 32, h = item & 7, r = lane & 31, hh = lane >> 5;
    const bf16_t* QP = (const bf16_t*)(ws + WS_QP);
    const bf16_t* SK = (const bf16_t*)(ws + WS_SUBK);
    LAS unsigned char* IDX = lds + w * 1024;
    unsigned Lc[2][16];
#pragma unroll
    for (int c = 0; c < 2; ++c) {
        bf16x8 bq[4];
#pragma unroll
        for (int ks = 0; ks < 4; ++ks) bq[ks] = *(const bf16x8*)(QP + (size_t)(t0 + r) * 1024 + h * 128 + c * 64 + 16 * ks + 8 * hh);
        unsigned L[16];
#pragma unroll
        for (int i = 0; i < 16; ++i) L[i] = 0u;
#pragma unroll
        for (int kt = 0; kt < 4; ++kt) {
            f32x16 a = {0.f, 0.f, 0.f, 0.f, 0.f, 0.f, 0.f, 0.f, 0.f, 0.f, 0.f, 0.f, 0.f, 0.f, 0.f, 0.f};
#pragma unroll
            for (int ks = 0; ks < 4; ++ks) {
                const bf16x8 kf = *(const bf16x8*)(SK + ((size_t)((h * 2 + c) * 128 + 32 * kt + r)) * 64 + 16 * ks + 8 * hh);
                a = __builtin_amdgcn_mfma_f32_32x32x16_bf16(kf, bq[ks], a, 0, 0, 0);
            }
#pragma unroll
            for (int reg = 0; reg < 16; ++reg) {
                const int key0 = 32 * kt + 8 * (reg >> 2) + (reg & 3);
                const unsigned low = (unsigned)(127 ^ key0) ^ (unsigned)(4 * hh);
                ins16(L, (f2ord(a[reg]) & ~127u) | low);
            }
        }
        unsigned tmp[16];
#pragma unroll
        for (int i = 0; i < 16; ++i) tmp[i] = __shfl_xor(L[i], 32);
#pragma unroll
        for (int i = 0; i < 16; ++i) ins16(L, tmp[i]);
#pragma unroll
        for (int i = 0; i < 16; ++i) Lc[c][i] = L[i];
        if (hh == 0) {
#pragma unroll
            for (int i = 0; i < 16; ++i) IDX[(r * 2 + c) * 16 + i] = (unsigned char)(127u - (L[i] & 127u));
        }
    }
    unsigned best[16];
#pragma unroll
    for (int i = 0; i < 16; ++i) best[i] = 0u;
#pragma unroll
    for (int i = 0; i < 16; ++i) {
        const float v0 = ord2f(Lc[0][i] & ~127u);
#pragma unroll
        for (int j = 0; j < 16; ++j) {
            if ((i + 1) * (j + 1) <= 16) {
                const float s = v0 + ord2f(Lc[1][j] & ~127u);
                ins16(best, (f2ord(s) & ~255u) | (unsigned)(255 - (i * 16 + j)));
            }
        }
    }
    const float mv = ord2f(best[0] & ~255u);
    float e[16], sum = 0.f;
#pragma unroll
    for (int k = 0; k < 16; ++k) { e[k] = fast_exp2((ord2f(best[k] & ~255u) - mv) * LOG2E); sum += e[k]; }
    const float inv = 1.0f / sum;
    asm volatile("s_waitcnt lgkmcnt(0)" ::: "memory");
    if (hh == 0) {
        u32x2* out = (u32x2*)(ws + WS_PK) + ((size_t)(t0 + r) * 8 + h) * 16;
#pragma unroll
        for (int k = 0; k < 16; ++k) {
            const unsigned flat = 255u - (best[k] & 255u); const unsigned i = flat >> 4, j = flat & 15u;
            const unsigned e0 = IDX[(r * 2 + 0) * 16 + i], e1 = IDX[(r * 2 + 1) * 16 + j];
            u32x2 v; v.x = e0 * 128u + e1; v.y = __float_as_uint(e[k] * inv); out[k] = v;
        }
    }
}

__device__ __forceinline__ void peer_token(const Params& P, int tok, int lane, float* outbase) {
    unsigned char* ws = P.ws;
    float* X1 = P.out + (size_t)tok * 1024 + lane * 16;
    const f32x4 xa = ((const f32x4*)X1)[0], xb = ((const f32x4*)X1)[1], xc = ((const f32x4*)X1)[2], xd = ((const f32x4*)X1)[3];
    float xr[16] = {xa[0], xa[1], xa[2], xa[3], xb[0], xb[1], xb[2], xb[3], xc[0], xc[1], xc[2], xc[3], xd[0], xd[1], xd[2], xd[3]};
    h16x2 xh[8];
#pragma unroll
    for (int i = 0; i < 8; ++i) { xh[i].x = (_Float16)xr[2 * i]; xh[i].y = (_Float16)xr[2 * i + 1]; }
    const u32x2* pk = (const u32x2*)(ws + WS_PK) + (size_t)tok * 128;
    const u32x2 p0 = pk[lane], p1 = pk[64 + lane];
    const unsigned char* UT = ws + WS_UTAB + lane * 32; const unsigned char* VT = ws + WS_VTAB + lane * 32;
    float h0 = 0.f, h1 = 0.f;
    for (int k = 0; k < 128; k += 2) {
        const unsigned ea = __builtin_amdgcn_readlane(k < 64 ? p0.x : p1.x, k & 63), eb = __builtin_amdgcn_readlane(k < 64 ? p0.x : p1.x, (k + 1) & 63);
        const u32x4 a0 = *(const u32x4*)(UT + (size_t)ea * 2048), a1 = *(const u32x4*)(UT + (size_t)ea * 2048 + 16);
        const u32x4 b0 = *(const u32x4*)(UT + (size_t)eb * 2048), b1 = *(const u32x4*)(UT + (size_t)eb * 2048 + 16);
        float da = 0.f, db = 0.f;
        {
            const unsigned aw[8] = {a0.x, a0.y, a0.z, a0.w, a1.x, a1.y, a1.z, a1.w}, bw[8] = {b0.x, b0.y, b0.z, b0.w, b1.x, b1.y, b1.z, b1.w};
#pragma unroll
            for (int i = 0; i < 8; ++i) {
                const h16x2 va = __builtin_bit_cast(h16x2, aw[i]), vb = __builtin_bit_cast(h16x2, bw[i]);
                da = __builtin_fmaf((float)va.x, xr[2 * i], da); da = __builtin_fmaf((float)va.y, xr[2 * i + 1], da);
                db = __builtin_fmaf((float)vb.x, xr[2 * i], db); db = __builtin_fmaf((float)vb.y, xr[2 * i + 1], db);
            }
        }
        da = wave_sum(da); db = wave_sum(db);
        if (k < 64) { h0 = (lane == k) ? da : h0; h0 = (lane == k + 1) ? db : h0; } else { h1 = (lane == k - 64) ? da : h1; h1 = (lane == k - 63) ? db : h1; }
    }
        const float w0 = __uint_as_float(p0.y) * (ABL_NOH ? 1.f : gelu_tanh(h0)), w1 = __uint_as_float(p1.y) * (ABL_NOH ? 1.f : gelu_tanh(h1));
    float acc[16];
#pragma unroll
    for (int i = 0; i < 16; ++i) acc[i] = 0.f;
    for (int k = 0; k < 128; k += 2) {
        const unsigned ea = __builtin_amdgcn_readlane(k < 64 ? p0.x : p1.x, k & 63), eb = __builtin_amdgcn_readlane(k < 64 ? p0.x : p1.x, (k + 1) & 63);
        const float wa = __uint_as_float(__builtin_amdgcn_readlane(__float_as_uint(k < 64 ? w0 : w1), k & 63)), wb = __uint_as_float(__builtin_amdgcn_readlane(__float_as_uint(k < 64 ? w0 : w1), (k + 1) & 63));
        const u32x4 a0 = *(const u32x4*)(VT + (size_t)ea * 2048), a1 = *(const u32x4*)(VT + (size_t)ea * 2048 + 16);
        const u32x4 b0 = *(const u32x4*)(VT + (size_t)eb * 2048), b1 = *(const u32x4*)(VT + (size_t)eb * 2048 + 16);
        const unsigned aw[8] = {a0.x, a0.y, a0.z, a0.w, a1.x, a1.y, a1.z, a1.w}, bw[8] = {b0.x, b0.y, b0.z, b0.w, b1.x, b1.y, b1.z, b1.w};
#pragma unroll
        for (int i = 0; i < 8; ++i) {
            const h16x2 va = __builtin_bit_cast(h16x2, aw[i]), vb = __builtin_bit_cast(h16x2, bw[i]);
            acc[2 * i] = __builtin_fmaf((float)va.x, wa, acc[2 * i]); acc[2 * i + 1] = __builtin_fmaf((float)va.y, wa, acc[2 * i + 1]);
            acc[2 * i] = __builtin_fmaf((float)vb.x, wb, acc[2 * i]); acc[2 * i + 1] = __builtin_fmaf((float)vb.y, wb, acc[2 * i + 1]);
        }
    }
    float s = 0.f;
#pragma unroll
    for (int i = 0; i < 16; ++i) { acc[i] = DN_ALPHA * xr[i] + (ABL_NOPEER ? 0.f : acc[i]); s += acc[i]; }
    const float mean = wave_sum(s) * (1.0f / 1024.0f); float s2 = 0.f;
#pragma unroll
    for (int i = 0; i < 16; ++i) { acc[i] -= mean; s2 += acc[i] * acc[i]; }
    const float rstd = 1.0f / sqrtf(wave_sum(s2) * (1.0f / 1024.0f) + LN_EPS);
    const float* g2 = P.in[27] + lane * 16; const float* b2 = P.in[28] + lane * 16;
#pragma unroll
    for (int i = 0; i < 4; ++i) {
        const f32x4 gg = ((const f32x4*)g2)[i], bb = ((const f32x4*)b2)[i]; f32x4 o;
#pragma unroll
        for (int j = 0; j < 4; ++j) o[j] = acc[4 * i + j] * rstd * gg[j] + bb[j];
        ((f32x4*)(outbase + (size_t)tok * 1024 + lane * 16))[i] = o;
    }
}


__device__ __forceinline__ float dpp_add(float v, const int ctrl_sel) {
    const int b = __float_as_int(v); int r;
    if (ctrl_sel == 0) r = __builtin_amdgcn_update_dpp(0, b, 0xB1, 0xf, 0xf, false);
    else if (ctrl_sel == 1) r = __builtin_amdgcn_update_dpp(0, b, 0x4E, 0xf, 0xf, false);
    else if (ctrl_sel == 2) r = __builtin_amdgcn_update_dpp(0, b, 0x141, 0xf, 0xf, false);
    else if (ctrl_sel == 3) r = __builtin_amdgcn_update_dpp(0, b, 0x140, 0xf, 0xf, false);
    else if (ctrl_sel == 4) r = __builtin_amdgcn_update_dpp(0, b, 0x142, 0xa, 0xf, false);
    else r = __builtin_amdgcn_update_dpp(0, b, 0x143, 0xc, 0xf, false);
    return v + __int_as_float(r);
}
__device__ __forceinline__ float wave_total(float v) {
    v = dpp_add(v, 0); v = dpp_add(v, 1); v = dpp_add(v, 2); v = dpp_add(v, 3); v = dpp_add(v, 4); v = dpp_add(v, 5);
    return __int_as_float(__builtin_amdgcn_readlane(__float_as_int(v), 63));
}
typedef float f32x2_t __attribute__((ext_vector_type(2)));
__device__ __forceinline__ float dot16_8(const u32x4& a, const h16x2 (&x)[8]) {
    const unsigned aw[4] = {a.x, a.y, a.z, a.w}; float d = 0.f;
#pragma unroll
    for (int i = 0; i < 4; ++i) {
        const f32x2_t lo = __builtin_amdgcn_cvt_pk_f32_fp8((int)aw[i], false), hi = __builtin_amdgcn_cvt_pk_f32_fp8((int)aw[i], true);
        d = __builtin_fmaf(lo.x, (float)x[2 * i].x, d); d = __builtin_fmaf(lo.y, (float)x[2 * i].y, d); d = __builtin_fmaf(hi.x, (float)x[2 * i + 1].x, d); d = __builtin_fmaf(hi.y, (float)x[2 * i + 1].y, d);
    }
    return d;
}
__device__ __forceinline__ void axpy16_h(const u32x4& a0, const u32x4& a1, float w, float (&acc)[16]) {
    const unsigned aw[8] = {a0.x, a0.y, a0.z, a0.w, a1.x, a1.y, a1.z, a1.w};
#pragma unroll
    for (int i = 0; i < 8; ++i) { const h16x2 va = __builtin_bit_cast(h16x2, aw[i]); acc[2 * i] = __builtin_fmaf((float)va.x, w, acc[2 * i]); acc[2 * i + 1] = __builtin_fmaf((float)va.y, w, acc[2 * i + 1]); }
}
__device__ __forceinline__ void peer_round(const Params& P, LAS unsigned char* wl, int tok0, int lane) {
    unsigned char* ws = P.ws;
    LAS u32x2* sorted = (LAS u32x2*)wl;
    LAS unsigned* cnt = (LAS unsigned*)(wl + 4096);
    LAS unsigned* off = (LAS unsigned*)(wl + 4096 + 256);
    LAS unsigned char* xl = wl + 4608;
#pragma unroll
    for (int t = 0; t < 4; ++t) {
        const f32x4* X1 = (const f32x4*)(P.out + (size_t)(tok0 + t) * 1024 + lane * 16);
        const f32x4 v0 = X1[0], v1 = X1[1], v2 = X1[2], v3 = X1[3];
        u32x4 w0, w1; w0.x = pack_h2(v0[0], v0[1]); w0.y = pack_h2(v0[2], v0[3]); w0.z = pack_h2(v1[0], v1[1]); w0.w = pack_h2(v1[2], v1[3]);
        w1.x = pack_h2(v2[0], v2[1]); w1.y = pack_h2(v2[2], v2[3]); w1.z = pack_h2(v3[0], v3[1]); w1.w = pack_h2(v3[2], v3[3]);
        *(LAS u32x4*)(xl + t * 2048 + lane * 32) = w0; *(LAS u32x4*)(xl + t * 2048 + lane * 32 + 16) = w1;
    }
    cnt[lane] = 0u;
    __builtin_amdgcn_fence(__ATOMIC_RELEASE, "wavefront"); __builtin_amdgcn_wave_barrier();
    const u32x2* pk = (const u32x2*)(ws + WS_PK) + (size_t)tok0 * 128;
    u32x2 pv[8]; unsigned pos[8];
#pragma unroll
    for (int m = 0; m < 8; ++m) { pv[m] = pk[m * 64 + lane]; pos[m] = __hip_atomic_fetch_add(&cnt[pv[m].x >> 8], 1u, __ATOMIC_RELAXED, __HIP_MEMORY_SCOPE_WAVEFRONT); }
    __builtin_amdgcn_fence(__ATOMIC_ACQ_REL, "wavefront"); __builtin_amdgcn_wave_barrier();
    {
        const unsigned c = cnt[lane]; unsigned sfx = c;
#pragma unroll
        for (int o = 1; o < 64; o <<= 1) { const unsigned t = __shfl_up(sfx, o); if (lane >= o) sfx += t; }
        off[lane] = sfx - c;
    }
    __builtin_amdgcn_fence(__ATOMIC_ACQ_REL, "wavefront"); __builtin_amdgcn_wave_barrier();
#pragma unroll
    for (int m = 0; m < 8; ++m) { const unsigned dst = off[pv[m].x >> 8] + pos[m]; u32x2 e; e.x = pv[m].x | ((unsigned)(m >> 1) << 14); e.y = pv[m].y; sorted[dst] = e; }
    __builtin_amdgcn_fence(__ATOMIC_ACQ_REL, "wavefront"); __builtin_amdgcn_wave_barrier();
    const unsigned char* UT = ws + WS_UTAB + lane * 16; const unsigned char* VT = ws + WS_VTAB + lane * 16;
#pragma nounroll
    for (int b = 0; b < 8; ++b) {
        const u32x2 sp = sorted[b * 64 + lane];
        float hv = 0.f;
#pragma nounroll
        for (int k = 0; k < 64; k += 4) {
            unsigned ev[4]; u32x4 a0[4];
#pragma unroll
            for (int j = 0; j < 4; ++j) { ev[j] = (unsigned)__builtin_amdgcn_readlane((int)sp.x, k + j); a0[j] = *(const u32x4*)(UT + (size_t)(ev[j] & 0x3fffu) * 1024); }
            float pt[4];
#pragma unroll
            for (int j = 0; j < 4; ++j) {
                const unsigned tau = ev[j] >> 14;
                const u32x4 x0 = *(const LAS u32x4*)(xl + tau * 2048 + lane * 32), x1 = *(const LAS u32x4*)(xl + tau * 2048 + lane * 32 + 16);
                const unsigned xw[8] = {x0.x, x0.y, x0.z, x0.w, x1.x, x1.y, x1.z, x1.w};
                h16x2 xs[8];
#pragma unroll
                for (int i = 0; i < 8; ++i) xs[i] = __builtin_bit_cast(h16x2, xw[i]);
                pt[j] = dot16_8(a0[j], xs);
            }
#pragma unroll
            for (int j = 0; j < 4; ++j) { const float tot = wave_total(pt[j]); hv = (lane == k + j) ? tot : hv; }
        }
        u32x2 nw = sp; nw.y = __float_as_uint(__uint_as_float(sp.y) * gelu_tanh(hv * (1.0f / 64.0f)) * 0.125f); sorted[b * 64 + lane] = nw;
    }
    __builtin_amdgcn_fence(__ATOMIC_ACQ_REL, "wavefront"); __builtin_amdgcn_wave_barrier();
    float acc[4][16];
#pragma unroll
    for (int t = 0; t < 4; ++t)
#pragma unroll
        for (int i = 0; i < 16; ++i) acc[t][i] = 0.f;
#pragma nounroll
    for (int b = 0; b < 8; ++b) {
        const u32x2 sp = sorted[b * 64 + lane];
#pragma nounroll
        for (int k = 0; k < 64; k += 4) {
            unsigned ev[4]; float wv[4]; u32x4 a0[4];
#pragma unroll
            for (int j = 0; j < 4; ++j) { ev[j] = (unsigned)__builtin_amdgcn_readlane((int)sp.x, k + j); wv[j] = __uint_as_float((unsigned)__builtin_amdgcn_readlane((int)sp.y, k + j));
                a0[j] = *(const u32x4*)(VT + (size_t)(ev[j] & 0x3fffu) * 1024); }
#pragma unroll
            for (int j = 0; j < 4; ++j) {
                const unsigned tau = ev[j] >> 14;
                const float w0 = tau == 0u ? wv[j] : 0.f, w1 = tau == 1u ? wv[j] : 0.f, w2 = tau == 2u ? wv[j] : 0.f, w3 = tau == 3u ? wv[j] : 0.f;
                const unsigned aw[4] = {a0[j].x, a0[j].y, a0[j].z, a0[j].w};
#pragma unroll
                for (int i = 0; i < 8; ++i) {
                    const f32x2_t vv = (i & 1) ? __builtin_amdgcn_cvt_pk_f32_fp8((int)aw[i >> 1], true) : __builtin_amdgcn_cvt_pk_f32_fp8((int)aw[i >> 1], false); const float vx = vv.x, vy = vv.y;
                    acc[0][2 * i] = __builtin_fmaf(vx, w0, acc[0][2 * i]); acc[0][2 * i + 1] = __builtin_fmaf(vy, w0, acc[0][2 * i + 1]);
                    acc[1][2 * i] = __builtin_fmaf(vx, w1, acc[1][2 * i]); acc[1][2 * i + 1] = __builtin_fmaf(vy, w1, acc[1][2 * i + 1]);
                    acc[2][2 * i] = __builtin_fmaf(vx, w2, acc[2][2 * i]); acc[2][2 * i + 1] = __builtin_fmaf(vy, w2, acc[2][2 * i + 1]);
                    acc[3][2 * i] = __builtin_fmaf(vx, w3, acc[3][2 * i]); acc[3][2 * i + 1] = __builtin_fmaf(vy, w3, acc[3][2 * i + 1]);
                }
            }
        }
    }
    const float* g2 = P.in[27] + lane * 16; const float* b2 = P.in[28] + lane * 16;
#pragma unroll
    for (int t = 0; t < 4; ++t) {
        float* X1 = P.out + (size_t)(tok0 + t) * 1024 + lane * 16;
        float s = 0.f;
#pragma unroll
        for (int i = 0; i < 4; ++i) { const f32x4 v = ((const f32x4*)X1)[i];
#pragma unroll
            for (int j = 0; j < 4; ++j) { acc[t][4 * i + j] = DN_ALPHA * v[j] + (ABL_NOPEER ? 0.f : acc[t][4 * i + j]); s += acc[t][4 * i + j]; } }
        const float mean = wave_total(s) * (1.0f / 1024.0f); float s2 = 0.f;
#pragma unroll
        for (int i = 0; i < 16; ++i) { acc[t][i] -= mean; s2 += acc[t][i] * acc[t][i]; }
        const float rstd = 1.0f / sqrtf(wave_total(s2) * (1.0f / 1024.0f) + LN_EPS);
#pragma unroll
        for (int i = 0; i < 4; ++i) {
            const f32x4 gg = ((const f32x4*)g2)[i], bb = ((const f32x4*)b2)[i]; f32x4 o;
#pragma unroll
            for (int j = 0; j < 4; ++j) o[j] = acc[t][4 * i + j] * rstd * gg[j] + bb[j];
            ((f32x4*)X1)[i] = o;
        }
    }
}


__device__ __forceinline__ float row16_total(float v) {
    v = dpp_add(v, 0); v = dpp_add(v, 1); v = dpp_add(v, 2); v = dpp_add(v, 3); return v;
}
__device__ __forceinline__ void peer_round4(const Params& P, LAS unsigned char* wl, int tok0, int lane) {
    unsigned char* ws = P.ws;
    const int tau = lane >> 4, l16 = lane & 15;
    LAS u32x2* sorted = (LAS u32x2*)wl;
    LAS unsigned* cnt = (LAS unsigned*)(wl + 4096);
    LAS unsigned* off = (LAS unsigned*)(wl + 4096 + 1024);
    const int tok = tok0 + tau;
    h16x2 xh[32];
    {
        const f32x4* X1 = (const f32x4*)(P.out + (size_t)tok * 1024 + l16 * 64);
#pragma unroll
        for (int i = 0; i < 16; ++i) { const f32x4 v = X1[i]; xh[2 * i].x = (_Float16)v[0]; xh[2 * i].y = (_Float16)v[1]; xh[2 * i + 1].x = (_Float16)v[2]; xh[2 * i + 1].y = (_Float16)v[3]; }
    }
#pragma unroll
    for (int i = 0; i < 4; ++i) cnt[i * 64 + lane] = 0u;
    __builtin_amdgcn_fence(__ATOMIC_RELEASE, "wavefront"); __builtin_amdgcn_wave_barrier();
    const u32x2* pk = (const u32x2*)(ws + WS_PK) + (size_t)tok * 128;
    u32x2 pv[8]; unsigned pos[8];
#pragma unroll
    for (int m = 0; m < 8; ++m) { pv[m] = pk[m * 16 + l16]; pos[m] = __hip_atomic_fetch_add(&cnt[tau * 64 + (pv[m].x >> 8)], 1u, __ATOMIC_RELAXED, __HIP_MEMORY_SCOPE_WAVEFRONT); }
    __builtin_amdgcn_fence(__ATOMIC_ACQ_REL, "wavefront"); __builtin_amdgcn_wave_barrier();
#pragma unroll
    for (int t = 0; t < 4; ++t) {
        const unsigned c = cnt[t * 64 + lane]; unsigned sfx = c;
#pragma unroll
        for (int o = 1; o < 64; o <<= 1) { const unsigned u = __shfl_up(sfx, o); if (lane >= o) sfx += u; }
        off[t * 64 + lane] = sfx - c;
    }
    __builtin_amdgcn_fence(__ATOMIC_ACQ_REL, "wavefront"); __builtin_amdgcn_wave_barrier();
#pragma unroll
    for (int m = 0; m < 8; ++m) { const unsigned dst = off[tau * 64 + (pv[m].x >> 8)] + pos[m]; sorted[tau * 128 + dst] = pv[m]; }
    __builtin_amdgcn_fence(__ATOMIC_ACQ_REL, "wavefront"); __builtin_amdgcn_wave_barrier();
    const unsigned char* UT = ws + WS_UTAB + l16 * 64; const unsigned char* VT = ws + WS_VTAB + l16 * 64;
#pragma nounroll
    for (int i0 = 0; i0 < 128; i0 += 16) {
        float hv = 0.f;
#pragma nounroll
        for (int i = i0; i < i0 + 16; i += 2) {
            u32x4 a[2][4];
#pragma unroll
            for (int j = 0; j < 2; ++j) { const unsigned e = sorted[tau * 128 + i + j].x; const u32x4* row = (const u32x4*)(UT + (size_t)e * 1024);
#pragma unroll
                for (int q = 0; q < 4; ++q) a[j][q] = row[q]; }
#pragma unroll
            for (int j = 0; j < 2; ++j) {
                float d = 0.f;
#pragma unroll
                for (int q = 0; q < 4; ++q) {
                    const unsigned aw[4] = {a[j][q].x, a[j][q].y, a[j][q].z, a[j][q].w};
#pragma unroll
                    for (int c = 0; c < 4; ++c) {
                        const f32x2_t lo = __builtin_amdgcn_cvt_pk_f32_fp8((int)aw[c], false), hi = __builtin_amdgcn_cvt_pk_f32_fp8((int)aw[c], true);
                        const h16x2 x0 = xh[8 * q + 2 * c], x1 = xh[8 * q + 2 * c + 1];
                        d = __builtin_fmaf(lo.x, (float)x0.x, d); d = __builtin_fmaf(lo.y, (float)x0.y, d); d = __builtin_fmaf(hi.x, (float)x1.x, d); d = __builtin_fmaf(hi.y, (float)x1.y, d);
                    }
                }
                const float tot = row16_total(d);
                hv = (l16 == ((i + j) & 15)) ? tot : hv;
            }
        }
        u32x2 sp = sorted[tau * 128 + i0 + l16]; sp.y = __float_as_uint(__uint_as_float(sp.y) * gelu_tanh(hv * (1.0f / 64.0f)) * 0.125f); sorted[tau * 128 + i0 + l16] = sp;
    }
    __builtin_amdgcn_fence(__ATOMIC_ACQ_REL, "wavefront"); __builtin_amdgcn_wave_barrier();
    float acc[64];
#pragma unroll
    for (int i = 0; i < 64; ++i) acc[i] = 0.f;
#pragma nounroll
    for (int i = 0; i < 128; i += 2) {
        u32x4 a[2][4]; float wv[2];
#pragma unroll
        for (int j = 0; j < 2; ++j) { const u32x2 sp = sorted[tau * 128 + i + j]; wv[j] = __uint_as_float(sp.y); const u32x4* row = (const u32x4*)(VT + (size_t)sp.x * 1024);
#pragma unroll
            for (int q = 0; q < 4; ++q) a[j][q] = row[q]; }
#pragma unroll
        for (int j = 0; j < 2; ++j)
#pragma unroll
            for (int q = 0; q < 4; ++q) {
                const unsigned aw[4] = {a[j][q].x, a[j][q].y, a[j][q].z, a[j][q].w};
#pragma unroll
                for (int c = 0; c < 4; ++c) {
                    const f32x2_t lo = __builtin_amdgcn_cvt_pk_f32_fp8((int)aw[c], false), hi = __builtin_amdgcn_cvt_pk_f32_fp8((int)aw[c], true);
                    acc[16 * q + 4 * c + 0] = __builtin_fmaf(lo.x, wv[j], acc[16 * q + 4 * c + 0]); acc[16 * q + 4 * c + 1] = __builtin_fmaf(lo.y, wv[j], acc[16 * q + 4 * c + 1]);
                    acc[16 * q + 4 * c + 2] = __builtin_fmaf(hi.x, wv[j], acc[16 * q + 4 * c + 2]); acc[16 * q + 4 * c + 3] = __builtin_fmaf(hi.y, wv[j], acc[16 * q + 4 * c + 3]);
                }
            }
    }
    {
        float* X1 = P.out + (size_t)tok * 1024 + l16 * 64;
        float s = 0.f;
#pragma unroll
        for (int i = 0; i < 16; ++i) { const f32x4 v = ((const f32x4*)X1)[i];
#pragma unroll
            for (int j = 0; j < 4; ++j) { acc[4 * i + j] = DN_ALPHA * v[j] + (ABL_NOPEER ? 0.f : acc[4 * i + j]); s += acc[4 * i + j]; } }
        const float mean = row16_total(s) * (1.0f / 1024.0f); float s2 = 0.f;
#pragma unroll
        for (int i = 0; i < 64; ++i) { acc[i] -= mean; s2 += acc[i] * acc[i]; }
        const float rstd = 1.0f / sqrtf(row16_total(s2) * (1.0f / 1024.0f) + LN_EPS);
        const float* g2 = P.in[27] + l16 * 64; const float* b2 = P.in[28] + l16 * 64;
#pragma unroll
        for (int i = 0; i < 16; ++i) {
            const f32x4 gg = ((const f32x4*)g2)[i], bb = ((const f32x4*)b2)[i]; f32x4 o;
#pragma unroll
            for (int j = 0; j < 4; ++j) o[j] = acc[4 * i + j] * rstd * gg[j] + bb[j];
            ((f32x4*)X1)[i] = o;
        }
    }
}

#define XB_TMO      128
#define XB_XCNT(j)  (256  + 64 * (j))
#define XB_XSUB(j)  (1280 + 64 * (j))
#define XB_XGEN(j)  (2304 + 64 * (j))
#define XB_TOP      3328
#define XB_TOPGEN   3392
#define XCD_BAR_WORDS 3456
#define XB_SPIN_CAP (1u << 24)
__device__ __forceinline__ unsigned xb_ld(unsigned* p)              { return __hip_atomic_load(p, __ATOMIC_RELAXED, __HIP_MEMORY_SCOPE_AGENT); }
__device__ __forceinline__ unsigned xb_add(unsigned* p, unsigned v) { return __hip_atomic_fetch_add(p, v, __ATOMIC_RELAXED, __HIP_MEMORY_SCOPE_AGENT); }
__device__ __forceinline__ unsigned xb_xcc_id() { return (unsigned)__builtin_amdgcn_s_getreg((3 << 11) | 20) & 0xFu; }
#define XB_SPIN(cond, bar) do { unsigned _sp = 0; while (cond) { __builtin_amdgcn_s_sleep(1); \
    if ((++_sp & 255u) == 0u) { if (xb_ld(&(bar)[XB_TMO])) break; if (_sp > XB_SPIN_CAP) { atomicAdd(&(bar)[XB_TMO], 1u); break; } } } } while (0)
struct XcdBarrier { unsigned* bar; unsigned x; volatile LAS unsigned* st; };
__device__ __forceinline__ XcdBarrier xcd_barrier_post(unsigned* bar, volatile LAS unsigned* st) {
    XcdBarrier b; b.bar = bar; b.x = xb_xcc_id(); b.st = st;
    if (threadIdx.x == 0) (void)xb_add(&bar[XB_XCNT(b.x)], 1u);
    return b;
}
__device__ __forceinline__ void xcd_barrier_complete(unsigned* bar, unsigned x, unsigned& nloc, unsigned& nx) {
    const unsigned G = gridDim.x * gridDim.y * gridDim.z;
    unsigned sum, cnt, mine, sp = 0u;
    for (;;) {
        sum = 0u; cnt = 0u; mine = 0u;
#pragma unroll
        for (unsigned j = 0; j < 16; ++j) { const unsigned c = xb_ld(&bar[XB_XCNT(j)]); sum += c; cnt += (c > 0u) ? 1u : 0u; mine = (j == x) ? c : mine; }
        if (sum == G) break;
        __builtin_amdgcn_s_sleep(1);
        if ((++sp & 255u) == 0u) { if (xb_ld(&bar[XB_TMO])) break; if (sp > XB_SPIN_CAP) { atomicAdd(&bar[XB_TMO], 1u); break; } }
    }
    nloc = mine > 0u ? mine : 1u; nx = cnt > 0u ? cnt : 1u;
}
__device__ __forceinline__ void xcd_barrier(const XcdBarrier& b) {
    asm volatile("s_waitcnt vmcnt(0)" ::: "memory");
    __syncthreads();
    if (threadIdx.x == 0) {
        unsigned* bar = b.bar;
        __builtin_amdgcn_s_waitcnt(0);
        unsigned nloc = b.st[0], nx = b.st[1];
        if (nloc == 0u) { xcd_barrier_complete(bar, b.x, nloc, nx); b.st[0] = nloc; b.st[1] = nx; }
        const unsigned old = xb_add(&bar[XB_XSUB(b.x)], 1u);
        const unsigned gen = old / nloc;
        if (old + 1u == (gen + 1u) * nloc) {
            __builtin_amdgcn_fence(__ATOMIC_RELEASE, "agent");
            asm volatile("s_waitcnt vmcnt(0)" ::: "memory");
            const unsigned og = xb_add(&bar[XB_TOP], 1u);
            const unsigned tg = og / nx;
            if (og + 1u == (tg + 1u) * nx) xb_add(&bar[XB_TOPGEN], 1u);
            else XB_SPIN(xb_ld(&bar[XB_TOPGEN]) == tg, bar);
            __builtin_amdgcn_fence(__ATOMIC_ACQUIRE, "agent");
            xb_add(&bar[XB_XGEN(b.x)], 1u);
            asm volatile("s_waitcnt vmcnt(0)" ::: "memory");
        } else {
            XB_SPIN(xb_ld(&bar[XB_XGEN(b.x)]) == gen, bar);
            __builtin_amdgcn_fence(__ATOMIC_ACQUIRE, "agent");
            asm volatile("s_waitcnt vmcnt(0)" ::: "memory");
        }
    }
    __syncthreads();
}

__device__ __forceinline__ int next_item(unsigned* ctr, LAS int* slot) {
    __syncthreads();
    if (threadIdx.x == 0) *slot = (int)atomicAdd(ctr, 1u);
    __syncthreads();
    return __builtin_amdgcn_readfirstlane(*slot);
}


#ifdef CHECK_PEER
__device__ __forceinline__ void check_peer(const Params& P, LAS unsigned char* lds, unsigned* ctl) {
    unsigned char* ws = P.ws;
    const int tid = threadIdx.x;
    const bf16_t* QP = (const bf16_t*)(ws + WS_QP); const bf16_t* SK = (const bf16_t*)(ws + WS_SUBK);
    const u32x2* PK = (const u32x2*)(ws + WS_PK);
    unsigned bad_e = 0, bad_g = 0;
    if (tid < 64) {
        LAS float* sc = (LAS float*)lds + tid * 257;
        LAS float* sv = (LAS float*)(lds + 64 * 257 * 4) + tid * 33;
        LAS int* si = (LAS int*)(lds + 64 * 257 * 4 + 64 * 33 * 4) + tid * 33;
        for (int pair = blockIdx.x * 64 + tid; pair < T_TOK * 8; pair += gridDim.x * 64) {
            const int t = pair >> 3, h = pair & 7;
            for (int c = 0; c < 2; ++c)
                for (int k = 0; k < 128; ++k) {
                    float a = 0.f;
                    for (int d = 0; d < 64; ++d) a += bf2f(QP[(size_t)t * 1024 + h * 128 + c * 64 + d]) * bf2f(SK[((size_t)((h * 2 + c) * 128 + k)) * 64 + d]);
                    sc[c * 128 + k] = a;
                }
            for (int c = 0; c < 2; ++c) {
                float pv = 3.0e38f; int pi = -1;
                for (int r = 0; r < 16; ++r) {
                    float bv = -3.0e38f; int bi = -1;
                    for (int k = 0; k < 128; ++k) { const float v = sc[c * 128 + k]; const bool after = (v < pv) || (v == pv && k > pi); if (after && (v > bv)) { bv = v; bi = k; } }
                    sv[c * 16 + r] = bv; si[c * 16 + r] = bi; pv = bv; pi = bi;
                }
            }
            float pv = 3.0e38f; int pi = -1; float best[16]; int bexp[16];
            float mv = 0.f, sum = 0.f;
            for (int r = 0; r < 16; ++r) {
                float bv = -3.0e38f; int bi = -1;
                for (int f = 0; f < 256; ++f) { const float v = sv[f >> 4] + sv[16 + (f & 15)]; const bool after = (v < pv) || (v == pv && f > pi); if (after && (v > bv)) { bv = v; bi = f; } }
                pv = bv; pi = bi;
                const int e = si[bi >> 4] * 128 + si[16 + (bi & 15)];
                if (r == 0) mv = bv;
                const float ev = expf(bv - mv); sum += ev;
                bool found = false; float gpk = 0.f;
                for (int k = 0; k < 16; ++k) { const u32x2 q = PK[(size_t)pair * 16 + k]; if ((int)q.x == e) { found = true; gpk = __uint_as_float(q.y); } }
                if (!found) ++bad_e;
                sc[r] = ev; sc[16 + r] = found ? gpk : -1.f;
            }
            for (int r = 0; r < 16; ++r) { const float gref = sc[r] / sum, gpk = sc[16 + r]; if (gpk >= 0.f && fabsf(gref - gpk) > 0.02f) ++bad_g; }
        }
    }
    if (bad_e) atomicAdd(ctl + 300, bad_e);
    if (bad_g) atomicAdd(ctl + 301, bad_g);
}
#endif

#ifdef CHECK_PROJ
__device__ __forceinline__ void check_proj(const Params& P, unsigned* ctl) {
    unsigned char* ws = P.ws;
    const float* x = P.in[0]; const float* w = P.in[1]; const float* bi = P.in[2];
    const int gtid = blockIdx.x * 512 + threadIdx.x, NT = gridDim.x * 512;
    unsigned bad[5] = {0, 0, 0, 0, 0};
    const int nrows = 128;
    for (int i = gtid; i < nrows * INC; i += NT) {
        const int col = i % INC, row = (i / INC) * 127 + 5;
        float a = bi[col];
        for (int k = 0; k < 1024; ++k) a += x[(size_t)row * 1024 + k] * w[(size_t)k * INC + col];
        float got, ref; int cat;
        if (col < 512) { const int b = row >> 12, sq = row & 4095, g = col >> 4, hp = col & 15; got = bf2f(((const bf16_t*)(ws + WS_UG))[((size_t)((b * 32 + g) * 4096 + sq)) * 16 + hp]); ref = a; cat = 0; }
        else if (col < 1024) { got = bf2f(((const bf16_t*)(ws + WS_Q))[(size_t)row * 512 + col - 512]); ref = a * 0.125f * LOG2E; cat = 1; }
        else if (col < 1792) { const int idx = (col - 1024) >> 7, cc = (col - 1024) & 127; got = bf2f(((const bf16_t*)(ws + WS_KV))[((size_t)idx * T_TOK + row) * 128 + cc]); ref = a; cat = 2; }
        else if (col < 1816) { got = ((const float*)(ws + WS_GATES))[(size_t)row * 24 + col - 1792]; ref = 1.f / (1.f + expf(-a)); cat = 3; }
        else { got = bf2f(((const bf16_t*)P.out)[(size_t)row * 2048 + col - 1816]); ref = 1.f / (1.f + expf(-a)); cat = 4; }
        if (!(fabsf(got - ref) <= 0.04f + 0.02f * fabsf(ref))) ++bad[cat];
    }
    for (int c = 0; c < 5; ++c) if (bad[c]) atomicAdd(ctl + 300 + c, bad[c]);
}
#endif

#ifdef CHECK_S5
__device__ __forceinline__ void check_s5(const Params& P, LAS unsigned char* lds, unsigned* ctl) {
    unsigned char* ws = P.ws;
    if (blockIdx.x >= 16) return;
    const int tid = threadIdx.x, b = blockIdx.x & 3, g = (blockIdx.x * 7 + 3) & 31;
    const float* a_re = P.in[3]; const float* a_im = P.in[4]; const float* log_dt = P.in[5]; const float* b_re = P.in[6]; const float* b_im = P.in[7]; const float* c_re = P.in[8]; const float* c_im = P.in[9]; const float* dsk = P.in[10];
    LAS float* part = (LAS float*)lds;
    const bf16_t* UGp = (const bf16_t*)(ws + WS_UG) + ((size_t)(b * 32 + g) * 4096) * 16;
    const bf16_t* YG = (const bf16_t*)(ws + WS_YG);
    const int p = tid & 63;
    const float dt = expf(log_dt[g]); const float are = a_re[g * 64 + p], aim = a_im[g * 64 + p];
    const cpx lb = lam_pow(are, aim, dt, 1.0f); const cpx cf = bbar_coef(are, aim, dt);
    float bbr[16], bbi[16], cr[16], ci[16];
    for (int j = 0; j < 16; ++j) { const cpx bb = cmul(cf, cpx{b_re[(g * 64 + p) * 16 + j], b_im[(g * 64 + p) * 16 + j]}); bbr[j] = bb.re; bbi[j] = bb.im; cr[j] = c_re[(g * 16 + j) * 64 + p]; ci[j] = c_im[(g * 16 + j) * 64 + p]; }
    float xr = 0.f, xi = 0.f; unsigned bad = 0;
    for (int sq = 0; sq < 4096; ++sq) {
        float u[16];
        for (int j = 0; j < 16; ++j) u[j] = bf2f(UGp[(size_t)sq * 16 + j]);
        float br = 0.f, bim = 0.f;
        for (int j = 0; j < 16; ++j) { br += bbr[j] * u[j]; bim += bbi[j] * u[j]; }
        const float nr = lb.re * xr - lb.im * xi + br, ni = lb.re * xi + lb.im * xr + bim; xr = nr; xi = ni;
        __syncthreads();
        if (tid < 64) for (int j = 0; j < 16; ++j) part[p * 17 + j] = cr[j] * xr - ci[j] * xi;
        __syncthreads();
        if (tid < 16) {
            float y = 0.f; for (int q = 0; q < 64; ++q) y += part[q * 17 + tid];
            y += dsk[g * 16 + tid] * u[tid];
            const float ref = gelu_tanh(y); const float got = bf2f(YG[((size_t)(b * 4096 + sq)) * 512 + g * 16 + tid]);
            if (!(fabsf(got - ref) <= 0.03f + 0.03f * fabsf(ref))) ++bad;
        }
    }
    if (bad) atomicAdd(ctl + 300, bad);
}
#endif

#ifdef CHECK_ATTN
__device__ __forceinline__ void check_attn(const Params& P, LAS unsigned char* lds, unsigned* ctl) {
    unsigned char* ws = P.ws;
    const int tid = threadIdx.x, lane = tid & 63, r = tid >> 6;
    const bf16_t* Qp = (const bf16_t*)(ws + WS_Q); const bf16_t* KVp = (const bf16_t*)(ws + WS_KV);
    const float* GT = (const float*)(ws + WS_GATES); const bf16_t* Op = (const bf16_t*)(ws + WS_O);
    LAS float* sc = (LAS float*)lds;
    LAS float* impH = sc + 1024;
    LAS int* sel = (LAS int*)(impH + 256);
    unsigned bad = 0, badsel = 0;
    for (int smp = 0; smp < 3; ++smp) {
        const int id = blockIdx.x * 3 + smp;
        const int b = id & 3, g = (id >> 2) & 1;
        int t = (int)(((unsigned)id * 2654435761u) >> 20) & 4095;
        if (id < 16) t = id * 9;
        if (id >= 16 && id < 32) t = 1000 + (id - 16) * 4;
        const size_t rowq = (size_t)b * 4096 + t;
        const int hd = g * 4 + (r & 3);
        const float nslope2 = -exp2f(-(float)(hd + 1)) * LOG2E;
        const float q = r < 4 ? bf2f(Qp[rowq * 512 + hd * 64 + lane]) : 0.f;
        const bf16_t* KC = (const bf16_t*)(ws + WS_KC) + (size_t)(b * 2 + g) * 256 * 64; const bf16_t* VC = (const bf16_t*)(ws + WS_VC) + (size_t)(b * 2 + g) * 256 * 64;
        float tot = 0.f;
        __syncthreads();
        if (r < 4) {
            const int ncmp = t >= 31 ? (t - 31) / 16 + 1 : 0;
            float m = -1e30f;
            for (int c = 0; c < ncmp; ++c) { float s2 = wave_sum(q * bf2f(KC[c * 64 + lane])) + nslope2 * (float)(t - (16 * c + 31)); if (lane == 0) sc[r * 256 + c] = s2; m = fmaxf(m, s2); }
            float l = 0.f;
            for (int c = 0; c < ncmp; ++c) l += exp2f(sc[r * 256 + c] - m);
            float o = 0.f;
            for (int c = 0; c < ncmp; ++c) { const float p = exp2f(sc[r * 256 + c] - m) / l; o += p * bf2f(VC[c * 64 + lane]); }
            tot += GT[rowq * 24 + g * 12 + r * 3 + 0] * o;
            float im = 0.f;
            for (int cc = 4 * lane - 1; cc <= 4 * lane + 3; ++cc) if (cc >= 0 && cc < ncmp) im += exp2f(sc[r * 256 + cc] - m) / l;
            impH[r * 64 + lane] = im;
        }
        __syncthreads();
        if (tid < 64) {
            const int j = tid, cur = t >> 6; const float imp = impH[j] + impH[64 + j] + impH[128 + j] + impH[192 + j];
            const bool valid = j <= cur, forced = (j == 0) || (j == cur) || (j == cur - 1);
            const float key = valid ? imp + (forced ? 1.0e4f : 0.f) : -1e30f;
            sc[j] = key;
        }
        __syncthreads();
        if (tid < 64) {
            const int j = tid; const float key = sc[j]; int cnt = 0;
            for (int jp = 0; jp < 64; ++jp) { const float sj = sc[jp]; cnt += ((sj > key) || (sj == key && jp < j)) ? 1 : 0; }
            sel[j] = (cnt < 16) ? 1 : 0;
        }
        __syncthreads();
        if (r < 4) {
            const bf16_t* Ks = KVp + (size_t)2 * T_TOK * 128; const bf16_t* Vs = KVp + (size_t)3 * T_TOK * 128;
            float m = -1e30f, l = 0.f, o = 0.f;
            for (int j = 0; j < 64; ++j) if (sel[j]) for (int kk = 0; kk < 64; ++kk) { const int kp = 64 * j + kk; if (kp > t) break;
                const float s2 = wave_sum(q * bf2f(Ks[((size_t)b * 4096 + kp) * 128 + g * 64 + lane])) + nslope2 * (float)(t - kp);
                const float mn = fmaxf(m, s2), al = exp2f(m - mn), p = exp2f(s2 - mn); l = l * al + p; o = o * al + p * bf2f(Vs[((size_t)b * 4096 + kp) * 128 + g * 64 + lane]); m = mn; }
            tot += GT[rowq * 24 + g * 12 + r * 3 + 1] * o / fmaxf(l, 1e-30f);
            const bf16_t* Kw = KVp + (size_t)4 * T_TOK * 128; const bf16_t* Vw = KVp + (size_t)5 * T_TOK * 128;
            m = -1e30f; l = 0.f; o = 0.f;
            for (int kp = (t - 511 > 0 ? t - 511 : 0); kp <= t; ++kp) {
                const float s2 = wave_sum(q * bf2f(Kw[((size_t)b * 4096 + kp) * 128 + g * 64 + lane])) + nslope2 * (float)(t - kp);
                const float mn = fmaxf(m, s2), al = exp2f(m - mn), p = exp2f(s2 - mn); l = l * al + p; o = o * al + p * bf2f(Vw[((size_t)b * 4096 + kp) * 128 + g * 64 + lane]); m = mn; }
            tot += GT[rowq * 24 + g * 12 + r * 3 + 2] * o / fmaxf(l, 1e-30f);
            const float got = bf2f(Op[rowq * 512 + hd * 64 + lane]);
            if (!(fabsf(got - tot) <= 0.02f + 0.03f * fabsf(tot))) ++bad;
        }
    }
    if (bad) atomicAdd(ctl + 300, bad);
}
#endif

#ifdef CHECK_CMP
__device__ __forceinline__ void check_cmp(const Params& P, LAS unsigned char* lds, unsigned* ctl) {
    unsigned char* ws = P.ws;
    const int tid = threadIdx.x;
    LAS float* h1 = (LAS float*)lds;
    unsigned bad = 0;
    for (int smp = 0; smp < 4; ++smp) {
        const int id = blockIdx.x * 4 + smp;
        const int kv = id & 1, b = (id >> 1) & 3, g = (id >> 3) & 1; int c = (int)(((unsigned)id * 2654435761u) >> 22) % 255; if (id < 32) c = 254 - (id >> 4);
        const bf16_t* src = (const bf16_t*)(ws + WS_KV) + (size_t)kv * T_TOK * 128;
        const float* pe = P.in[kv ? 16 : 13]; const float* w1 = P.in[kv ? 17 : 14]; const float* w2 = P.in[kv ? 18 : 15];
        const bf16_t* dst = (const bf16_t*)(ws + (kv ? WS_VC : WS_KC));
        __syncthreads();
        if (tid < 128) { float a = 0.f;
            for (int k = 0; k < 2048; ++k) { const int l = k >> 6, d = k & 63; a += (bf2f(src[((size_t)(b * 4096 + 16 * c + l)) * 128 + g * 64 + d]) + pe[k]) * w1[(size_t)k * 128 + tid]; }
            h1[tid] = gelu_tanh(a); }
        __syncthreads();
        if (tid < 64) { float a = 0.f; for (int n = 0; n < 128; ++n) a += h1[n] * w2[n * 64 + tid];
            const float got = bf2f(dst[((size_t)((b * 2 + g) * 256 + c)) * 64 + tid]);
            if (!(fabsf(got - a) <= 0.02f + 0.03f * fabsf(a))) ++bad; }
    }
    if (bad) atomicAdd(ctl + 300, bad);
}
#endif

#ifdef CHECK_X1
#ifndef X1TOL
#define X1TOL 0.03f
#endif
#ifndef X1SRC
#define X1SRC 0
#endif
__device__ __forceinline__ void check_x1(const Params& P, LAS unsigned char* lds, unsigned* ctl, const bf16_t* GMcopy) {
    unsigned char* ws = P.ws;
    const int tid = threadIdx.x; const int row = (int)(((unsigned)blockIdx.x * 2654435761u) >> 18) & 16383;
    LAS float* yg = (LAS float*)lds; LAS float* z = yg + 512; LAS float* o = z + 512; LAS float* m = o + 512; LAS float* rr = m + 1024; LAS float* red = rr + 1024;
    const bf16_t* YG = (const bf16_t*)(ws + WS_YG); const bf16_t* Op = (const bf16_t*)(ws + WS_O);
    const float* wglu = P.in[11]; const float* wups = P.in[12]; const float* wupn = P.in[19]; const float* wout = P.in[20];
    yg[tid] = bf2f(YG[(size_t)row * 512 + tid]); o[tid] = bf2f(Op[(size_t)row * 512 + tid]);
    __syncthreads();
    { float ga = 0.f, gb = 0.f; for (int k = 0; k < 512; ++k) { ga += yg[k] * wglu[(size_t)k * 1024 + tid]; gb += yg[k] * wglu[(size_t)k * 1024 + 512 + tid]; } z[tid] = ga / (1.f + expf(-gb)); }
    __syncthreads();
    if (CHECK_X1 == 2) { const float got = bf2f(((const bf16_t*)(ws + WS_Z))[(size_t)row * 512 + tid]); if (!(fabsf(got - z[tid]) <= 0.02f + 0.03f * fabsf(z[tid]))) atomicAdd(ctl + 300, 1u); return; }
    for (int n = tid; n < 1024; n += 512) { float ya = 0.f, yb = 0.f; for (int k = 0; k < 512; ++k) { ya += z[k] * wups[(size_t)k * 1024 + n]; yb += o[k] * wupn[(size_t)k * 1024 + n]; }
        m[n] = bf2f(GMcopy[(size_t)blockIdx.x * 2048 + n]) * ya + bf2f(GMcopy[(size_t)blockIdx.x * 2048 + 1024 + n]) * yb; }
    __syncthreads();
    if (CHECK_X1 == 3) { for (int n = tid; n < 1024; n += 512) { const float got = bf2f(((const bf16_t*)(ws + WS_MIXIN))[(size_t)row * 1024 + n]); if (!(fabsf(got - m[n]) <= 0.02f + 0.03f * fabsf(m[n]))) atomicAdd(ctl + 300, 1u); } return; }
    for (int n = tid; n < 1024; n += 512) { float a = 0.f; for (int k = 0; k < 1024; ++k) a += m[k] * wout[(size_t)k * 1024 + n]; rr[n] = DN_ALPHA * P.in[0][(size_t)row * 1024 + n] + a; }
    __syncthreads();
    if (CHECK_X1 == 4) { for (int n = tid; n < 1024; n += 512) { const float got = P.out[(size_t)row * 1024 + n]; if (!(fabsf(got - rr[n]) <= 0.03f + 0.03f * fabsf(rr[n]))) atomicAdd(ctl + 300, 1u); } return; }
    float sm = 0.f; for (int n = tid; n < 1024; n += 512) sm += rr[n]; sm = wave_sum(sm); if ((tid & 63) == 0) red[tid >> 6] = sm; __syncthreads();
    float mean = 0.f; for (int i = 0; i < 8; ++i) mean += red[i]; mean *= (1.f / 1024.f); __syncthreads();
    float sq = 0.f; for (int n = tid; n < 1024; n += 512) sq += (rr[n] - mean) * (rr[n] - mean); sq = wave_sum(sq); if ((tid & 63) == 0) red[tid >> 6] = sq; __syncthreads();
    float var = 0.f; for (int i = 0; i < 8; ++i) var += red[i]; var *= (1.f / 1024.f);
    const float rstd = 1.f / sqrtf(var + LN_EPS); unsigned bad = 0;
    for (int n = tid; n < 1024; n += 512) { const float ref = (rr[n] - mean) * rstd * P.in[21][n] + P.in[22][n]; const float got = X1SRC ? bf2f(((const bf16_t*)(ws + WS_X1B))[(size_t)row * 1024 + n]) : P.out[(size_t)row * 1024 + n]; if (!(fabsf(got - ref) <= X1TOL + X1TOL * fabsf(ref))) ++bad; }
    if (bad) atomicAdd(ctl + 300, bad);
}
#endif

#ifdef CHECK_QP
__device__ __forceinline__ void check_qp(const Params& P, LAS unsigned char* lds, unsigned* ctl) {
    const int tid = threadIdx.x; const int row = (int)(((unsigned)blockIdx.x * 2654435761u) >> 18) & 16383;
    LAS float* xs = (LAS float*)lds;
    for (int n = tid; n < 1024; n += 512) xs[n] = P.out[(size_t)row * 1024 + n];
    __syncthreads();
    const float* wq = P.in[23]; const bf16_t* QP = (const bf16_t*)(P.ws + WS_QP);
    for (int n = tid; n < 1024; n += 512) { float a = 0.f; for (int k = 0; k < 1024; ++k) a += xs[k] * wq[(size_t)k * 1024 + n];
        const float got = bf2f(QP[(size_t)row * 1024 + n]); if (!(fabsf(got - a) <= 0.03f + 0.03f * fabsf(a))) atomicAdd(ctl + 300, 1u); }
}
#endif

#ifdef CHECK_P10
__device__ __forceinline__ void check_p10(const Params& P, LAS unsigned char* lds, unsigned* ctl) {
    const int tid = threadIdx.x; const int row = (int)(((unsigned)blockIdx.x * 2654435761u) >> 18) & 16383;
    LAS float* xs = (LAS float*)lds; LAS float* wgt = xs + 1024; LAS float* rr = wgt + 128; LAS float* red = rr + 1024;
    const float* xsave = (const float*)(P.ws + WS_Z) + (size_t)blockIdx.x * 1024;
    for (int n = tid; n < 1024; n += 512) xs[n] = xsave[n];
    __syncthreads();
    const u32x2* pk = (const u32x2*)(P.ws + WS_PK) + (size_t)row * 128;
    const float* ut = P.in[25]; const float* vt = P.in[26];
    if (tid < 128) { const u32x2 q = pk[tid]; float h = 0.f;
#pragma nounroll
        for (int k = 0; k < 1024; ++k) h += ut[(size_t)q.x * 1024 + k] * xs[k]; wgt[tid] = __uint_as_float(q.y) * (ABL_NOH ? 1.f : gelu_tanh(h)); }
    __syncthreads();
    for (int n = tid; n < 1024; n += 512) { float y = 0.f;
#pragma nounroll
        for (int k = 0; k < 128; ++k) y += wgt[k] * vt[(size_t)pk[k].x * 1024 + n]; rr[n] = DN_ALPHA * xs[n] + (ABL_NOPEER ? 0.f : y); }
    __syncthreads();
    float sm = 0.f; for (int n = tid; n < 1024; n += 512) sm += rr[n]; sm = wave_sum(sm); if ((tid & 63) == 0) red[tid >> 6] = sm; __syncthreads();
    float mean = 0.f; for (int i = 0; i < 8; ++i) mean += red[i]; mean *= (1.f / 1024.f); __syncthreads();
    float sq = 0.f; for (int n = tid; n < 1024; n += 512) sq += (rr[n] - mean) * (rr[n] - mean); sq = wave_sum(sq); if ((tid & 63) == 0) red[tid >> 6] = sq; __syncthreads();
    float var = 0.f; for (int i = 0; i < 8; ++i) var += red[i]; var *= (1.f / 1024.f);
    const float rstd = 1.f / sqrtf(var + LN_EPS);
    for (int n = tid; n < 1024; n += 512) { const float ref = (rr[n] - mean) * rstd * P.in[27][n] + P.in[28][n]; const float got = P.out[(size_t)row * 1024 + n]; if (!(fabsf(got - ref) <= 0.03f + 0.03f * fabsf(ref))) atomicAdd(ctl + 300, 1u); }
}
#endif
#ifndef STOP_AFTER
#define STOP_AFTER 99
#endif

#ifndef DG_A
#define DG_A 0
#define DG_B 0
#endif
__device__ __forceinline__ void digest(const Params& P) {
    const int gtid = blockIdx.x * 512 + threadIdx.x, NT = gridDim.x * 512;
    const unsigned short* a = (const unsigned short*)(P.ws + (size_t)(DG_A < 0 ? 0 : DG_A) * MiB); const unsigned short* b = (const unsigned short*)(P.ws + (size_t)DG_B * MiB);
    for (int i = gtid; i < 8 * 1024 * 1024; i += NT) { P.out[i] = (float)a[i]; P.out[8 * 1024 * 1024 + i] = (float)b[i]; }
}
#ifndef NC_A
#define NC_A -1
#define NC_AN 0
#define NC_B -1
#define NC_BN 0
#define NC_C -1
#define NC_CN 0
#endif
__device__ __forceinline__ void nan_probe(const Params& P, unsigned* ctl, const XcdBarrier& bar) {
    const int gtid = blockIdx.x * 512 + threadIdx.x, NT = gridDim.x * 512;
    const int offs[3] = {NC_A, NC_B, NC_C}, szs[3] = {NC_AN, NC_BN, NC_CN};
#pragma unroll
    for (int w = 0; w < 3; ++w) if (offs[w] >= 0) {
        const unsigned short* a = (const unsigned short*)(P.ws + (size_t)offs[w] * KiB); unsigned cnt = 0;
        for (size_t i = gtid; i < (size_t)szs[w] * KiB / 2; i += NT) cnt += ((a[i] & 0x7f80u) == 0x7f80u) ? 1u : 0u;
        if (cnt) atomicAdd(ctl + 300 + w, cnt);
    }
    xcd_barrier(bar);
    float c = 0.f;
#pragma unroll
    for (int w = 0; w < 3; ++w) if (offs[w] >= 0) { if (__hip_atomic_load(ctl + 300 + w, __ATOMIC_RELAXED, __HIP_MEMORY_SCOPE_AGENT) != 0u) c += (float)(1 << w); }
#ifdef NC_COUNT
    c = log2f(1.0f + (float)__hip_atomic_load(ctl + 300, __ATOMIC_RELAXED, __HIP_MEMORY_SCOPE_AGENT));
#endif
    for (int i = gtid; i < T_TOK * DM; i += NT) P.out[i] = c;
}
#define PHASE_END(k) do { if (STOP_AFTER == (k)) { GRID_BAR(); if (NC_A >= 0) nan_probe(P, ctl, bar); else if (DG_A >= 0) digest(P); return; } } while (0)
__global__ void __launch_bounds__(512, 2) hybrid_fwd(Params P) {
    extern __shared__ __attribute__((aligned(16))) unsigned char lds_raw[];
    LAS unsigned char* lds = (LAS unsigned char*)lds_raw;
    LAS int* slot = (LAS int*)(lds + LDS_BYTES - 64);
    cg::grid_group grid = cg::this_grid();
    unsigned char* ws = P.ws;
    unsigned* ctl = (unsigned*)(ws + WS_CTL);
    const int tid = threadIdx.x, lane = tid & 63, wave = __builtin_amdgcn_readfirstlane(tid >> 6);
    const int G = gridDim.x;
    volatile LAS unsigned* MISC = (volatile LAS unsigned*)(lds + LDS_BYTES - 32);
    if (tid < 2) MISC[tid] = 0u;
    __syncthreads();
    const XcdBarrier bar = xcd_barrier_post(ctl + CW_BAR, MISC);
#define GRID_BAR() xcd_barrier(bar)

    p0_prologue(P, lds);
#if DUP_PHASE == 0
    p0_prologue(P, lds);
#endif
    asm volatile("s_waitcnt vmcnt(0)" ::: "memory");
    grid.sync();
    if (tid == 0) { __builtin_amdgcn_fence(__ATOMIC_ACQUIRE, "agent"); asm volatile("s_waitcnt vmcnt(0)" ::: "memory"); }
    __syncthreads();

    {
        pg8::Gemm g{(const bf16_t*)(ws + WS_XB), (const bf16_t*)(ws + WS_WIN), T_TOK, INCP, 1024};
        pg8::StaticOrder S; S.init(T_TOK, INCP, G, (int)blockIdx.x);
        pg8::Epi8<FInProj> E{FInProj{P.in[2], (bf16_t*)(ws + WS_UG), (bf16_t*)(ws + WS_Q), (bf16_t*)(ws + WS_KV), (float*)(ws + WS_GATES), (bf16_t*)P.out}};
        pg8::gemm_phase(lds, g, S, E);
    }
    GRID_BAR();

#ifdef CHECK_PROJ
    check_proj(P, ctl);
    GRID_BAR();
    { float c = 0.f; for (int k = 0; k < 5; ++k) if (__hip_atomic_load(ctl + 300 + k, __ATOMIC_RELAXED, __HIP_MEMORY_SCOPE_AGENT) != 0u) c += (float)(k < 3 ? (1 << k) : 0);
      if (CHECK_PROJ == 1) { c = 0.f; if (__hip_atomic_load(ctl + 303, __ATOMIC_RELAXED, __HIP_MEMORY_SCOPE_AGENT) != 0u) c += 1.f; if (__hip_atomic_load(ctl + 304, __ATOMIC_RELAXED, __HIP_MEMORY_SCOPE_AGENT) != 0u) c += 2.f; }
      for (int i = blockIdx.x * 512 + tid; i < T_TOK * DM; i += G * 512) P.out[i] = c; }
    return;
#endif
    PHASE_END(1);
    for (;;) { const int it = next_item(ctl + CW_Q2, slot); if (it >= 256) break; compress_item(P, lds, it); }
    s5_tables(P);
    GRID_BAR();

#ifdef CHECK_CMP
    check_cmp(P, lds, ctl);
    GRID_BAR();
    { const float c = log2f(1.0f + (float)__hip_atomic_load(ctl + 300, __ATOMIC_RELAXED, __HIP_MEMORY_SCOPE_AGENT));
      for (int i = blockIdx.x * 512 + tid; i < T_TOK * DM; i += G * 512) P.out[i] = c; }
    return;
#endif
    PHASE_END(2);
#if DUP_PHASE == 3
    for (;;) { const int it = next_item(ctl + 256, slot); if (it >= 128) break; s5_item(P, lds, it & 31, it >> 5); }
    for (;;) { const int k = next_item(ctl + 320, slot); if (k >= 512) break; attn_item(P, lds, (k & 7) >> 1, k & 1, 63 - (k >> 3)); }
    GRID_BAR();
#endif
#if DUP_PHASE == 32
    for (;;) { const int k = next_item(ctl + 320, slot); if (k >= 512) break; attn_item(P, lds, (k & 7) >> 1, k & 1, 63 - (k >> 3)); }
    GRID_BAR();
#endif
#if DUP_PHASE == 31
    for (;;) { const int it = next_item(ctl + 256, slot); if (it >= 128) break; s5_item(P, lds, it & 31, it >> 5); }
    GRID_BAR();
#endif
    for (;;) { const int it = next_item(ctl + CW_Q3, slot); if (it >= 128) break; s5_item(P, lds, it & 31, it >> 5); }
#ifndef SKIP_ATTN
    for (;;) { const int k = next_item(ctl + CW_Q3B, slot); if (k >= 512) break; attn_item(P, lds, (k & 7) >> 1, k & 1, 63 - (k >> 3)); }
#endif
    GRID_BAR();

#ifdef CHECK_ATTN
    check_attn(P, lds, ctl);
    GRID_BAR();
    { const float c = log2f(1.0f + (float)__hip_atomic_load(ctl + 300, __ATOMIC_RELAXED, __HIP_MEMORY_SCOPE_AGENT));
      for (int i = blockIdx.x * 512 + tid; i < T_TOK * DM; i += G * 512) P.out[i] = c; }
    return;
#endif
#ifdef CHECK_S5
    check_s5(P, lds, ctl);
    GRID_BAR();
    { const float c = log2f(1.0f + (float)__hip_atomic_load(ctl + 300, __ATOMIC_RELAXED, __HIP_MEMORY_SCOPE_AGENT));
      for (int i = blockIdx.x * 512 + tid; i < T_TOK * DM; i += G * 512) P.out[i] = c; }
    return;
#endif
    PHASE_END(3);
    {
        pg8::Gemm g{(const bf16_t*)(ws + WS_YG), (const bf16_t*)(ws + WS_WGLU), T_TOK, 1024, 512};
        pg8::StaticOrder S; S.init(T_TOK, 1024, G, (int)blockIdx.x);
        EpiGLU E{(bf16_t*)(ws + WS_Z)};
        pg8::gemm_phase(lds, g, S, E);
    }
    GRID_BAR();

#if defined(CHECK_X1) && CHECK_X1 == 2
    check_x1(P, lds, ctl, (const bf16_t*)(ws + WS_PK));
    GRID_BAR();
    { const float c = log2f(1.0f + (float)__hip_atomic_load(ctl + 300, __ATOMIC_RELAXED, __HIP_MEMORY_SCOPE_AGENT));
      for (int i = blockIdx.x * 512 + tid; i < T_TOK * DM; i += G * 512) P.out[i] = c; }
    return;
#endif
    PHASE_END(4);
    {
        pg8::Gemm g{(const bf16_t*)(ws + WS_Z), (const bf16_t*)(ws + WS_WUPS), T_TOK, 1024, 512};
        pg8::StaticOrder S; S.init(T_TOK, 1024, G, (int)blockIdx.x);
        pg8::Epi8<FUp1> E{FUp1{(const bf16_t*)P.out, (bf16_t*)(ws + WS_M1)}};
        pg8::gemm_phase(lds, g, S, E);
    }
    {
        pg8::Gemm g{(const bf16_t*)(ws + WS_O), (const bf16_t*)(ws + WS_WUPN), T_TOK, 1024, 512};
        pg8::StaticOrder S; S.init(T_TOK, 1024, G, (int)blockIdx.x);
        pg8::Epi8<FUp2> E{FUp2{(const bf16_t*)P.out, (const bf16_t*)(ws + WS_M1), (bf16_t*)(ws + WS_MIXIN)}};
        pg8::gemm_phase(lds, g, S, E);
    }
    GRID_BAR();

#ifdef CHECK_X1
    { const int row = (int)(((unsigned)blockIdx.x * 2654435761u) >> 18) & 16383; bf16_t* dstg = (bf16_t*)(ws + WS_PK); const bf16_t* srcg = (const bf16_t*)P.out;
      for (int i = tid; i < 2048; i += 512) dstg[(size_t)blockIdx.x * 2048 + i] = srcg[(size_t)row * 2048 + i]; }
    GRID_BAR();
#if CHECK_X1 == 3
    check_x1(P, lds, ctl, (const bf16_t*)(ws + WS_PK));
    GRID_BAR();
    { const float c = log2f(1.0f + (float)__hip_atomic_load(ctl + 300, __ATOMIC_RELAXED, __HIP_MEMORY_SCOPE_AGENT));
      for (int i = blockIdx.x * 512 + tid; i < T_TOK * DM; i += G * 512) P.out[i] = c; }
    return;
#endif
#endif
    PHASE_END(5);
    {
        pg8::Gemm g{(const bf16_t*)(ws + WS_MIXIN), (const bf16_t*)(ws + WS_WOUT), T_TOK, 1024, 1024};
        pg8::StaticOrder S; S.init(T_TOK, 1024, G, (int)blockIdx.x);
        pg8::Epi8<FOut> E{FOut{P.in[0], P.out}};
        pg8::gemm_phase(lds, g, S, E);
    }
    GRID_BAR();

#if defined(CHECK_X1) && CHECK_X1 == 4
    check_x1(P, lds, ctl, (const bf16_t*)(ws + WS_PK));
    GRID_BAR();
    { const float c = log2f(1.0f + (float)__hip_atomic_load(ctl + 300, __ATOMIC_RELAXED, __HIP_MEMORY_SCOPE_AGENT));
      for (int i = blockIdx.x * 512 + tid; i < T_TOK * DM; i += G * 512) P.out[i] = c; }
    return;
#endif
    PHASE_END(6);
    {
        const float* g1 = P.in[21]; const float* b1 = P.in[22];
        for (int row = blockIdx.x * 8 + wave; row < T_TOK; row += G * 8) {
            f32x4* xr = (f32x4*)(P.out + (size_t)row * 1024) + lane;
            f32x4 v[4]; float s = 0.f;
#pragma unroll
            for (int j = 0; j < 4; ++j) { v[j] = xr[64 * j]; s += (v[j][0] + v[j][1]) + (v[j][2] + v[j][3]); }
            const float mean = wave_sum(s) * (1.f / 1024.f); float s2 = 0.f;
#pragma unroll
            for (int j = 0; j < 4; ++j) { v[j] = v[j] - mean; s2 += (v[j][0] * v[j][0] + v[j][1] * v[j][1]) + (v[j][2] * v[j][2] + v[j][3] * v[j][3]); }
            const float rstd = 1.f / sqrtf(wave_sum(s2) * (1.f / 1024.f) + LN_EPS);
            u32x2* ob = (u32x2*)((bf16_t*)(ws + WS_X1B) + (size_t)row * 1024) + lane;
#pragma unroll
            for (int j = 0; j < 4; ++j) {
                const f32x4 gg = ((const f32x4*)g1)[64 * j + lane], bb = ((const f32x4*)b1)[64 * j + lane];
                const f32x4 o = v[j] * rstd * gg + bb; xr[64 * j] = o;
                u32x2 pw; pw.x = cvt_pk_bf16(o[0], o[1]); pw.y = cvt_pk_bf16(o[2], o[3]); ob[64 * j] = pw;
            }
        }
    }
    GRID_BAR();

#ifdef CHECK_X1
    check_x1(P, lds, ctl, (const bf16_t*)(ws + WS_PK));
    GRID_BAR();
    { const float c = log2f(1.0f + (float)__hip_atomic_load(ctl + 300, __ATOMIC_RELAXED, __HIP_MEMORY_SCOPE_AGENT));
      for (int i = blockIdx.x * 512 + tid; i < T_TOK * DM; i += G * 512) P.out[i] = c; }
    return;
#endif
    PHASE_END(7);
    {
        pg8::Gemm g{(const bf16_t*)(ws + WS_X1B), (const bf16_t*)(ws + WS_WQ), T_TOK, 1024, 1024};
        pg8::StaticOrder S; S.init(T_TOK, 1024, G, (int)blockIdx.x);
        pg8::Epi8<FQP> E{FQP{(bf16_t*)(ws + WS_QP)}};
        pg8::gemm_phase(lds, g, S, E);
    }
    GRID_BAR();

#ifdef CHECK_QP
    check_qp(P, lds, ctl);
    GRID_BAR();
    { const float c = log2f(1.0f + (float)__hip_atomic_load(ctl + 300, __ATOMIC_RELAXED, __HIP_MEMORY_SCOPE_AGENT));
      for (int i = blockIdx.x * 512 + tid; i < T_TOK * DM; i += G * 512) P.out[i] = c; }
    return;
#endif
    PHASE_END(8);
#if DUP_PHASE == 9
    for (int it = blockIdx.x * 8 + wave; it < 4096; it += G * 8) peer_score_item(P, lds, it, wave, lane);
    GRID_BAR();
#endif
    for (int it = blockIdx.x * 8 + wave; it < 4096; it += G * 8) peer_score_item(P, lds, it, wave, lane);
    GRID_BAR();

#ifdef CHECK_PEER
    check_peer(P, lds, ctl);
    GRID_BAR();
    { const float c = log2f(1.0f + (float)__hip_atomic_load(ctl + 300 + CHECK_PEER, __ATOMIC_RELAXED, __HIP_MEMORY_SCOPE_AGENT));
      for (int i = blockIdx.x * 512 + tid; i < T_TOK * DM; i += G * 512) P.out[i] = c; }
    return;
#endif
    PHASE_END(9);
#ifdef CHECK_P10
    { const int row = (int)(((unsigned)blockIdx.x * 2654435761u) >> 18) & 16383; float* xsave = (float*)(ws + WS_Z) + (size_t)blockIdx.x * 1024;
      for (int n = tid; n < 1024; n += 512) xsave[n] = P.out[(size_t)row * 1024 + n]; }
    GRID_BAR();
#endif
#if DUP_PHASE == 10
    for (int tok = blockIdx.x * 8 + wave; tok < T_TOK; tok += G * 8) peer_token(P, tok, lane, (float*)(ws + WS_Z));
    GRID_BAR();
#endif
#ifdef P10_OLD
    for (int tok = blockIdx.x * 8 + wave; tok < T_TOK; tok += G * 8) peer_token(P, tok, lane, P.out);
#else
    for (int tq = (blockIdx.x * 8 + wave) * 4; tq < T_TOK; tq += G * 8 * 4) peer_round4(P, lds + wave * 6144, tq, lane);
#endif
#ifdef CHECK_P10
    GRID_BAR();
    check_p10(P, lds, ctl);
    GRID_BAR();
    { const float c = log2f(1.0f + (float)__hip_atomic_load(ctl + 300, __ATOMIC_RELAXED, __HIP_MEMORY_SCOPE_AGENT));
      for (int i = blockIdx.x * 512 + tid; i < T_TOK * DM; i += G * 512) P.out[i] = c; }
#endif
}

extern "C" void kernel_launch(void* const* d_in, const int* in_sizes, int n_in, void* d_out, int out_size, void* d_ws, size_t ws_size, hipStream_t stream) {
    static int grid_blocks = 0;
    if (grid_blocks == 0) {
        if (n_in != 29 || out_size != T_TOK * DM || ws_size < WS_NEED) { fprintf(stderr, "kernel_launch: unexpected problem shape (n_in %d, out %d, ws %zu)\n", n_in, out_size, ws_size); grid_blocks = -1; return; }
        int dev = 0, cus = 0, per_cu = 0;
        hipGetDevice(&dev);
        hipDeviceGetAttribute(&cus, hipDeviceAttributeMultiprocessorCount, dev);
        hipFuncSetAttribute((const void*)hybrid_fwd, hipFuncAttributeMaxDynamicSharedMemorySize, LDS_BYTES);
        hipOccupancyMaxActiveBlocksPerMultiprocessor(&per_cu, (const void*)hybrid_fwd, 512, LDS_BYTES);
        if (per_cu < 1) { fprintf(stderr, "kernel_launch: occupancy query reports %d blocks per CU\n", per_cu); per_cu = 1; }
        grid_blocks = cus;
    }
    if (grid_blocks < 0) return;
    hipMemsetAsync((char*)d_ws + WS_CTL, 0, CTL_BYTES, stream);
    Params p{};
    for (int i = 0; i < 29; ++i) p.in[i] = (const float*)d_in[i];
    p.out = (float*)d_out; p.ws = (unsigned char*)d_ws;
    void* args[] = {&p};
    hipError_t e = hipLaunchCooperativeKernel((const void*)hybrid_fwd, dim3(grid_blocks), dim3(512), args, LDS_BYTES, stream);
    if (e != hipSuccess) fprintf(stderr, "cooperative launch failed: %s (grid %d)\n", hipGetErrorString(e), grid_blocks);
}
```

```cpp
#define STOP_AFTER 99
#define DG_A -1
#define DG_B 0
#include <hip/hip_runtime.h>
#include <hip/hip_cooperative_groups.h>
#include <cstdio>
namespace cg = cooperative_groups;
#ifndef ABL_NOPEER
#define ABL_NOPEER 0
#endif
#ifndef ABL_NOMIX
#define ABL_NOMIX 0
#endif
#ifndef ABL_NOSSM
#define ABL_NOSSM 0
#endif
#ifndef ABL_NONSA
#define ABL_NONSA 0
#endif
#ifndef ABL_NOCMP
#define ABL_NOCMP 0
#endif
#ifndef ABL_NOSLC
#define ABL_NOSLC 0
#endif
#ifndef ABL_NOWIN
#define ABL_NOWIN 0
#endif
#ifndef ABL_NOH
#define ABL_NOH 0
#endif
#ifndef DUP_PHASE
#define DUP_PHASE -1
#endif
#ifndef REP_SEL
#define REP_SEL 1
#endif
#ifndef REP_WIN
#define REP_WIN 1
#endif
#ifndef REP_CMP
#define REP_CMP 1
#endif

#define LAS __attribute__((address_space(3)))
typedef unsigned short bf16_t;
typedef short bf16x8 __attribute__((ext_vector_type(8)));
typedef short s16x4 __attribute__((ext_vector_type(4)));
typedef float f32x4 __attribute__((ext_vector_type(4)));
typedef float f32x16 __attribute__((ext_vector_type(16)));
typedef unsigned u32x4 __attribute__((ext_vector_type(4)));
typedef unsigned u32x2 __attribute__((ext_vector_type(2)));
typedef _Float16 h16x2 __attribute__((ext_vector_type(2)));

constexpr int T_TOK = 16384, DM = 1024, SEQ = 4096, NBATCH = 4;
constexpr int INC = 3864, INCP = 4096;
constexpr float DN_ALPHA = 1.189207115002721f;
constexpr float LN_EPS = 1e-5f;
constexpr float LOG2E = 1.4426950408889634f;

constexpr size_t MiB = 1u << 20, KiB = 1u << 10;
constexpr size_t WS_CTL = 0;
constexpr size_t CTL_BYTES = 64 * KiB;
constexpr size_t WS_SUBK = 1 * MiB;
constexpr size_t WS_W2K = WS_SUBK + 256 * KiB;
constexpr size_t WS_W2V = WS_W2K + 16 * KiB;
constexpr size_t WS_B1K = WS_W2V + 16 * KiB;
constexpr size_t WS_B1V = WS_B1K + 1 * KiB;
constexpr size_t WS_LAML = WS_B1V + 1 * KiB;
constexpr size_t WS_CF = WS_LAML + 16 * KiB;
constexpr size_t WS_LP = 30 * MiB + 512 * KiB;
constexpr size_t WS_W1K = 2 * MiB;
constexpr size_t WS_W1V = 2 * MiB + 512 * KiB;
constexpr size_t WS_KTAB = 3 * MiB;
constexpr size_t WS_ETAB = 5 * MiB;
constexpr size_t WS_FTAB = 13 * MiB;
constexpr size_t WS_WGLU = 21 * MiB;
constexpr size_t WS_WUPS = 22 * MiB;
constexpr size_t WS_WUPN = 23 * MiB;
constexpr size_t WS_WOUT = 24 * MiB;
constexpr size_t WS_WQ = 26 * MiB;
constexpr size_t WS_KC = 28 * MiB;
constexpr size_t WS_VC = WS_KC + 256 * KiB;
constexpr size_t WS_GATES = 29 * MiB;
constexpr size_t WS_UTAB = 32 * MiB;
constexpr size_t WS_VTAB = 48 * MiB;
constexpr size_t WS_XB = 96 * MiB;
constexpr size_t WS_Z = 96 * MiB;
constexpr size_t WS_O = 112 * MiB;
constexpr size_t WS_WIN = 128 * MiB;
constexpr size_t WS_UG = 136 * MiB;
constexpr size_t WS_MIXIN = 136 * MiB;
constexpr size_t WS_Q = 152 * MiB;
constexpr size_t WS_KV = 168 * MiB;
constexpr size_t WS_X1B = 168 * MiB;
constexpr size_t WS_YG = 192 * MiB;
constexpr size_t WS_M1 = 208 * MiB;
constexpr size_t WS_QP = 208 * MiB;
constexpr size_t WS_PK = 240 * MiB;
constexpr size_t WS_NEED = 256 * MiB;
constexpr int CW_Q2 = 64, CW_Q3 = 128, CW_Q3B = 192, CW_BAR = 4096;

constexpr int LDS_BYTES = 147456;

struct Params {
    const float* in[29];
    float* out;
    unsigned char* ws;
};

typedef __bf16 bf16v2 __attribute__((ext_vector_type(2)));
__device__ __forceinline__ unsigned cvt_pk_bf16(float lo, float hi) { bf16v2 v; v.x = (__bf16)lo; v.y = (__bf16)hi; return __builtin_bit_cast(unsigned, v); }
__device__ __forceinline__ float bf_lo(unsigned w) { return __uint_as_float(w << 16); }
__device__ __forceinline__ float bf_hi(unsigned w) { return __uint_as_float(w & 0xffff0000u); }
__device__ __forceinline__ float bf2f(bf16_t b) { return __uint_as_float(((unsigned)b) << 16); }
__device__ __forceinline__ bf16_t f2bf(float f) { return (bf16_t)(cvt_pk_bf16(f, 0.f) & 0xffffu); }
__device__ __forceinline__ float fast_exp2(float x) { return __builtin_amdgcn_exp2f(x); }
__device__ __forceinline__ float fast_rcp(float x) { return __builtin_amdgcn_rcpf(x); }
__device__ __forceinline__ float sigmoidf_(float x) { return fast_rcp(1.0f + fast_exp2(-x * LOG2E)); }
__device__ __forceinline__ float gelu_tanh(float x) { const float u = 1.5957691216057308f * x * (1.0f + 0.044715f * x * x); return x * fast_rcp(1.0f + fast_exp2(-u * LOG2E)); }
__device__ __forceinline__ float wave_sum(float v) {
#pragma unroll
    for (int o = 1; o < 64; o <<= 1) v += __shfl_xor(v, o);
    return v;
}
__device__ __forceinline__ unsigned pack_h2(float a, float b) { h16x2 h; h.x = (_Float16)a; h.y = (_Float16)b; return __builtin_bit_cast(unsigned, h); }

namespace pg8 {
constexpr int BM = 256, BK = 64, HALF = 128, HTB = HALF * BK * 2, STAGE_BYTES = 8 * HTB, NXCD = 8, WGM = 8;
__host__ __device__ __forceinline__ int lds_byte(int r, int c) { const int st = (r >> 4) * 2 + (c >> 5), rr = r & 15, cc = c & 31, ob = rr * 64 + cc * 2; return st * 1024 + (ob ^ (((ob >> 9) & 1) << 5)); }
__host__ __device__ __forceinline__ void stage_rc(int b, int& R, int& C) { const int st = b / 1024, sb = b % 1024, swz = sb ^ (((sb >> 9) & 1) << 5); R = (st >> 1) * 16 + swz / 64; C = (st & 1) * 32 + (swz % 64) / 2; }
__host__ __device__ __forceinline__ int perm32(int rho) { const int n = rho >> 4, i = rho & 15; return 8 * (i >> 2) + 4 * n + (i & 3); }
struct Unit { int pm, pn; };
struct Gemm { const bf16_t* A; const bf16_t* Bt; int M, N, K; };
struct StaticOrder {
    int nM, nN, nwg, G, c;
    __device__ void init(int M, int N, int G_, int c_) { nM = M / BM; nN = N / BM; nwg = nM * nN; G = G_; c = c_; }
    __device__ bool next(int i, Unit& u) const {
        const long L = (long)i * G + c; if (L >= nwg) return false;
        int wgid = (int)L; { const int q = nwg / NXCD, r = nwg % NXCD, xcd = wgid % NXCD, off = wgid / NXCD; wgid = (xcd < r ? xcd * (q + 1) : r * (q + 1) + (xcd - r) * q) + off; }
        const int nig = WGM * nN, gid = wgid / nig, fm = gid * WGM, gsz = (nM - fm) < WGM ? (nM - fm) : WGM;
        u.pm = fm + ((wgid % nig) % gsz); u.pn = (wgid % nig) / gsz; return true;
    }
};
template <class Epi>
__device__ __forceinline__ void gemm_phase(LAS unsigned char* lds, const Gemm g, const StaticOrder& S, const Epi& E) {
    int tid_ = threadIdx.x; asm volatile("" : "+v"(tid_));
    const int tid = tid_, wid = __builtin_amdgcn_readfirstlane(tid >> 6), lane = tid & 63, wr = wid >> 2, wc = wid & 3, fr = lane & 15, fq = lane >> 4;
    const int K = g.K, nt = K / BK;
    unsigned voffA[2], voffB[2];
#pragma unroll
    for (int i = 0; i < 2; ++i) { int R, C; stage_rc(tid * 16 + i * 8192, R, C); const int Rb = (R & ~31) + perm32(R & 31);
        voffA[i] = (unsigned)(R * K + C) * 2u; voffB[i] = (unsigned)(Rb * K + C) * 2u; }
    const size_t kstep = (size_t)(BK * 2);
    const size_t hstep = (size_t)HALF * K * 2;
    const size_t tstep = 2 * hstep;
    const unsigned ldsw = (unsigned)wid * 1024u;
    const int aoff = lds_byte(wr * 64 + fr, fq * 8), boff = lds_byte(wc * 32 + fr, fq * 8);
#define PG8_SA(b, h) (((b) * 2 + (h)) * HTB)
#define PG8_SB(b, h) ((4 + (b) * 2 + (h)) * HTB)
#define PG8_STAGE(bufoff, gbase, voff) do { _Pragma("unroll") for (int _i = 0; _i < 2; ++_i) \
        __builtin_amdgcn_global_load_lds((const unsigned*)((const char*)(gbase) + (voff)[_i]), (LAS unsigned*)(lds + (bufoff) + ldsw + _i * 8192), 16, 0, 0); } while (0)
#define PG8_LDA(dst, b, h) do { _Pragma("unroll") for (int m = 0; m < 4; ++m) _Pragma("unroll") for (int k = 0; k < 2; ++k) dst[m][k] = *(const LAS bf16x8*)(lds + PG8_SA(b, h) + aoff + m * 2048 + k * 1024); } while (0)
#define PG8_LDB(dst, b, h) do { _Pragma("unroll") for (int n = 0; n < 2; ++n) _Pragma("unroll") for (int k = 0; k < 2; ++k) dst[n][k] = *(const LAS bf16x8*)(lds + PG8_SB(b, h) + boff + n * 2048 + k * 1024); } while (0)
#define PG8_MMA(ai, bj, At, Bt) do { __builtin_amdgcn_s_setprio(1); _Pragma("unroll") for (int m = 0; m < 4; ++m) _Pragma("unroll") for (int n = 0; n < 2; ++n) _Pragma("unroll") for (int k = 0; k < 2; ++k) \
        acc[ai][bj][m][n] = __builtin_amdgcn_mfma_f32_16x16x32_bf16(Bt[n][k], At[m][k], acc[ai][bj][m][n], 0, 0, 0); __builtin_amdgcn_s_setprio(0); } while (0)
#define PG8_WAIT_V(n) asm volatile("s_waitcnt vmcnt(" #n ")" ::: "memory")
#define PG8_WAIT_L(n) asm volatile("s_waitcnt lgkmcnt(" #n ")" ::: "memory")
#define PG8_BAR __builtin_amdgcn_s_barrier()
#define PG8_SCHED __builtin_amdgcn_sched_barrier(0)
    Unit cur, nxt; int ui = 0;
    if (!S.next(0, cur)) return;
    f32x4 acc[2][2][4][2];
#pragma unroll
    for (int a = 0; a < 2; ++a)
#pragma unroll
        for (int b = 0; b < 2; ++b)
#pragma unroll
            for (int m = 0; m < 4; ++m)
#pragma unroll
                for (int n = 0; n < 2; ++n) acc[a][b][m][n] = (f32x4){0.f, 0.f, 0.f, 0.f};
    bf16x8 At[4][2], B0[2][2], B1[2][2];
    const char* cA = (const char*)g.A + (size_t)cur.pm * tstep; const char* cB = (const char*)g.Bt + (size_t)cur.pn * tstep;
    PG8_STAGE(PG8_SB(0, 0), cB, voffB); PG8_STAGE(PG8_SA(0, 0), cA, voffA); PG8_STAGE(PG8_SB(0, 1), cB + hstep, voffB); PG8_STAGE(PG8_SA(0, 1), cA + hstep, voffA);
    if (wr == 1) PG8_BAR;
    PG8_WAIT_V(4); PG8_BAR;
    PG8_STAGE(PG8_SB(1, 0), cB + kstep, voffB); PG8_STAGE(PG8_SA(1, 0), cA + kstep, voffA); PG8_STAGE(PG8_SB(1, 1), cB + hstep + kstep, voffB);
    PG8_WAIT_V(6); PG8_BAR;
    for (;;) {
        const bool has_next = S.next(ui + 1, nxt);
        const char* nA = has_next ? (const char*)g.A + (size_t)nxt.pm * tstep : cA; const char* nB = has_next ? (const char*)g.Bt + (size_t)nxt.pn * tstep : cB;
        for (int t = 0; t < nt; t += 2) {
            const bool last = (t == nt - 2);
            const char* a1 = cA + (size_t)(t + 1) * kstep;
            const char* a2 = last ? nA : cA + (size_t)(t + 2) * kstep; const char* b2 = last ? nB : cB + (size_t)(t + 2) * kstep;
            const char* a3 = a2 + kstep; const char* b3 = b2 + kstep;
            PG8_LDB(B0, 0, 0); PG8_SCHED; PG8_LDA(At, 0, 0); PG8_STAGE(PG8_SA(1, 1), a1 + hstep, voffA);
            PG8_WAIT_L(8); PG8_BAR; PG8_WAIT_L(0); PG8_MMA(0, 0, At, B0); PG8_BAR; PG8_SCHED;
            PG8_LDB(B1, 0, 1); PG8_STAGE(PG8_SB(0, 0), b2, voffB);
            PG8_BAR; PG8_WAIT_L(0); PG8_MMA(0, 1, At, B1); PG8_BAR;
            PG8_LDA(At, 0, 1); PG8_STAGE(PG8_SA(0, 0), a2, voffA);
            PG8_BAR; PG8_WAIT_L(0); PG8_MMA(1, 0, At, B0); PG8_BAR; PG8_SCHED;
            PG8_STAGE(PG8_SB(0, 1), b2 + hstep, voffB);
            PG8_WAIT_V(6); PG8_BAR; PG8_MMA(1, 1, At, B1); PG8_BAR;
            PG8_LDB(B0, 1, 0); PG8_SCHED; PG8_LDA(At, 1, 0); PG8_STAGE(PG8_SA(0, 1), a2 + hstep, voffA);
            PG8_WAIT_L(8); PG8_BAR; PG8_WAIT_L(0); PG8_MMA(0, 0, At, B0); PG8_BAR; PG8_SCHED;
            PG8_LDB(B1, 1, 1); PG8_STAGE(PG8_SB(1, 0), b3, voffB);
            PG8_BAR; PG8_WAIT_L(0); PG8_MMA(0, 1, At, B1); PG8_BAR;
            PG8_LDA(At, 1, 1); PG8_STAGE(PG8_SA(1, 0), a3, voffA);
            PG8_BAR; PG8_WAIT_L(0); PG8_MMA(1, 0, At, B0); PG8_BAR; PG8_SCHED;
            PG8_STAGE(PG8_SB(1, 1), b3 + hstep, voffB);
            PG8_WAIT_V(6); PG8_BAR; PG8_MMA(1, 1, At, B1); PG8_BAR;
        }
        E(acc, cur, wr, wc, fr, fq);
        if (!has_next) break;
#pragma unroll
        for (int a = 0; a < 2; ++a)
#pragma unroll
            for (int b = 0; b < 2; ++b)
#pragma unroll
                for (int m = 0; m < 4; ++m)
#pragma unroll
                    for (int n = 0; n < 2; ++n) acc[a][b][m][n] = (f32x4){0.f, 0.f, 0.f, 0.f};
        cur = nxt; cA = nA; cB = nB; ++ui;
    }
    PG8_WAIT_V(0);
    if (wr == 0) PG8_BAR;
    PG8_BAR;
#undef PG8_SA
#undef PG8_SB
#undef PG8_STAGE
#undef PG8_LDA
#undef PG8_LDB
#undef PG8_MMA
#undef PG8_WAIT_V
#undef PG8_WAIT_L
#undef PG8_BAR
#undef PG8_SCHED
}
template <class F> struct Epi8 {
    F f;
    __device__ __forceinline__ void operator()(const f32x4 (&acc)[2][2][4][2], const Unit& u, int wr, int wc, int fr, int fq) const {
        const int row0 = u.pm * BM + wr * 64 + fr, col0 = u.pn * BM + wc * 32 + 8 * fq;
#pragma unroll
        for (int ai = 0; ai < 2; ++ai)
#pragma unroll
            for (int m = 0; m < 4; ++m) {
                const int row = row0 + ai * HALF + m * 16;
#pragma unroll
                for (int bj = 0; bj < 2; ++bj) f(row, col0 + bj * HALF, acc[ai][bj][m][0], acc[ai][bj][m][1]);
            }
    }
};
}

__device__ __forceinline__ u32x4 pack8(const f32x4& a, const f32x4& b) {
    u32x4 w; w.x = cvt_pk_bf16(a[0], a[1]); w.y = cvt_pk_bf16(a[2], a[3]); w.z = cvt_pk_bf16(b[0], b[1]); w.w = cvt_pk_bf16(b[2], b[3]); return w;
}

struct FInProj {
    const float* bias; bf16_t* UG; bf16_t* Q; bf16_t* KV; float* GATES; bf16_t* GM;
    __device__ __forceinline__ void operator()(int row, int col, f32x4 v0, f32x4 v1) const {
        if (col >= INC) return;
        const f32x4 b0 = *(const f32x4*)(bias + col), b1 = *(const f32x4*)(bias + col + 4);
        v0 += b0; v1 += b1;
        if (col < 512) {
            const int b = row >> 12, s = row & 4095, g = col >> 4, hp = col & 15;
            *(u32x4*)(UG + ((size_t)((b * 32 + g) * 4096 + s)) * 16 + hp) = pack8(v0, v1);
        } else if (col < 1024) {
            *(u32x4*)(Q + (size_t)row * 512 + (col - 512)) = pack8(v0 * (0.125f * LOG2E), v1 * (0.125f * LOG2E));
        } else if (col < 1792) {
            const int idx = (col - 1024) >> 7, cc = (col - 1024) & 127;
            *(u32x4*)(KV + ((size_t)idx * T_TOK + row) * 128 + cc) = pack8(v0, v1);
        } else if (col < 1816) {
            f32x4 s0, s1;
#pragma unroll
            for (int j = 0; j < 4; ++j) { s0[j] = sigmoidf_(v0[j]); s1[j] = sigmoidf_(v1[j]); }
            float* gp = GATES + (size_t)row * 24 + (col - 1792);
            *(f32x4*)gp = s0; *(f32x4*)(gp + 4) = s1;
        } else {
            f32x4 s0, s1;
#pragma unroll
            for (int j = 0; j < 4; ++j) { s0[j] = sigmoidf_(v0[j]); s1[j] = sigmoidf_(v1[j]); }
            *(u32x4*)(GM + (size_t)row * 2048 + (col - 1816)) = pack8(s0, s1);
        }
    }
};
struct EpiGLU {
    bf16_t* ZO;
    __device__ __forceinline__ void operator()(const f32x4 (&acc)[2][2][4][2], const pg8::Unit& u, int wr, int wc, int fr, int fq) const {
        const int row0 = u.pm * 256 + wr * 64 + fr, col0 = u.pn * 128 + wc * 32 + 8 * fq;
#pragma unroll
        for (int ai = 0; ai < 2; ++ai)
#pragma unroll
            for (int m = 0; m < 4; ++m) {
                const int row = row0 + ai * 128 + m * 16;
                f32x4 z0, z1;
#pragma unroll
                for (int j = 0; j < 4; ++j) { z0[j] = acc[ai][0][m][0][j] * sigmoidf_(acc[ai][1][m][0][j]); z1[j] = acc[ai][0][m][1][j] * sigmoidf_(acc[ai][1][m][1][j]); }
                *(u32x4*)(ZO + (size_t)row * 512 + col0) = pack8(z0, z1);
            }
    }
};
struct FUp1 {
    const bf16_t* GM; bf16_t* M1;
    __device__ __forceinline__ void operator()(int row, int col, f32x4 v0, f32x4 v1) const {
        const u32x4 g = *(const u32x4*)(GM + (size_t)row * 2048 + col);
        if (ABL_NOSSM) { v0 = (f32x4){0.f, 0.f, 0.f, 0.f}; v1 = v0; }
        v0[0] *= bf_lo(g.x); v0[1] *= bf_hi(g.x); v0[2] *= bf_lo(g.y); v0[3] *= bf_hi(g.y);
        v1[0] *= bf_lo(g.z); v1[1] *= bf_hi(g.z); v1[2] *= bf_lo(g.w); v1[3] *= bf_hi(g.w);
        *(u32x4*)(M1 + (size_t)row * 1024 + col) = pack8(v0, v1);
    }
};
struct FUp2 {
    const bf16_t* GM; const bf16_t* M1; bf16_t* MX;
    __device__ __forceinline__ void operator()(int row, int col, f32x4 v0, f32x4 v1) const {
        const u32x4 g = *(const u32x4*)(GM + (size_t)row * 2048 + 1024 + col);
        const u32x4 a = *(const u32x4*)(M1 + (size_t)row * 1024 + col);
        if (ABL_NONSA) { v0 = (f32x4){0.f, 0.f, 0.f, 0.f}; v1 = v0; }
        v0[0] = v0[0] * bf_lo(g.x) + bf_lo(a.x); v0[1] = v0[1] * bf_hi(g.x) + bf_hi(a.x); v0[2] = v0[2] * bf_lo(g.y) + bf_lo(a.y); v0[3] = v0[3] * bf_hi(g.y) + bf_hi(a.y);
        v1[0] = v1[0] * bf_lo(g.z) + bf_lo(a.z); v1[1] = v1[1] * bf_hi(g.z) + bf_hi(a.z); v1[2] = v1[2] * bf_lo(g.w) + bf_lo(a.w); v1[3] = v1[3] * bf_hi(g.w) + bf_hi(a.w);
        *(u32x4*)(MX + (size_t)row * 1024 + col) = pack8(v0, v1);
    }
};
struct FOut {
    const float* x; float* R;
    __device__ __forceinline__ void operator()(int row, int col, f32x4 v0, f32x4 v1) const {
        const f32x4 x0 = *(const f32x4*)(x + (size_t)row * 1024 + col), x1 = *(const f32x4*)(x + (size_t)row * 1024 + col + 4);
        if (ABL_NOMIX) { v0 = (f32x4){0.f, 0.f, 0.f, 0.f}; v1 = v0; }
        *(f32x4*)(R + (size_t)row * 1024 + col) = x0 * DN_ALPHA + v0;
        *(f32x4*)(R + (size_t)row * 1024 + col + 4) = x1 * DN_ALPHA + v1;
    }
};
struct FQP {
    bf16_t* QP;
    __device__ __forceinline__ void operator()(int row, int col, f32x4 v0, f32x4 v1) const { *(u32x4*)(QP + (size_t)row * 1024 + col) = pack8(v0, v1); }
};

struct cpx { float re, im; };
__device__ __forceinline__ cpx cmul(cpx a, cpx b) { return {a.re * b.re - a.im * b.im, a.re * b.im + a.im * b.re}; }
__device__ __forceinline__ cpx lam_pow(float are, float aim, float dt, float tau) {
    const float er = are * dt * tau, ei = aim * dt * tau; const float m = expf(er); float s, c; sincosf(ei, &s, &c); return {m * c, m * s};
}
__device__ __forceinline__ cpx bbar_coef(float are, float aim, float dt) {
    const float x = are * dt, y = aim * dt; const float ex1 = expm1f(x); float s, c; sincosf(y, &s, &c); const float sh = sinf(0.5f * y);
    const float nr = ex1 * c - 2.f * sh * sh, ni = (ex1 + 1.f) * s;
    const float den = are * are + aim * aim;
    return {(nr * are + ni * aim) / den, (ni * are - nr * aim) / den};
}
template <class CM>
__device__ __forceinline__ void transpose_w(const float* src, int K, int Ns, bf16_t* dst, int Nd, CM cm, int gtid, int NT) {
    const int kch = K / 8; const long total = (long)Nd * kch;
    for (long i = gtid; i < total; i += NT) {
        const int n = (int)(i % Nd), kc = (int)(i / Nd); const int sc = cm(n);
        float v[8];
#pragma unroll
        for (int j = 0; j < 8; ++j) v[j] = sc >= 0 ? src[(size_t)(kc * 8 + j) * Ns + sc] : 0.f;
        u32x4 w; w.x = cvt_pk_bf16(v[0], v[1]); w.y = cvt_pk_bf16(v[2], v[3]); w.z = cvt_pk_bf16(v[4], v[5]); w.w = cvt_pk_bf16(v[6], v[7]);
        *(u32x4*)(dst + (size_t)n * K + kc * 8) = w;
    }
}
__device__ __forceinline__ void p0_prologue(const Params& P, LAS unsigned char* lds) {
    const int gtid = blockIdx.x * 512 + threadIdx.x, NT = gridDim.x * 512;
    unsigned char* ws = P.ws;
    { const f32x4* x4 = (const f32x4*)P.in[0]; u32x4* o = (u32x4*)(ws + WS_XB);
      for (int i = gtid; i < T_TOK * DM / 8; i += NT) { const f32x4 a = x4[2 * i], b = x4[2 * i + 1]; o[i] = pack8(a, b); } }
    { const f32x4* u4 = (const f32x4*)P.in[25]; const f32x4* v4 = (const f32x4*)P.in[26]; u32x4* uo = (u32x4*)(ws + WS_UTAB); u32x4* vo = (u32x4*)(ws + WS_VTAB);
      for (int i = gtid; i < 16384 * 1024 / 16; i += NT) {
          u32x4 w, z;
#pragma unroll
          for (int q = 0; q < 4; ++q) {
              const f32x4 a = u4[4 * i + q] * 64.0f, c = v4[4 * i + q] * 8.0f;
              int t = __builtin_amdgcn_cvt_pk_fp8_f32(a[0], a[1], 0, false); t = __builtin_amdgcn_cvt_pk_fp8_f32(a[2], a[3], t, true); w[q] = (unsigned)t;
              int r = __builtin_amdgcn_cvt_pk_fp8_f32(c[0], c[1], 0, false); r = __builtin_amdgcn_cvt_pk_fp8_f32(c[2], c[3], r, true); z[q] = (unsigned)r;
          }
          uo[i] = w; vo[i] = z; } }
    {
        LAS float* scr = (LAS float*)(lds + (threadIdx.x >> 6) * 8448);
        const int lane = threadIdx.x & 63, gw = gtid >> 6, NGW = NT >> 6;
        const float* srcs[10] = {P.in[1], P.in[11], P.in[12], P.in[19], P.in[20], P.in[23], P.in[14], P.in[17], P.in[15], P.in[18]};
        const size_t dsts[10] = {WS_WIN, WS_WGLU, WS_WUPS, WS_WUPN, WS_WOUT, WS_WQ, WS_W1K, WS_W1V, WS_W2K, WS_W2V};
        const int Ks[10] = {1024, 512, 512, 512, 1024, 1024, 2048, 2048, 128, 128};
        const int Ns[10] = {INC, 1024, 1024, 1024, 1024, 1024, 128, 128, 64, 64};
        int base = 0;
#pragma unroll
        for (int mtx = 0; mtx < 10; ++mtx) {
            const int K = Ks[mtx], N = Ns[mtx], nblk = (N + 31) / 32, nitems = (K / 64) * nblk;
            const float* W = srcs[mtx]; bf16_t* WT = (bf16_t*)(ws + dsts[mtx]);
            for (int it = gw - base; it < nitems; it += NGW) {
                if (it < 0) continue;
                const int kb = it / nblk, nb = it % nblk, k0 = 64 * kb, n0 = 32 * nb;
                const bool nok = (n0 + (lane & 31)) < N;
#pragma unroll 8
                for (int i = 0; i < 32; ++i) { const int kk = 2 * i + (lane >> 5); scr[kk * 33 + (lane & 31)] = nok ? W[(size_t)(k0 + kk) * N + n0 + (lane & 31)] : 0.f; }
                asm volatile("s_waitcnt lgkmcnt(0)" ::: "memory");
                int r0 = n0;
                if (mtx == 1) { const int bj = n0 >> 9, pn = (n0 >> 7) & 3, i0 = n0 & 127; r0 = 256 * pn + 128 * bj + i0; }
                const int c = lane & 7;
#pragma unroll
                for (int j = 0; j < 4; ++j) { const int n = (lane >> 3) + 8 * j; const LAS float* sp = scr + (8 * c) * 33 + n;
                    u32x4 o; o.x = cvt_pk_bf16(sp[0 * 33], sp[1 * 33]); o.y = cvt_pk_bf16(sp[2 * 33], sp[3 * 33]); o.z = cvt_pk_bf16(sp[4 * 33], sp[5 * 33]); o.w = cvt_pk_bf16(sp[6 * 33], sp[7 * 33]);
                    *(u32x4*)(WT + (size_t)(r0 + n) * K + k0 + 8 * c) = o; }
                asm volatile("s_waitcnt lgkmcnt(0)" ::: "memory");
            }
            base = (base + nitems) % NGW;
        }
        { u32x4* z = (u32x4*)((bf16_t*)(ws + WS_WIN) + (size_t)3872 * 1024); const u32x4 zero = {0u, 0u, 0u, 0u}; for (int i = gtid; i < 224 * 1024 / 8; i += NT) z[i] = zero; }
    }
    { const float* sk = P.in[24]; bf16_t* o = (bf16_t*)(ws + WS_SUBK); for (int i = gtid; i < 8 * 2 * 128 * 64; i += NT) o[i] = f2bf(sk[i]); }
    { const int gw = gtid >> 6, ln = gtid & 63;
      if (gw < 256) { const int kv = gw >> 7, n = gw & 127; const float* pe = P.in[kv ? 16 : 13]; const float* w1 = P.in[kv ? 17 : 14]; float s = 0.f;
        for (int k = ln; k < 2048; k += 64) s += pe[k] * w1[(size_t)k * 128 + n];
        s = wave_sum(s);
        if (ln == 0) ((float*)(ws + (kv ? WS_B1V : WS_B1K)))[n] = s; } }
    const float* a_re = P.in[3]; const float* a_im = P.in[4]; const float* log_dt = P.in[5]; const float* b_re = P.in[6]; const float* b_im = P.in[7]; const float* c_re = P.in[8]; const float* c_im = P.in[9];
    for (int i = gtid; i < 32 * 64 * 65; i += NT) {
        const int lag = i % 65, gp = i / 65, g = gp >> 6; const float dt = expf(log_dt[g]);
        const cpx l = lam_pow(a_re[gp], a_im[gp], dt, (float)lag);
        ((float*)(ws + WS_LP))[2 * i] = l.re; ((float*)(ws + WS_LP))[2 * i + 1] = l.im;
        if (lag == 64) { ((float*)(ws + WS_LAML))[2 * gp] = l.re; ((float*)(ws + WS_LAML))[2 * gp + 1] = l.im; }
        if (lag == 0) { const cpx cf = bbar_coef(a_re[gp], a_im[gp], dt); ((float*)(ws + WS_CF))[2 * gp] = cf.re; ((float*)(ws + WS_CF))[2 * gp + 1] = cf.im; }
    }
}
__device__ __forceinline__ void s5_tables(const Params& P) {
    const int gtid = blockIdx.x * 512 + threadIdx.x, NT = gridDim.x * 512;
    unsigned char* ws = P.ws;
    const float* b_re = P.in[6]; const float* b_im = P.in[7]; const float* c_re = P.in[8]; const float* c_im = P.in[9];
    const float* LP = (const float*)(ws + WS_LP); const float* CF = (const float*)(ws + WS_CF);
    for (int i = gtid; i < 32 * 64 * 64; i += NT) {
        const int sq = i & 63, p = (i >> 6) & 63, g = i >> 12, gp = g * 64 + p;
        const cpx lp = {LP[2 * (gp * 65 + 63 - sq)], LP[2 * (gp * 65 + 63 - sq) + 1]}; const cpx cf = {CF[2 * gp], CF[2 * gp + 1]};
        const cpx f = cmul(lp, cf);
        float vr[16], vi[16];
#pragma unroll
        for (int j = 0; j < 16; ++j) { const float br = b_re[gp * 16 + j], bi = b_im[gp * 16 + j]; vr[j] = f.re * br - f.im * bi; vi[j] = f.re * bi + f.im * br; }
        bf16_t* er = (bf16_t*)(ws + WS_ETAB) + ((size_t)g * 128 + p) * 1024 + sq * 16; bf16_t* ei = er + (size_t)64 * 1024;
        u32x4 w;
        w.x = cvt_pk_bf16(vr[0], vr[1]); w.y = cvt_pk_bf16(vr[2], vr[3]); w.z = cvt_pk_bf16(vr[4], vr[5]); w.w = cvt_pk_bf16(vr[6], vr[7]); ((u32x4*)er)[0] = w;
        w.x = cvt_pk_bf16(vr[8], vr[9]); w.y = cvt_pk_bf16(vr[10], vr[11]); w.z = cvt_pk_bf16(vr[12], vr[13]); w.w = cvt_pk_bf16(vr[14], vr[15]); ((u32x4*)er)[1] = w;
        w.x = cvt_pk_bf16(vi[0], vi[1]); w.y = cvt_pk_bf16(vi[2], vi[3]); w.z = cvt_pk_bf16(vi[4], vi[5]); w.w = cvt_pk_bf16(vi[6], vi[7]); ((u32x4*)ei)[0] = w;
        w.x = cvt_pk_bf16(vi[8], vi[9]); w.y = cvt_pk_bf16(vi[10], vi[11]); w.z = cvt_pk_bf16(vi[12], vi[13]); w.w = cvt_pk_bf16(vi[14], vi[15]); ((u32x4*)ei)[1] = w;
    }
    for (int i = gtid; i < 32 * 64 * 16 * 2 * 8; i += NT) {
        const int p8 = i & 7, half = (i >> 3) & 1, h = (i >> 4) & 15, t = (i >> 8) & 63, g = i >> 14;
        float v[8];
#pragma unroll
        for (int j = 0; j < 8; ++j) { const int p = p8 * 8 + j, gp = g * 64 + p; const cpx lp = {LP[2 * (gp * 65 + t + 1)], LP[2 * (gp * 65 + t + 1) + 1]};
            const cpx C = {c_re[(g * 16 + h) * 64 + p], c_im[(g * 16 + h) * 64 + p]}; const cpx cl = cmul(C, lp); v[j] = half ? -cl.im : cl.re; }
        u32x4 w; w.x = cvt_pk_bf16(v[0], v[1]); w.y = cvt_pk_bf16(v[2], v[3]); w.z = cvt_pk_bf16(v[4], v[5]); w.w = cvt_pk_bf16(v[6], v[7]);
        *(u32x4*)((bf16_t*)(ws + WS_FTAB) + ((size_t)g * 1024 + t * 16 + h) * 128 + half * 64 + p8 * 8) = w;
    }
}

__device__ __forceinline__ void compress_item(const Params& P, LAS unsigned char* lds, int item) {
    unsigned char* ws = P.ws;
    int tid_ = threadIdx.x; asm volatile("" : "+v"(tid_));
    const int tid = tid_, lane = tid & 63, w = __builtin_amdgcn_readfirstlane(tid >> 6), fr = lane & 15, q = lane >> 4;
    const int ct = item & 15, g = (item >> 4) & 1, b = (item >> 5) & 3, kv = item >> 7;
    const bf16_t* src = (const bf16_t*)(ws + WS_KV) + (size_t)(kv ? 1 : 0) * T_TOK * 128;
    const bf16_t* W1T = (const bf16_t*)(ws + (kv ? WS_W1V : WS_W1K));
    const bf16_t* W2T = (const bf16_t*)(ws + (kv ? WS_W2V : WS_W2K));
    const float* bias1 = (const float*)(ws + (kv ? WS_B1V : WS_B1K));
    bf16_t* dst = (bf16_t*)(ws + (kv ? WS_VC : WS_KC));
    constexpr int AT_BYTES = 288 * 144;
    for (int pc = tid; pc < 272 * 8; pc += 512) {
        const int r = pc >> 3, piece = pc & 7; int tok = 256 * ct + r; tok = tok > 4095 ? 4095 : tok;
        const u32x4 v = *(const u32x4*)(src + ((size_t)(b * 4096 + tok)) * 128 + g * 64 + piece * 8);
        *(LAS u32x4*)(lds + ((r & 15) * 18 + (r >> 4)) * 144 + piece * 16) = v;
    }
    __syncthreads();
    f32x4 acc = {0.f, 0.f, 0.f, 0.f};
    const bf16_t* brow = W1T + (size_t)(16 * w + fr) * 2048 + 8 * q;
#pragma unroll 8
    for (int kk = 0; kk < 64; ++kk) {
        const int l = kk >> 1, d = (kk & 1) * 32 + 8 * q;
        const bf16x8 A = *(const LAS bf16x8*)(lds + ((l & 15) * 18 + fr + (l >> 4)) * 144 + d * 2);
        const bf16x8 B = *(const bf16x8*)(brow + kk * 32);
        acc = __builtin_amdgcn_mfma_f32_16x16x32_bf16(A, B, acc, 0, 0, 0);
    }
    LAS bf16_t* H1 = (LAS bf16_t*)(lds + AT_BYTES);
    { const int col = 16 * w + fr; const float bb = bias1[col];
#pragma unroll
      for (int r = 0; r < 4; ++r) H1[(4 * q + r) * 136 + col] = f2bf(gelu_tanh(acc[r] + bb)); }
    __syncthreads();
    if (w < 4) {
        f32x4 a2 = {0.f, 0.f, 0.f, 0.f};
#pragma unroll
        for (int kk = 0; kk < 4; ++kk) {
            const bf16x8 A = *(const LAS bf16x8*)(H1 + fr * 136 + kk * 32 + 8 * q);
            const bf16x8 B = *(const bf16x8*)(W2T + (size_t)(16 * w + fr) * 128 + kk * 32 + 8 * q);
            a2 = __builtin_amdgcn_mfma_f32_16x16x32_bf16(A, B, a2, 0, 0, 0);
        }
#pragma unroll
        for (int r = 0; r < 4; ++r) dst[((size_t)((b * 2 + g) * 256 + ct * 16 + 4 * q + r)) * 64 + 16 * w + fr] = f2bf(a2[r]);
    }
    __syncthreads();
}
__device__ __forceinline__ void ktab_item(const Params& P, LAS unsigned char* lds, int item) {
    unsigned char* ws = P.ws;
    const int tid = threadIdx.x, g = item / 9, lb = item % 9;
    const float* b_re = P.in[6]; const float* b_im = P.in[7]; const float* c_re = P.in[8]; const float* c_im = P.in[9];
    const float* LP = (const float*)(ws + WS_LP); const float* CF = (const float*)(ws + WS_CF);
    typedef float f2v __attribute__((ext_vector_type(2)));
    LAS f2v* CC = (LAS f2v*)lds;
    LAS f2v* BB = CC + 1024;
    LAS f2v* LPs = BB + 1024;
    for (int idx = tid; idx < 1024; idx += 512) {
        { const int h = idx >> 6, p = idx & 63, gp = g * 64 + p; const cpx C = {c_re[(g * 16 + h) * 64 + p], c_im[(g * 16 + h) * 64 + p]}; const cpx cf = {CF[2 * gp], CF[2 * gp + 1]}; const cpx cc = cmul(C, cf); CC[idx] = (f2v){cc.re, cc.im}; }
        { const int p = idx >> 4, hp = idx & 15, gp = g * 64 + p; BB[idx] = (f2v){b_re[gp * 16 + hp], b_im[gp * 16 + hp]}; }
    }
    { const int p = tid >> 3, j = tid & 7, lag = 8 * lb + j - 1, gp = g * 64 + p; f2v v = {0.f, 0.f}; if (lag >= 0 && lag <= 63) v = (f2v){LP[2 * (gp * 65 + lag)], LP[2 * (gp * 65 + lag) + 1]}; LPs[tid] = v; }
    __syncthreads();
    { const int j = tid >> 6, h = (tid >> 2) & 15, hq = tid & 3, li = 8 * lb + j;
      float acc[4] = {0.f, 0.f, 0.f, 0.f};
      for (int p = 0; p < 64; ++p) {
          const f2v lp = LPs[p * 8 + j], cc = CC[h * 64 + p]; const float ar = cc.x * lp.x - cc.y * lp.y, ai = cc.x * lp.y + cc.y * lp.x;
#pragma unroll
          for (int e = 0; e < 4; ++e) { const f2v bb = BB[p * 16 + 4 * hq + e]; acc[e] += ar * bb.x - ai * bb.y; }
      }
      if (li < 65) { u32x2 o; o.x = cvt_pk_bf16(acc[0], acc[1]); o.y = cvt_pk_bf16(acc[2], acc[3]); *(u32x2*)((bf16_t*)(ws + WS_KTAB) + ((size_t)(g * 65 + li) * 16 + h) * 16 + 4 * hq) = o; }
    }
    __syncthreads();
}

constexpr int S5_KT_OFF = 0;
constexpr int S5_UB_OFF = 33280;
constexpr int S5_XE_OFF = S5_UB_OFF + 33024;
constexpr int S5_XIN_OFF = S5_XE_OFF + 8192;
__device__ __forceinline__ void s5_item(const Params& P, LAS unsigned char* lds, int g, int b) {
    unsigned char* ws = P.ws;
    int tid_ = threadIdx.x; asm volatile("" : "+v"(tid_));
    const int tid = tid_, lane = tid & 63, w = __builtin_amdgcn_readfirstlane(tid >> 6), fr = lane & 15, q = lane >> 4;
    const bf16_t* UGp = (const bf16_t*)(ws + WS_UG) + ((size_t)(b * 32 + g) * 4096) * 16;
    const bf16_t* ET = (const bf16_t*)(ws + WS_ETAB) + (size_t)g * 128 * 1024;
    const bf16_t* FT = (const bf16_t*)(ws + WS_FTAB) + (size_t)g * 1024 * 128;
    bf16_t* YG = (bf16_t*)(ws + WS_YG);
    const float* dsk = P.in[10];
    { const u32x4* src = (const u32x4*)((const bf16_t*)(ws + WS_KTAB) + (size_t)g * 65 * 256);
      for (int i = tid; i < 33280 / 16; i += 512) *(LAS u32x4*)(lds + S5_KT_OFF + i * 16) = src[i]; }
    float st_re = 0.f, st_im = 0.f, lr = 0.f, li = 0.f;
    if (tid < 64) { const float* ll = (const float*)(ws + WS_LAML) + (size_t)(g * 64 + tid) * 2; lr = ll[0]; li = ll[1]; }
    float dval[4];
#pragma unroll
    for (int r = 0; r < 4; ++r) dval[r] = dsk[g * 16 + 4 * q + r];
    LAS float* XE = (LAS float*)(lds + S5_XE_OFF);
    LAS bf16_t* XIN = (LAS bf16_t*)(lds + S5_XIN_OFF);
    for (int batch = 0; batch < 4; ++batch) {
        __syncthreads();
        { const u32x4* src = (const u32x4*)(UGp + (size_t)batch * 1024 * 16);
#pragma unroll
          for (int i = 0; i < 4; ++i) { const int pc = tid + i * 512; *(LAS u32x4*)(lds + S5_UB_OFF + (pc >> 7) * 2064 + (pc & 127) * 16) = src[pc]; } }
        __syncthreads();
        {
            f32x4 acc = {0.f, 0.f, 0.f, 0.f};
            const bf16_t* arow = ET + (size_t)(16 * w + fr) * 1024 + 8 * q;
            const LAS unsigned char* bb = lds + S5_UB_OFF + fr * 2064 + (q >> 1) * 32 + (q & 1) * 16;
#pragma unroll
            for (int k0 = 0; k0 < 32; k0 += 16) {
                bf16x8 A[16];
#pragma unroll
                for (int i = 0; i < 16; ++i) A[i] = *(const bf16x8*)(arow + (k0 + i) * 32);
#pragma unroll
                for (int i = 0; i < 16; ++i) {
                    const bf16x8 B = *(const LAS bf16x8*)(bb + (k0 + i) * 64);
                    acc = __builtin_amdgcn_mfma_f32_16x16x32_bf16(A[i], B, acc, 0, 0, 0);
                }
            }
#pragma unroll
            for (int r = 0; r < 4; ++r) XE[(16 * w + 4 * q + r) * 16 + fr] = acc[r];
        }
        __syncthreads();
        if (tid < 64) {
            for (int c = 0; c < 16; ++c) {
                XIN[c * 136 + tid] = f2bf(st_re); XIN[c * 136 + 64 + tid] = f2bf(st_im);
                const float xr = XE[tid * 16 + c], xi = XE[(64 + tid) * 16 + c];
                const float nr = lr * st_re - li * st_im + xr, ni = lr * st_im + li * st_re + xi;
                st_re = nr; st_im = ni;
            }
        }
        __syncthreads();
        for (int t = w; t < 64; t += 8) {
            f32x4 acc = {0.f, 0.f, 0.f, 0.f};
            const bf16_t* frow = FT + (size_t)(t * 16 + fr) * 128 + 8 * q;
            bf16x8 FA[4];
#pragma unroll
            for (int kk = 0; kk < 4; ++kk) FA[kk] = *(const bf16x8*)(frow + kk * 32);
            const LAS unsigned char* bb = lds + S5_UB_OFF + fr * 2064 + (q >> 1) * 32 + (q & 1) * 16;
            const LAS unsigned char* ka = lds + S5_KT_OFF + ((t + 1 - (q >> 1)) * 256 + fr * 16 + (q & 1) * 8) * 2;
            const int nk = (t >> 1) + 1;
            for (int kk = 0; kk < nk; ++kk) {
                const bf16x8 A = *(const LAS bf16x8*)(ka - kk * 1024);
                const bf16x8 B = *(const LAS bf16x8*)(bb + kk * 64);
                acc = __builtin_amdgcn_mfma_f32_16x16x32_bf16(A, B, acc, 0, 0, 0);
            }
#pragma unroll
            for (int kk = 0; kk < 4; ++kk) {
                const bf16x8 B = *(const LAS bf16x8*)(XIN + fr * 136 + kk * 32 + 8 * q);
                acc = __builtin_amdgcn_mfma_f32_16x16x32_bf16(FA[kk], B, acc, 0, 0, 0);
            }
            const u32x2 uu = *(const LAS u32x2*)(lds + S5_UB_OFF + fr * 2064 + t * 32 + q * 8);
            float y0 = acc[0] + dval[0] * bf_lo(uu.x), y1 = acc[1] + dval[1] * bf_hi(uu.x), y2 = acc[2] + dval[2] * bf_lo(uu.y), y3 = acc[3] + dval[3] * bf_hi(uu.y);
            u32x2 o; o.x = cvt_pk_bf16(gelu_tanh(y0), gelu_tanh(y1)); o.y = cvt_pk_bf16(gelu_tanh(y2), gelu_tanh(y3));
            const int tok = batch * 1024 + fr * 64 + t;
            *(u32x2*)(YG + ((size_t)(b * 4096 + tok)) * 512 + g * 16 + 4 * q) = o;
        }
    }
    __syncthreads();
}

constexpr int AT_K_OFF = 0;
constexpr int AT_V_OFF = 9216;
constexpr int AT_IMP_OFF = 18432;
constexpr int AT_SEL_OFF = AT_IMP_OFF + 65536;
__device__ __forceinline__ void load_tile64(LAS unsigned char* buf, const bf16_t* src, size_t row0, int rowstride, int coloff, int tid) {
    const u32x4 v = *(const u32x4*)(src + (row0 + (tid >> 3)) * rowstride + coloff + (tid & 7) * 8);
    *(LAS u32x4*)(buf + (tid >> 3) * 144 + (tid & 7) * 16) = v;
}
__device__ __forceinline__ void qk_tile(const LAS unsigned char* kbuf, const bf16x8 (&bq)[4], int lane, f32x16 (&st)[2]) {
    const int r = lane & 31, hh = lane >> 5;
#pragma unroll
    for (int kt = 0; kt < 2; ++kt) {
        f32x16 a = {0.f, 0.f, 0.f, 0.f, 0.f, 0.f, 0.f, 0.f, 0.f, 0.f, 0.f, 0.f, 0.f, 0.f, 0.f, 0.f};
#pragma unroll
        for (int ks = 0; ks < 4; ++ks) {
            const bf16x8 kf = *(const LAS bf16x8*)(kbuf + (32 * kt + r) * 144 + (16 * ks + 8 * hh) * 2);
            a = __builtin_amdgcn_mfma_f32_32x32x16_bf16(kf, bq[ks], a, 0, 0, 0);
        }
        st[kt] = a;
    }
}
__device__ __forceinline__ void pv_tile(const LAS unsigned char* vbuf, const f32x16 (&p)[2], int lane, f32x16 (&o)[2]) {
    const int hh = lane >> 5, i = lane & 15, d0 = 16 * ((lane >> 4) & 1), qq = i >> 2, pp = i & 3;
#pragma unroll
    for (int kt = 0; kt < 2; ++kt)
#pragma unroll
        for (int s = 0; s < 2; ++s) {
            u32x4 pw; pw.x = cvt_pk_bf16(p[kt][8 * s + 0], p[kt][8 * s + 1]); pw.y = cvt_pk_bf16(p[kt][8 * s + 2], p[kt][8 * s + 3]);
            pw.z = cvt_pk_bf16(p[kt][8 * s + 4], p[kt][8 * s + 5]); pw.w = cvt_pk_bf16(p[kt][8 * s + 6], p[kt][8 * s + 7]);
            const bf16x8 pb = __builtin_bit_cast(bf16x8, pw);
            const int kb = 32 * kt + 16 * s + 4 * hh;
#pragma unroll
            for (int dt = 0; dt < 2; ++dt) {
                const LAS unsigned char* a0 = vbuf + (kb + qq) * 144 + (32 * dt + d0 + 4 * pp) * 2;
                const s16x4 v0 = __builtin_amdgcn_ds_read_tr16_b64_v4i16((LAS s16x4*)a0);
                const s16x4 v1 = __builtin_amdgcn_ds_read_tr16_b64_v4i16((LAS s16x4*)(a0 + 8 * 144));
                bf16x8 va; va[0] = v0[0]; va[1] = v0[1]; va[2] = v0[2]; va[3] = v0[3]; va[4] = v1[0]; va[5] = v1[1]; va[6] = v1[2]; va[7] = v1[3];
                o[dt] = __builtin_amdgcn_mfma_f32_32x32x16_bf16(va, pb, o[dt], 0, 0, 0);
            }
        }
}
template <bool WIN, int CM>
__device__ __forceinline__ float mask_scores(f32x16 (&st)[2], float fdl, float nslope2) {
    float mx = -3.0e38f;
#pragma unroll
    for (int kt = 0; kt < 2; ++kt)
#pragma unroll
        for (int reg = 0; reg < 16; ++reg) {
            const float distf = fdl - (float)(CM * (32 * kt + (reg & 3) + 8 * (reg >> 2)));
            float s2 = __builtin_fmaf(distf, nslope2, st[kt][reg]);
            if (WIN) { const float d = distf - __builtin_amdgcn_fmed3f(distf, 0.0f, 511.0f); s2 = __builtin_fmaf(-__builtin_fabsf(d), 3.0e38f, s2); }
            else s2 = __builtin_fmaf(__builtin_fminf(distf, 0.0f), 3.0e38f, s2);
            st[kt][reg] = s2; mx = fmaxf(mx, s2);
        }
    return fmaxf(mx, __shfl_xor(mx, 32));
}
template <bool WIN>
__device__ __forceinline__ void online_block(const LAS unsigned char* kbuf, const LAS unsigned char* vbuf, const bf16x8 (&bq)[4], int lane, float fdl, float nslope2,
                                             float& m, float& l, f32x16 (&o)[2]) {
    f32x16 st[2];
    qk_tile(kbuf, bq, lane, st);
    const float mx = mask_scores<WIN, 1>(st, fdl, nslope2);
    const float mn = fmaxf(m, mx), alpha = fast_exp2(m - mn); m = mn;
    float sum = 0.f;
#pragma unroll
    for (int kt = 0; kt < 2; ++kt)
#pragma unroll
        for (int reg = 0; reg < 16; ++reg) { const float pv = fast_exp2(st[kt][reg] - mn); st[kt][reg] = pv; sum += pv; }
    l = l * alpha + sum;
#pragma unroll
    for (int dt = 0; dt < 2; ++dt)
#pragma unroll
        for (int reg = 0; reg < 16; ++reg) o[dt][reg] *= alpha;
    pv_tile(vbuf, st, lane, o);
}

struct TileRegs { u32x4 k, v; };
__device__ __forceinline__ void tile_prefetch(TileRegs& r, const bf16_t* Ksrc, const bf16_t* Vsrc, size_t row0, int coloff, int tid) {
    const size_t off = (row0 + (tid >> 3)) * 128 + coloff + (tid & 7) * 8;
    r.k = *(const u32x4*)(Ksrc + off); r.v = *(const u32x4*)(Vsrc + off);
}
__device__ __forceinline__ void tile_commit(const TileRegs& r, LAS unsigned char* kbuf, LAS unsigned char* vbuf, int tid) {
    *(LAS u32x4*)(kbuf + (tid >> 3) * 144 + (tid & 7) * 16) = r.k; *(LAS u32x4*)(vbuf + (tid >> 3) * 144 + (tid & 7) * 16) = r.v;
}
template <int MODE>
__device__ __forceinline__ void online_block2(const LAS unsigned char* kbuf, const LAS unsigned char* vbuf, const bf16x8 (&bq)[4], int lane, float blk, float slope2, float fdl,
                                              float& m, float& l, f32x16 (&o)[2]) {
    const int r = lane & 31, hh = lane >> 5;
    const float s1 = slope2, s2 = 2.0f * slope2, s3 = 3.0f * slope2;
    f32x16 st[2];
#pragma unroll
    for (int kt = 0; kt < 2; ++kt) {
        f32x16 a;
#pragma unroll
        for (int i = 0; i < 4; ++i) {
            const float bi = __builtin_fmaf((float)(32 * kt + 8 * i), slope2, blk);
            a[4 * i] = bi; a[4 * i + 1] = bi + s1; a[4 * i + 2] = bi + s2; a[4 * i + 3] = bi + s3;
        }
#pragma unroll
        for (int ks = 0; ks < 4; ++ks) {
            const bf16x8 kf = *(const LAS bf16x8*)(kbuf + (32 * kt + r) * 144 + (16 * ks + 8 * hh) * 2);
            a = __builtin_amdgcn_mfma_f32_32x32x16_bf16(kf, bq[ks], a, 0, 0, 0);
        }
        st[kt] = a;
    }
    float mx = -3.0e38f;
#pragma unroll
    for (int kt = 0; kt < 2; ++kt)
#pragma unroll
        for (int reg = 0; reg < 16; ++reg) {
            float s2 = st[kt][reg];
            if (MODE == 1) s2 = __builtin_fmaf(__builtin_fminf(fdl - (float)(32 * kt + (reg & 3) + 8 * (reg >> 2)), 0.0f), 3.0e38f, s2);
            if (MODE == 2) s2 = __builtin_fmaf(__builtin_fmaxf(fdl - (float)(32 * kt + (reg & 3) + 8 * (reg >> 2) + 511), 0.0f), -3.0e38f, s2);
            st[kt][reg] = s2; mx = fmaxf(mx, s2);
        }
    mx = fmaxf(mx, __shfl_xor(mx, 32));
    if (!__all(mx <= m)) {
        const float mn = fmaxf(m, mx), alpha = fast_exp2(m - mn); m = mn; l *= alpha;
#pragma unroll
        for (int dt = 0; dt < 2; ++dt)
#pragma unroll
            for (int reg = 0; reg < 16; ++reg) o[dt][reg] *= alpha;
    }
    float sum = 0.f;
#pragma unroll
    for (int kt = 0; kt < 2; ++kt)
#pragma unroll
        for (int reg = 0; reg < 16; ++reg) { const float pv = fast_exp2(st[kt][reg] - m); st[kt][reg] = pv; sum += pv; }
    l += sum;
    pv_tile(vbuf, st, lane, o);
}
__device__ __forceinline__ void attn_item(const Params& P, LAS unsigned char* lds, int b, int g, int qt) {
    unsigned char* ws = P.ws;
    int tid_ = threadIdx.x; asm volatile("" : "+v"(tid_));
    const int tid = tid_, lane = tid & 63, w = __builtin_amdgcn_readfirstlane(tid >> 6);
    const int r = w & 3, qhalf = w >> 2, hh = lane >> 5, ql = 32 * qhalf + (lane & 31);
    const int tq = 64 * qt + ql, hd = g * 4 + r;
    const size_t rowq = (size_t)b * 4096 + tq;
    const bf16_t* Qp = (const bf16_t*)(ws + WS_Q);
    const bf16_t* KVp = (const bf16_t*)(ws + WS_KV);
    const bf16_t* KC = (const bf16_t*)(ws + WS_KC) + (size_t)(b * 2 + g) * 256 * 64;
    const bf16_t* VC = (const bf16_t*)(ws + WS_VC) + (size_t)(b * 2 + g) * 256 * 64;
    const float* GT = (const float*)(ws + WS_GATES);
    LAS unsigned char* kbuf = lds + AT_K_OFF; LAS unsigned char* vbuf = lds + AT_V_OFF;
    LAS float* IMP = (LAS float*)(lds + AT_IMP_OFF);
    LAS unsigned long long* SEL = (LAS unsigned long long*)(lds + AT_SEL_OFF);
    bf16x8 bq[4];
#pragma unroll
    for (int ks = 0; ks < 4; ++ks) bq[ks] = *(const bf16x8*)(Qp + rowq * 512 + hd * 64 + 16 * ks + 8 * hh);
    const float nslope2 = -exp2f(-(float)(hd + 1)) * LOG2E;
    const float gc = ABL_NOCMP ? 0.f : GT[rowq * 24 + g * 12 + r * 3 + 0], gs = ABL_NOSLC ? 0.f : GT[rowq * 24 + g * 12 + r * 3 + 1], gw = ABL_NOWIN ? 0.f : GT[rowq * 24 + g * 12 + r * 3 + 2];
    f32x16 oc[2];

    const int ncb = ((4 * qt + 2) >> 6) + 1;
    float m = -1e30f, l = 0.f;
    for (int cb = 0; cb < ncb; ++cb) {
        __syncthreads();
        load_tile64(kbuf, KC, (size_t)cb * 64, 64, 0, tid);
        __syncthreads();
        f32x16 st[2];
        qk_tile(kbuf, bq, lane, st);
        const int dl = tq - 31 - 1024 * cb - 64 * hh;
        const float mx = mask_scores<false, 16>(st, (float)dl, nslope2);
        const float mn = fmaxf(m, mx), alpha = fast_exp2(m - mn); m = mn;
        float sum = 0.f;
#pragma unroll
        for (int kt = 0; kt < 2; ++kt)
#pragma unroll
            for (int reg = 0; reg < 16; ++reg) sum += fast_exp2(st[kt][reg] - mn);
        l = l * alpha + sum;
    }
    {
        const float ltot = l + __shfl_xor(l, 32);
        const float inv = 1.0f / fmaxf(ltot, 1e-30f);
        f32x16 o[2];
#pragma unroll
        for (int dt = 0; dt < 2; ++dt)
#pragma unroll
            for (int reg = 0; reg < 16; ++reg) o[dt][reg] = 0.f;
        float carry = 0.f;
        for (int cb = 0; cb < 4; ++cb) {
            if (cb < ncb) {
                __syncthreads();
                load_tile64(kbuf, KC, (size_t)cb * 64, 64, 0, tid);
                load_tile64(vbuf, VC, (size_t)cb * 64, 64, 0, tid);
                __syncthreads();
                f32x16 st[2];
                qk_tile(kbuf, bq, lane, st);
                const int dl = tq - 31 - 1024 * cb - 64 * hh;
                (void)mask_scores<false, 16>(st, (float)dl, nslope2);
#pragma unroll
                for (int kt = 0; kt < 2; ++kt)
#pragma unroll
                    for (int reg = 0; reg < 16; ++reg) st[kt][reg] = fast_exp2(st[kt][reg] - m) * inv;
                float pv3[2][4];
#pragma unroll
                for (int kt = 0; kt < 2; ++kt)
#pragma unroll
                    for (int i = 0; i < 4; ++i) pv3[kt][i] = __shfl_xor(st[kt][4 * i + 3], 32);
#pragma unroll
                for (int kt = 0; kt < 2; ++kt)
#pragma unroll
                    for (int i = 0; i < 4; ++i) {
                        const float s4 = (st[kt][4 * i] + st[kt][4 * i + 1]) + (st[kt][4 * i + 2] + st[kt][4 * i + 3]);
                        const float prev0 = (i > 0) ? pv3[kt][i > 0 ? i - 1 : 0] : (kt > 0 ? pv3[0][3] : carry);
                        const float prev = hh ? pv3[kt][i] : prev0;
                        IMP[(r * 64 + ql) * 64 + 16 * cb + 8 * kt + 2 * i + hh] = s4 + prev;
                    }
                carry = pv3[1][3];
                pv_tile(vbuf, st, lane, o);
            } else {
#pragma unroll
                for (int kt = 0; kt < 2; ++kt)
#pragma unroll
                    for (int i = 0; i < 4; ++i) {
                        const float prev = (!hh && kt == 0 && i == 0) ? carry : 0.f;
                        IMP[(r * 64 + ql) * 64 + 16 * cb + 8 * kt + 2 * i + hh] = prev;
                    }
                carry = 0.f;
            }
        }
#pragma unroll
        for (int dt = 0; dt < 2; ++dt)
#pragma unroll
            for (int reg = 0; reg < 16; ++reg) oc[dt][reg] = gc * o[dt][reg];
    }
    __syncthreads();
    {
        const int cur = qt, j = lane;
        for (int qi = 0; qi < 8; ++qi) {
            const int qq = 8 * w + qi;
            const float sc = ((IMP[(0 * 64 + qq) * 64 + j] + IMP[(1 * 64 + qq) * 64 + j]) + IMP[(2 * 64 + qq) * 64 + j]) + IMP[(3 * 64 + qq) * 64 + j];
            const bool valid = j <= cur, forced = (j == 0) || (j == cur) || (j == cur - 1);
            const float key = forced ? 3.0e38f : (valid ? sc : -1.0f);
            int cnt = 0;
            for (int jp = 0; jp <= cur; ++jp) {
                const float sj = __uint_as_float(__builtin_amdgcn_readlane(__float_as_uint(key), jp));
                cnt += ((sj > key) || (sj == key && jp < j)) ? 1 : 0;
            }
            const unsigned long long msk = __ballot(valid && cnt < 16);
            if (lane == 0) SEL[qq] = msk;
        }
    }
    __syncthreads();
    const unsigned long long mymask = SEL[ql];
    unsigned long long uni = SEL[lane];
#pragma unroll
    for (int o_ = 1; o_ < 64; o_ <<= 1) uni |= __shfl_xor(uni, o_);
    const unsigned uni_lo = __builtin_amdgcn_readfirstlane((unsigned)uni), uni_hi = __builtin_amdgcn_readfirstlane((unsigned)(uni >> 32));
    const float slope2 = -nslope2;
    LAS float* OA = (LAS float*)(lds + AT_IMP_OFF) + w * 2048 + lane;
    __syncthreads();
#pragma unroll
    for (int dt = 0; dt < 2; ++dt)
#pragma unroll
        for (int reg = 0; reg < 16; ++reg) OA[(dt * 16 + reg) * 64] = oc[dt][reg];
    for (int rep_ = 0; rep_ < REP_SEL; ++rep_)
    {
        float ms = -1e30f, ls = 0.f; f32x16 o[2];
#pragma unroll
        for (int dt = 0; dt < 2; ++dt)
#pragma unroll
            for (int reg = 0; reg < 16; ++reg) o[dt][reg] = 0.f;
        const bf16_t* Ks = KVp + (size_t)2 * T_TOK * 128; const bf16_t* Vs = KVp + (size_t)3 * T_TOK * 128;
        TileRegs tr; int jn = qt;
        tile_prefetch(tr, Ks, Vs, (size_t)b * 4096 + 64 * jn, g * 64, tid);
        while (jn >= 0) {
            const int j = jn;
            __syncthreads();
            tile_commit(tr, kbuf, vbuf, tid);
            __syncthreads();
            { unsigned lo = uni_lo, hi = uni_hi; if (j < 32) { hi = 0u; lo = j == 0 ? 0u : (lo & ((1u << j) - 1u)); } else { hi = j == 32 ? 0u : (hi & ((1u << (j - 32)) - 1u)); }
              jn = hi ? 63 - __builtin_clz(hi) : (lo ? 31 - __builtin_clz(lo) : -1); }
            if (jn >= 0) tile_prefetch(tr, Ks, Vs, (size_t)b * 4096 + 64 * jn, g * 64, tid);
            const bool ok = (mymask >> j) & 1ull;
            const float blk = ok ? slope2 * (float)(64 * j + 4 * hh) : -3.0e38f;
            if (j == qt) online_block2<1>(kbuf, vbuf, bq, lane, blk, slope2, (float)(tq - 64 * j - 4 * hh), ms, ls, o);
            else online_block2<0>(kbuf, vbuf, bq, lane, blk, slope2, 0.f, ms, ls, o);
        }
        const float ltot = ls + __shfl_xor(ls, 32); const float sc = (rep_ == 0 ? gs : 0.f) / fmaxf(ltot, 1e-30f);
#pragma unroll
        for (int dt = 0; dt < 2; ++dt)
#pragma unroll
            for (int reg = 0; reg < 16; ++reg) OA[(dt * 16 + reg) * 64] += sc * o[dt][reg];
    }
    for (int rep_ = 0; rep_ < REP_WIN; ++rep_)
    {
        float mw = -1e30f, lw = 0.f; f32x16 o[2];
#pragma unroll
        for (int dt = 0; dt < 2; ++dt)
#pragma unroll
            for (int reg = 0; reg < 16; ++reg) o[dt][reg] = 0.f;
        const bf16_t* Kw = KVp + (size_t)4 * T_TOK * 128; const bf16_t* Vw = KVp + (size_t)5 * T_TOK * 128;
        const int j0 = qt - 8 > 0 ? qt - 8 : 0;
        TileRegs tr; int jn = qt;
        tile_prefetch(tr, Kw, Vw, (size_t)b * 4096 + 64 * jn, g * 64, tid);
        while (jn >= j0) {
            const int j = jn;
            __syncthreads();
            tile_commit(tr, kbuf, vbuf, tid);
            __syncthreads();
            jn = j - 1;
            if (jn >= j0) tile_prefetch(tr, Kw, Vw, (size_t)b * 4096 + 64 * jn, g * 64, tid);
            const float blk = slope2 * (float)(64 * j + 4 * hh), fdl = (float)(tq - 64 * j - 4 * hh);
            if (j == qt) online_block2<1>(kbuf, vbuf, bq, lane, blk, slope2, fdl, mw, lw, o);
            else if (j == qt - 8) online_block2<2>(kbuf, vbuf, bq, lane, blk, slope2, fdl, mw, lw, o);
            else online_block2<0>(kbuf, vbuf, bq, lane, blk, slope2, fdl, mw, lw, o);
        }
        const float ltot = lw + __shfl_xor(lw, 32); const float sc = (rep_ == 0 ? gw : 0.f) / fmaxf(ltot, 1e-30f);
#pragma unroll
        for (int dt = 0; dt < 2; ++dt)
#pragma unroll
            for (int reg = 0; reg < 16; ++reg) OA[(dt * 16 + reg) * 64] += sc * o[dt][reg];
    }
    {
        bf16_t* O = (bf16_t*)(ws + WS_O) + rowq * 512 + hd * 64;
#pragma unroll
        for (int dt = 0; dt < 2; ++dt)
#pragma unroll
            for (int rg = 0; rg < 4; ++rg) {
                u32x2 v; v.x = cvt_pk_bf16(OA[(dt * 16 + 4 * rg) * 64], OA[(dt * 16 + 4 * rg + 1) * 64]); v.y = cvt_pk_bf16(OA[(dt * 16 + 4 * rg + 2) * 64], OA[(dt * 16 + 4 * rg + 3) * 64]);
                *(u32x2*)(O + 32 * dt + 8 * rg + 4 * hh) = v;
            }
    }
    __syncthreads();
}

__device__ __forceinline__ unsigned f2ord(float f) { const unsigned u = __float_as_uint(f); return u ^ ((unsigned)((int)u >> 31) | 0x80000000u); }
__device__ __forceinline__ float ord2f(unsigned o) { const unsigned u = (o & 0x80000000u) ? (o ^ 0x80000000u) : ~o; return __uint_as_float(u); }
__device__ __forceinline__ void ins16(unsigned (&L)[16], unsigned x) {
#pragma unroll
    for (int i = 0; i < 16; ++i) { const unsigned hi = L[i] > x ? L[i] : x; x = L[i] > x ? x : L[i]; L[i] = hi; }
}
__device__ __forceinline__ void ce_desc(unsigned& a, unsigned& b) { const unsigned hi = a > b ? a : b, lo = a > b ? b : a; a = hi; b = lo; }
__device__ __forceinline__ void sort16_desc(unsigned (&v)[16]) {
#pragma unroll
    for (int k = 2; k <= 16; k <<= 1)
#pragma unroll
        for (int j = k >> 1; j > 0; j >>= 1)
#pragma unroll
            for (int i = 0; i < 16; ++i) { const int l = i ^ j; if (l > i) { if ((i & k) == 0) ce_desc(v[i], v[l]); else ce_desc(v[l], v[i]); } }
}
__device__ __forceinline__ void merge16_desc(unsigned (&A)[16], const unsigned (&B)[16]) {
#pragma unroll
    for (int i = 0; i < 16; ++i) A[i] = A[i] > B[15 - i] ? A[i] : B[15 - i];
#pragma unroll
    for (int j = 8; j > 0; j >>= 1)
#pragma unroll
        for (int i = 0; i < 16; ++i) { const int l = i ^ j; if (l > i) ce_desc(A[i], A[l]); }
}
__device__ __forceinline__ void peer_score_pair(const Params& P, LAS unsigned char* lds, int t0a, int t0b, int h, int w, int lane) {
    unsigned char* ws = P.ws;
    const int r = lane & 31, hh = lane >> 5;
    const bf16_t* QP = (const bf16_t*)(ws + WS_QP);
    const bf16_t* SK = (const bf16_t*)(ws + WS_SUBK);
    LAS unsigned char* IDX = lds + w * 2048;
    unsigned Lc[2][2][16];
#pragma unroll
    for (int c = 0; c < 2; ++c) {
        bf16x8 kf[16];
#pragma unroll
        for (int i = 0; i < 16; ++i) kf[i] = *(const bf16x8*)(SK + ((size_t)((h * 2 + c) * 128 + 32 * (i >> 2) + r)) * 64 + 16 * (i & 3) + 8 * hh);
#pragma unroll
        for (int it = 0; it < 2; ++it) {
            const int t0 = it ? t0b : t0a;
            bf16x8 bq[4];
#pragma unroll
            for (int ks = 0; ks < 4; ++ks) bq[ks] = *(const bf16x8*)(QP + (size_t)(t0 + r) * 1024 + h * 128 + c * 64 + 16 * ks + 8 * hh);
            unsigned L[16];
#pragma unroll
            for (int kt = 0; kt < 4; ++kt) {
                f32x16 a = {0.f, 0.f, 0.f, 0.f, 0.f, 0.f, 0.f, 0.f, 0.f, 0.f, 0.f, 0.f, 0.f, 0.f, 0.f, 0.f};
#pragma unroll
                for (int ks = 0; ks < 4; ++ks) a = __builtin_amdgcn_mfma_f32_32x32x16_bf16(kf[4 * kt + ks], bq[ks], a, 0, 0, 0);
                unsigned G[16];
#pragma unroll
                for (int reg = 0; reg < 16; ++reg) {
                    const int key0 = 32 * kt + 8 * (reg >> 2) + (reg & 3);
                    const unsigned low = (unsigned)(127 ^ key0) ^ (unsigned)(4 * hh);
                    G[reg] = (f2ord(a[reg]) & ~127u) | low;
                }
                sort16_desc(G);
                if (kt == 0) {
#pragma unroll
                    for (int i = 0; i < 16; ++i) L[i] = G[i];
                } else merge16_desc(L, G);
            }
            unsigned tmp[16];
#pragma unroll
            for (int i = 0; i < 16; ++i) tmp[i] = __shfl_xor(L[i], 32);
            merge16_desc(L, tmp);
#pragma unroll
            for (int i = 0; i < 16; ++i) Lc[it][c][i] = L[i];
            if (hh == 0) {
#pragma unroll
                for (int i = 0; i < 16; ++i) IDX[((it * 32 + r) * 2 + c) * 16 + i] = (unsigned char)(127u - (L[i] & 127u));
            }
        }
    }
#pragma unroll
    for (int it = 0; it < 2; ++it) {
        const int t0 = it ? t0b : t0a;
        float v0[16], v1[16];
#pragma unroll
        for (int i = 0; i < 16; ++i) { v0[i] = ord2f(Lc[it][0][i] & ~127u); v1[i] = ord2f(Lc[it][1][i] & ~127u); }
        unsigned best[16], grp[16];
        int n = 0;
#pragma unroll
        for (int i = 0; i < 16; ++i)
#pragma unroll
            for (int j = 0; j < 16; ++j)
                if ((i + 1) * (j + 1) <= 16) {
                    grp[n & 15] = (f2ord(v0[i] + v1[j]) & ~255u) | (unsigned)(255 - (i * 16 + j));
                    ++n;
                    if ((n & 15) == 0 || n == 50) {
                        if (n == 50) { grp[2] = 0u; grp[3] = 0u; grp[4] = 0u; grp[5] = 0u; grp[6] = 0u; grp[7] = 0u; grp[8] = 0u; grp[9] = 0u; grp[10] = 0u; grp[11] = 0u; grp[12] = 0u; grp[13] = 0u; grp[14] = 0u; grp[15] = 0u; }
                        sort16_desc(grp);
                        if (n == 16) {
#pragma unroll
                            for (int q = 0; q < 16; ++q) best[q] = grp[q];
                        } else merge16_desc(best, grp);
                    }
                }
        const float mv = ord2f(best[0] & ~255u);
        float e[16], sum = 0.f;
#pragma unroll
        for (int k = 0; k < 16; ++k) { e[k] = fast_exp2((ord2f(best[k] & ~255u) - mv) * LOG2E); sum += e[k]; }
        const float inv = 1.0f / sum;
        asm volatile("s_waitcnt lgkmcnt(0)" ::: "memory");
        if (hh == 0) {
            u32x2* out = (u32x2*)(ws + WS_PK) + ((size_t)(t0 + r) * 8 + h) * 16;
#pragma unroll
            for (int k = 0; k < 16; ++k) {
                const unsigned flat = 255u - (best[k] & 255u); const unsigned i = flat >> 4, j = flat & 15u;
                const unsigned e0 = IDX[((it * 32 + r) * 2 + 0) * 16 + i], e1 = IDX[((it * 32 + r) * 2 + 1) * 16 + j];
                u32x2 v; v.x = e0 * 128u + e1; v.y = __float_as_uint(e[k] * inv); out[k] = v;
            }
        }
    }
}

__device__ __forceinline__ void peer_token(const Params& P, int tok, int lane, float* outbase) {
    unsigned char* ws = P.ws;
    float* X1 = P.out + (size_t)tok * 1024 + lane * 16;
    const f32x4 xa = ((const f32x4*)X1)[0], xb = ((const f32x4*)X1)[1], xc = ((const f32x4*)X1)[2], xd = ((const f32x4*)X1)[3];
    float xr[16] = {xa[0], xa[1], xa[2], xa[3], xb[0], xb[1], xb[2], xb[3], xc[0], xc[1], xc[2], xc[3], xd[0], xd[1], xd[2], xd[3]};
    h16x2 xh[8];
#pragma unroll
    for (int i = 0; i < 8; ++i) { xh[i].x = (_Float16)xr[2 * i]; xh[i].y = (_Float16)xr[2 * i + 1]; }
    const u32x2* pk = (const u32x2*)(ws + WS_PK) + (size_t)tok * 128;
    const u32x2 p0 = pk[lane], p1 = pk[64 + lane];
    const unsigned char* UT = ws + WS_UTAB + lane * 32; const unsigned char* VT = ws + WS_VTAB + lane * 32;
    float h0 = 0.f, h1 = 0.f;
    for (int k = 0; k < 128; k += 2) {
        const unsigned ea = __builtin_amdgcn_readlane(k < 64 ? p0.x : p1.x, k & 63), eb = __builtin_amdgcn_readlane(k < 64 ? p0.x : p1.x, (k + 1) & 63);
        const u32x4 a0 = *(const u32x4*)(UT + (size_t)ea * 2048), a1 = *(const u32x4*)(UT + (size_t)ea * 2048 + 16);
        const u32x4 b0 = *(const u32x4*)(UT + (size_t)eb * 2048), b1 = *(const u32x4*)(UT + (size_t)eb * 2048 + 16);
        float da = 0.f, db = 0.f;
        {
            const unsigned aw[8] = {a0.x, a0.y, a0.z, a0.w, a1.x, a1.y, a1.z, a1.w}, bw[8] = {b0.x, b0.y, b0.z, b0.w, b1.x, b1.y, b1.z, b1.w};
#pragma unroll
            for (int i = 0; i < 8; ++i) {
                const h16x2 va = __builtin_bit_cast(h16x2, aw[i]), vb = __builtin_bit_cast(h16x2, bw[i]);
                da = __builtin_fmaf((float)va.x, xr[2 * i], da); da = __builtin_fmaf((float)va.y, xr[2 * i + 1], da);
                db = __builtin_fmaf((float)vb.x, xr[2 * i], db); db = __builtin_fmaf((float)vb.y, xr[2 * i + 1], db);
            }
        }
        da = wave_sum(da); db = wave_sum(db);
        if (k < 64) { h0 = (lane == k) ? da : h0; h0 = (lane == k + 1) ? db : h0; } else { h1 = (lane == k - 64) ? da : h1; h1 = (lane == k - 63) ? db : h1; }
    }
        const float w0 = __uint_as_float(p0.y) * (ABL_NOH ? 1.f : gelu_tanh(h0)), w1 = __uint_as_float(p1.y) * (ABL_NOH ? 1.f : gelu_tanh(h1));
    float acc[16];
#pragma unroll
    for (int i = 0; i < 16; ++i) acc[i] = 0.f;
    for (int k = 0; k < 128; k += 2) {
        const unsigned ea = __builtin_amdgcn_readlane(k < 64 ? p0.x : p1.x, k & 63), eb = __builtin_amdgcn_readlane(k < 64 ? p0.x : p1.x, (k + 1) & 63);
        const float wa = __uint_as_float(__builtin_amdgcn_readlane(__float_as_uint(k < 64 ? w0 : w1), k & 63)), wb = __uint_as_float(__builtin_amdgcn_readlane(__float_as_uint(k < 64 ? w0 : w1), (k + 1) & 63));
        const u32x4 a0 = *(const u32x4*)(VT + (size_t)ea * 2048), a1 = *(const u32x4*)(VT + (size_t)ea * 2048 + 16);
        const u32x4 b0 = *(const u32x4*)(VT + (size_t)eb * 2048), b1 = *(const u32x4*)(VT + (size_t)eb * 2048 + 16);
        const unsigned aw[8] = {a0.x, a0.y, a0.z, a0.w, a1.x, a1.y, a1.z, a1.w}, bw[8] = {b0.x, b0.y, b0.z, b0.w, b1.x, b1.y, b1.z, b1.w};
#pragma unroll
        for (int i = 0; i < 8; ++i) {
            const h16x2 va = __builtin_bit_cast(h16x2, aw[i]), vb = __builtin_bit_cast(h16x2, bw[i]);
            acc[2 * i] = __builtin_fmaf((float)va.x, wa, acc[2 * i]); acc[2 * i + 1] = __builtin_fmaf((float)va.y, wa, acc[2 * i + 1]);
            acc[2 * i] = __builtin_fmaf((float)vb.x, wb, acc[2 * i]); acc[2 * i + 1] = __builtin_fmaf((float)vb.y, wb, acc[2 * i + 1]);
        }
    }
    float s = 0.f;
#pragma unroll
    for (int i = 0; i < 16; ++i) { acc[i] = DN_ALPHA * xr[i] + (ABL_NOPEER ? 0.f : acc[i]); s += acc[i]; }
    const float mean = wave_sum(s) * (1.0f / 1024.0f); float s2 = 0.f;
#pragma unroll
    for (int i = 0; i < 16; ++i) { acc[i] -= mean; s2 += acc[i] * acc[i]; }
    const float rstd = 1.0f / sqrtf(wave_sum(s2) * (1.0f / 1024.0f) + LN_EPS);
    const float* g2 = P.in[27] + lane * 16; const float* b2 = P.in[28] + lane * 16;
#pragma unroll
    for (int i = 0; i < 4; ++i) {
        const f32x4 gg = ((const f32x4*)g2)[i], bb = ((const f32x4*)b2)[i]; f32x4 o;
#pragma unroll
        for (int j = 0; j < 4; ++j) o[j] = acc[4 * i + j] * rstd * gg[j] + bb[j];
        ((f32x4*)(outbase + (size_t)tok * 1024 + lane * 16))[i] = o;
    }
}


__device__ __forceinline__ float dpp_add(float v, const int ctrl_sel) {
    const int b = __float_as_int(v); int r;
    if (ctrl_sel == 0) r = __builtin_amdgcn_update_dpp(0, b, 0xB1, 0xf, 0xf, false);
    else if (ctrl_sel == 1) r = __builtin_amdgcn_update_dpp(0, b, 0x4E, 0xf, 0xf, false);
    else if (ctrl_sel == 2) r = __builtin_amdgcn_update_dpp(0, b, 0x141, 0xf, 0xf, false);
    else if (ctrl_sel == 3) r = __builtin_amdgcn_update_dpp(0, b, 0x140, 0xf, 0xf, false);
    else if (ctrl_sel == 4) r = __builtin_amdgcn_update_dpp(0, b, 0x142, 0xa, 0xf, false);
    else r = __builtin_amdgcn_update_dpp(0, b, 0x143, 0xc, 0xf, false);
    return v + __int_as_float(r);
}
__device__ __forceinline__ float wave_total(float v) {
    v = dpp_add(v, 0); v = dpp_add(v, 1); v = dpp_add(v, 2); v = dpp_add(v, 3); v = dpp_add(v, 4); v = dpp_add(v, 5);
    return __int_as_float(__builtin_amdgcn_readlane(__float_as_int(v), 63));
}
typedef float f32x2_t __attribute__((ext_vector_type(2)));
__device__ __forceinline__ float dot16_8(const u32x4& a, const h16x2 (&x)[8]) {
    const unsigned aw[4] = {a.x, a.y, a.z, a.w}; float d = 0.f;
#pragma unroll
    for (int i = 0; i < 4; ++i) {
        const f32x2_t lo = __builtin_amdgcn_cvt_pk_f32_fp8((int)aw[i], false), hi = __builtin_amdgcn_cvt_pk_f32_fp8((int)aw[i], true);
        d = __builtin_fmaf(lo.x, (float)x[2 * i].x, d); d = __builtin_fmaf(lo.y, (float)x[2 * i].y, d); d = __builtin_fmaf(hi.x, (float)x[2 * i + 1].x, d); d = __builtin_fmaf(hi.y, (float)x[2 * i + 1].y, d);
    }
    return d;
}
__device__ __forceinline__ void axpy16_h(const u32x4& a0, const u32x4& a1, float w, float (&acc)[16]) {
    const unsigned aw[8] = {a0.x, a0.y, a0.z, a0.w, a1.x, a1.y, a1.z, a1.w};
#pragma unroll
    for (int i = 0; i < 8; ++i) { const h16x2 va = __builtin_bit_cast(h16x2, aw[i]); acc[2 * i] = __builtin_fmaf((float)va.x, w, acc[2 * i]); acc[2 * i + 1] = __builtin_fmaf((float)va.y, w, acc[2 * i + 1]); }
}
__device__ __forceinline__ void peer_round(const Params& P, LAS unsigned char* wl, int tok0, int lane) {
    unsigned char* ws = P.ws;
    LAS u32x2* sorted = (LAS u32x2*)wl;
    LAS unsigned* cnt = (LAS unsigned*)(wl + 4096);
    LAS unsigned* off = (LAS unsigned*)(wl + 4096 + 256);
    LAS unsigned char* xl = wl + 4608;
#pragma unroll
    for (int t = 0; t < 4; ++t) {
        const f32x4* X1 = (const f32x4*)(P.out + (size_t)(tok0 + t) * 1024 + lane * 16);
        const f32x4 v0 = X1[0], v1 = X1[1], v2 = X1[2], v3 = X1[3];
        u32x4 w0, w1; w0.x = pack_h2(v0[0], v0[1]); w0.y = pack_h2(v0[2], v0[3]); w0.z = pack_h2(v1[0], v1[1]); w0.w = pack_h2(v1[2], v1[3]);
        w1.x = pack_h2(v2[0], v2[1]); w1.y = pack_h2(v2[2], v2[3]); w1.z = pack_h2(v3[0], v3[1]); w1.w = pack_h2(v3[2], v3[3]);
        *(LAS u32x4*)(xl + t * 2048 + lane * 32) = w0; *(LAS u32x4*)(xl + t * 2048 + lane * 32 + 16) = w1;
    }
    cnt[lane] = 0u;
    __builtin_amdgcn_fence(__ATOMIC_RELEASE, "wavefront"); __builtin_amdgcn_wave_barrier();
    const u32x2* pk = (const u32x2*)(ws + WS_PK) + (size_t)tok0 * 128;
    u32x2 pv[8]; unsigned pos[8];
#pragma unroll
    for (int m = 0; m < 8; ++m) { pv[m] = pk[m * 64 + lane]; pos[m] = __hip_atomic_fetch_add(&cnt[pv[m].x >> 8], 1u, __ATOMIC_RELAXED, __HIP_MEMORY_SCOPE_WAVEFRONT); }
    __builtin_amdgcn_fence(__ATOMIC_ACQ_REL, "wavefront"); __builtin_amdgcn_wave_barrier();
    {
        const unsigned c = cnt[lane]; unsigned sfx = c;
#pragma unroll
        for (int o = 1; o < 64; o <<= 1) { const unsigned t = __shfl_up(sfx, o); if (lane >= o) sfx += t; }
        off[lane] = sfx - c;
    }
    __builtin_amdgcn_fence(__ATOMIC_ACQ_REL, "wavefront"); __builtin_amdgcn_wave_barrier();
#pragma unroll
    for (int m = 0; m < 8; ++m) { const unsigned dst = off[pv[m].x >> 8] + pos[m]; u32x2 e; e.x = pv[m].x | ((unsigned)(m >> 1) << 14); e.y = pv[m].y; sorted[dst] = e; }
    __builtin_amdgcn_fence(__ATOMIC_ACQ_REL, "wavefront"); __builtin_amdgcn_wave_barrier();
    const unsigned char* UT = ws + WS_UTAB + lane * 16; const unsigned char* VT = ws + WS_VTAB + lane * 16;
#pragma nounroll
    for (int b = 0; b < 8; ++b) {
        const u32x2 sp = sorted[b * 64 + lane];
        float hv = 0.f;
#pragma nounroll
        for (int k = 0; k < 64; k += 4) {
            unsigned ev[4]; u32x4 a0[4];
#pragma unroll
            for (int j = 0; j < 4; ++j) { ev[j] = (unsigned)__builtin_amdgcn_readlane((int)sp.x, k + j); a0[j] = *(const u32x4*)(UT + (size_t)(ev[j] & 0x3fffu) * 1024); }
            float pt[4];
#pragma unroll
            for (int j = 0; j < 4; ++j) {
                const unsigned tau = ev[j] >> 14;
                const u32x4 x0 = *(const LAS u32x4*)(xl + tau * 2048 + lane * 32), x1 = *(const LAS u32x4*)(xl + tau * 2048 + lane * 32 + 16);
                const unsigned xw[8] = {x0.x, x0.y, x0.z, x0.w, x1.x, x1.y, x1.z, x1.w};
                h16x2 xs[8];
#pragma unroll
                for (int i = 0; i < 8; ++i) xs[i] = __builtin_bit_cast(h16x2, xw[i]);
                pt[j] = dot16_8(a0[j], xs);
            }
#pragma unroll
            for (int j = 0; j < 4; ++j) { const float tot = wave_total(pt[j]); hv = (lane == k + j) ? tot : hv; }
        }
        u32x2 nw = sp; nw.y = __float_as_uint(__uint_as_float(sp.y) * gelu_tanh(hv * (1.0f / 64.0f)) * 0.125f); sorted[b * 64 + lane] = nw;
    }
    __builtin_amdgcn_fence(__ATOMIC_ACQ_REL, "wavefront"); __builtin_amdgcn_wave_barrier();
    float acc[4][16];
#pragma unroll
    for (int t = 0; t < 4; ++t)
#pragma unroll
        for (int i = 0; i < 16; ++i) acc[t][i] = 0.f;
#pragma nounroll
    for (int b = 0; b < 8; ++b) {
        const u32x2 sp = sorted[b * 64 + lane];
#pragma nounroll
        for (int k = 0; k < 64; k += 4) {
            unsigned ev[4]; float wv[4]; u32x4 a0[4];
#pragma unroll
            for (int j = 0; j < 4; ++j) { ev[j] = (unsigned)__builtin_amdgcn_readlane((int)sp.x, k + j); wv[j] = __uint_as_float((unsigned)__builtin_amdgcn_readlane((int)sp.y, k + j));
                a0[j] = *(const u32x4*)(VT + (size_t)(ev[j] & 0x3fffu) * 1024); }
#pragma unroll
            for (int j = 0; j < 4; ++j) {
                const unsigned tau = ev[j] >> 14;
                const float w0 = tau == 0u ? wv[j] : 0.f, w1 = tau == 1u ? wv[j] : 0.f, w2 = tau == 2u ? wv[j] : 0.f, w3 = tau == 3u ? wv[j] : 0.f;
                const unsigned aw[4] = {a0[j].x, a0[j].y, a0[j].z, a0[j].w};
#pragma unroll
                for (int i = 0; i < 8; ++i) {
                    const f32x2_t vv = (i & 1) ? __builtin_amdgcn_cvt_pk_f32_fp8((int)aw[i >> 1], true) : __builtin_amdgcn_cvt_pk_f32_fp8((int)aw[i >> 1], false); const float vx = vv.x, vy = vv.y;
                    acc[0][2 * i] = __builtin_fmaf(vx, w0, acc[0][2 * i]); acc[0][2 * i + 1] = __builtin_fmaf(vy, w0, acc[0][2 * i + 1]);
                    acc[1][2 * i] = __builtin_fmaf(vx, w1, acc[1][2 * i]); acc[1][2 * i + 1] = __builtin_fmaf(vy, w1, acc[1][2 * i + 1]);
                    acc[2][2 * i] = __builtin_fmaf(vx, w2, acc[2][2 * i]); acc[2][2 * i + 1] = __builtin_fmaf(vy, w2, acc[2][2 * i + 1]);
                    acc[3][2 * i] = __builtin_fmaf(vx, w3, acc[3][2 * i]); acc[3][2 * i + 1] = __builtin_fmaf(vy, w3, acc[3][2 * i + 1]);
                }
            }
        }
    }
    const float* g2 = P.in[27] + lane * 16; const float* b2 = P.in[28] + lane * 16;
#pragma unroll
    for (int t = 0; t < 4; ++t) {
        float* X1 = P.out + (size_t)(tok0 + t) * 1024 + lane * 16;
        float s = 0.f;
#pragma unroll
        for (int i = 0; i < 4; ++i) { const f32x4 v = ((const f32x4*)X1)[i];
#pragma unroll
            for (int j = 0; j < 4; ++j) { acc[t][4 * i + j] = DN_ALPHA * v[j] + (ABL_NOPEER ? 0.f : acc[t][4 * i + j]); s += acc[t][4 * i + j]; } }
        const float mean = wave_total(s) * (1.0f / 1024.0f); float s2 = 0.f;
#pragma unroll
        for (int i = 0; i < 16; ++i) { acc[t][i] -= mean; s2 += acc[t][i] * acc[t][i]; }
        const float rstd = 1.0f / sqrtf(wave_total(s2) * (1.0f / 1024.0f) + LN_EPS);
#pragma unroll
        for (int i = 0; i < 4; ++i) {
            const f32x4 gg = ((const f32x4*)g2)[i], bb = ((const f32x4*)b2)[i]; f32x4 o;
#pragma unroll
            for (int j = 0; j < 4; ++j) o[j] = acc[t][4 * i + j] * rstd * gg[j] + bb[j];
            ((f32x4*)X1)[i] = o;
        }
    }
}


__device__ __forceinline__ float row16_total(float v) {
    v = dpp_add(v, 0); v = dpp_add(v, 1); v = dpp_add(v, 2); v = dpp_add(v, 3); return v;
}
__device__ __forceinline__ void peer_round4(const Params& P, LAS unsigned char* wl, int tok0, int lane) {
    unsigned char* ws = P.ws;
    const int tau = lane >> 4, l16 = lane & 15;
    LAS u32x2* sorted = (LAS u32x2*)wl;
    LAS unsigned* cnt = (LAS unsigned*)(wl + 4096);
    LAS unsigned* off = (LAS unsigned*)(wl + 4096 + 1024);
    const int tok = tok0 + tau;
    h16x2 xh[32];
    {
        const f32x4* X1 = (const f32x4*)(P.out + (size_t)tok * 1024 + l16 * 64);
#pragma unroll
        for (int i = 0; i < 16; ++i) { const f32x4 v = X1[i]; xh[2 * i].x = (_Float16)v[0]; xh[2 * i].y = (_Float16)v[1]; xh[2 * i + 1].x = (_Float16)v[2]; xh[2 * i + 1].y = (_Float16)v[3]; }
    }
#pragma unroll
    for (int i = 0; i < 4; ++i) cnt[i * 64 + lane] = 0u;
    __builtin_amdgcn_fence(__ATOMIC_RELEASE, "wavefront"); __builtin_amdgcn_wave_barrier();
    const u32x2* pk = (const u32x2*)(ws + WS_PK) + (size_t)tok * 128;
    u32x2 pv[8]; unsigned pos[8];
#pragma unroll
    for (int m = 0; m < 8; ++m) { pv[m] = pk[m * 16 + l16]; pos[m] = __hip_atomic_fetch_add(&cnt[tau * 64 + (pv[m].x >> 8)], 1u, __ATOMIC_RELAXED, __HIP_MEMORY_SCOPE_WAVEFRONT); }
    __builtin_amdgcn_fence(__ATOMIC_ACQ_REL, "wavefront"); __builtin_amdgcn_wave_barrier();
#pragma unroll
    for (int t = 0; t < 4; ++t) {
        const unsigned c = cnt[t * 64 + lane]; unsigned sfx = c;
#pragma unroll
        for (int o = 1; o < 64; o <<= 1) { const unsigned u = __shfl_up(sfx, o); if (lane >= o) sfx += u; }
        off[t * 64 + lane] = sfx - c;
    }
    __builtin_amdgcn_fence(__ATOMIC_ACQ_REL, "wavefront"); __builtin_amdgcn_wave_barrier();
#pragma unroll
    for (int m = 0; m < 8; ++m) { const unsigned dst = off[tau * 64 + (pv[m].x >> 8)] + pos[m]; sorted[tau * 128 + dst] = pv[m]; }
    __builtin_amdgcn_fence(__ATOMIC_ACQ_REL, "wavefront"); __builtin_amdgcn_wave_barrier();
    const unsigned char* UT = ws + WS_UTAB + l16 * 64; const unsigned char* VT = ws + WS_VTAB + l16 * 64;
#pragma nounroll
    for (int i0 = 0; i0 < 128; i0 += 16) {
        float hv = 0.f;
#pragma nounroll
        for (int i = i0; i < i0 + 16; i += 2) {
            u32x4 a[2][4];
#pragma unroll
            for (int j = 0; j < 2; ++j) { const unsigned e = sorted[tau * 128 + i + j].x; const u32x4* row = (const u32x4*)(UT + (size_t)e * 1024);
#pragma unroll
                for (int q = 0; q < 4; ++q) a[j][q] = row[q]; }
#pragma unroll
            for (int j = 0; j < 2; ++j) {
                float d = 0.f;
#pragma unroll
                for (int q = 0; q < 4; ++q) {
                    const unsigned aw[4] = {a[j][q].x, a[j][q].y, a[j][q].z, a[j][q].w};
#pragma unroll
                    for (int c = 0; c < 4; ++c) {
                        const f32x2_t lo = __builtin_amdgcn_cvt_pk_f32_fp8((int)aw[c], false), hi = __builtin_amdgcn_cvt_pk_f32_fp8((int)aw[c], true);
                        const h16x2 x0 = xh[8 * q + 2 * c], x1 = xh[8 * q + 2 * c + 1];
                        d = __builtin_fmaf(lo.x, (float)x0.x, d); d = __builtin_fmaf(lo.y, (float)x0.y, d); d = __builtin_fmaf(hi.x, (float)x1.x, d); d = __builtin_fmaf(hi.y, (float)x1.y, d);
                    }
                }
                const float tot = row16_total(d);
                hv = (l16 == ((i + j) & 15)) ? tot : hv;
            }
        }
        u32x2 sp = sorted[tau * 128 + i0 + l16]; sp.y = __float_as_uint(__uint_as_float(sp.y) * gelu_tanh(hv * (1.0f / 64.0f)) * 0.125f); sorted[tau * 128 + i0 + l16] = sp;
    }
    __builtin_amdgcn_fence(__ATOMIC_ACQ_REL, "wavefront"); __builtin_amdgcn_wave_barrier();
    float acc[64];
#pragma unroll
    for (int i = 0; i < 64; ++i) acc[i] = 0.f;
#pragma nounroll
    for (int i = 0; i < 128; i += 2) {
        u32x4 a[2][4]; float wv[2];
#pragma unroll
        for (int j = 0; j < 2; ++j) { const u32x2 sp = sorted[tau * 128 + i + j]; wv[j] = __uint_as_float(sp.y); const u32x4* row = (const u32x4*)(VT + (size_t)sp.x * 1024);
#pragma unroll
            for (int q = 0; q < 4; ++q) a[j][q] = row[q]; }
#pragma unroll
        for (int j = 0; j < 2; ++j)
#pragma unroll
            for (int q = 0; q < 4; ++q) {
                const unsigned aw[4] = {a[j][q].x, a[j][q].y, a[j][q].z, a[j][q].w};
#pragma unroll
                for (int c = 0; c < 4; ++c) {
                    const f32x2_t lo = __builtin_amdgcn_cvt_pk_f32_fp8((int)aw[c], false), hi = __builtin_amdgcn_cvt_pk_f32_fp8((int)aw[c], true);
                    acc[16 * q + 4 * c + 0] = __builtin_fmaf(lo.x, wv[j], acc[16 * q + 4 * c + 0]); acc[16 * q + 4 * c + 1] = __builtin_fmaf(lo.y, wv[j], acc[16 * q + 4 * c + 1]);
                    acc[16 * q + 4 * c + 2] = __builtin_fmaf(hi.x, wv[j], acc[16 * q + 4 * c + 2]); acc[16 * q + 4 * c + 3] = __builtin_fmaf(hi.y, wv[j], acc[16 * q + 4 * c + 3]);
                }
            }
    }
    {
        float* X1 = P.out + (size_t)tok * 1024 + l16 * 64;
        float s = 0.f;
#pragma unroll
        for (int i = 0; i < 16; ++i) { const f32x4 v = ((const f32x4*)X1)[i];
#pragma unroll
            for (int j = 0; j < 4; ++j) { acc[4 * i + j] = DN_ALPHA * v[j] + (ABL_NOPEER ? 0.f : acc[4 * i + j]); s += acc[4 * i + j]; } }
        const float mean = row16_total(s) * (1.0f / 1024.0f); float s2 = 0.f;
#pragma unroll
        for (int i = 0; i < 64; ++i) { acc[i] -= mean; s2 += acc[i] * acc[i]; }
        const float rstd = 1.0f / sqrtf(row16_total(s2) * (1.0f / 1024.0f) + LN_EPS);
        const float* g2 = P.in[27] + l16 * 64; const float* b2 = P.in[28] + l16 * 64;
#pragma unroll
        for (int i = 0; i < 16; ++i) {
            const f32x4 gg = ((const f32x4*)g2)[i], bb = ((const f32x4*)b2)[i]; f32x4 o;
#pragma unroll
            for (int j = 0; j < 4; ++j) o[j] = acc[4 * i + j] * rstd * gg[j] + bb[j];
            ((f32x4*)X1)[i] = o;
        }
    }
}

#define XB_TMO      128
#define XB_XCNT(j)  (256  + 64 * (j))
#define XB_XSUB(j)  (1280 + 64 * (j))
#define XB_XGEN(j)  (2304 + 64 * (j))
#define XB_TOP      3328
#define XB_TOPGEN   3392
#define XCD_BAR_WORDS 3456
#define XB_SPIN_CAP (1u << 24)
__device__ __forceinline__ unsigned xb_ld(unsigned* p)              { return __hip_atomic_load(p, __ATOMIC_RELAXED, __HIP_MEMORY_SCOPE_AGENT); }
__device__ __forceinline__ unsigned xb_add(unsigned* p, unsigned v) { return __hip_atomic_fetch_add(p, v, __ATOMIC_RELAXED, __HIP_MEMORY_SCOPE_AGENT); }
__device__ __forceinline__ unsigned xb_xcc_id() { return (unsigned)__builtin_amdgcn_s_getreg((3 << 11) | 20) & 0xFu; }
#define XB_SPIN(cond, bar) do { unsigned _sp = 0; while (cond) { __builtin_amdgcn_s_sleep(1); \
    if ((++_sp & 255u) == 0u) { if (xb_ld(&(bar)[XB_TMO])) break; if (_sp > XB_SPIN_CAP) { atomicAdd(&(bar)[XB_TMO], 1u); break; } } } } while (0)
struct XcdBarrier { unsigned* bar; unsigned x; volatile LAS unsigned* st; };
__device__ __forceinline__ XcdBarrier xcd_barrier_post(unsigned* bar, volatile LAS unsigned* st) {
    XcdBarrier b; b.bar = bar; b.x = xb_xcc_id(); b.st = st;
    if (threadIdx.x == 0) (void)xb_add(&bar[XB_XCNT(b.x)], 1u);
    return b;
}
__device__ __forceinline__ void xcd_barrier_complete(unsigned* bar, unsigned x, unsigned& nloc, unsigned& nx) {
    const unsigned G = gridDim.x * gridDim.y * gridDim.z;
    unsigned sum, cnt, mine, sp = 0u;
    for (;;) {
        sum = 0u; cnt = 0u; mine = 0u;
#pragma unroll
        for (unsigned j = 0; j < 16; ++j) { const unsigned c = xb_ld(&bar[XB_XCNT(j)]); sum += c; cnt += (c > 0u) ? 1u : 0u; mine = (j == x) ? c : mine; }
        if (sum == G) break;
        __builtin_amdgcn_s_sleep(1);
        if ((++sp & 255u) == 0u) { if (xb_ld(&bar[XB_TMO])) break; if (sp > XB_SPIN_CAP) { atomicAdd(&bar[XB_TMO], 1u); break; } }
    }
    nloc = mine > 0u ? mine : 1u; nx = cnt > 0u ? cnt : 1u;
}
__device__ __forceinline__ void xcd_barrier(const XcdBarrier& b) {
    asm volatile("s_waitcnt vmcnt(0)" ::: "memory");
    __syncthreads();
    if (threadIdx.x == 0) {
        unsigned* bar = b.bar;
        __builtin_amdgcn_s_waitcnt(0);
        unsigned nloc = b.st[0], nx = b.st[1];
        if (nloc == 0u) { xcd_barrier_complete(bar, b.x, nloc, nx); b.st[0] = nloc; b.st[1] = nx; }
        const unsigned old = xb_add(&bar[XB_XSUB(b.x)], 1u);
        const unsigned gen = old / nloc;
        if (old + 1u == (gen + 1u) * nloc) {
            __builtin_amdgcn_fence(__ATOMIC_RELEASE, "agent");
            asm volatile("s_waitcnt vmcnt(0)" ::: "memory");
            const unsigned og = xb_add(&bar[XB_TOP], 1u);
            const unsigned tg = og / nx;
            if (og + 1u == (tg + 1u) * nx) xb_add(&bar[XB_TOPGEN], 1u);
            else XB_SPIN(xb_ld(&bar[XB_TOPGEN]) == tg, bar);
            __builtin_amdgcn_fence(__ATOMIC_ACQUIRE, "agent");
            xb_add(&bar[XB_XGEN(b.x)], 1u);
            asm volatile("s_waitcnt vmcnt(0)" ::: "memory");
        } else {
            XB_SPIN(xb_ld(&bar[XB_XGEN(b.x)]) == gen, bar);
            __builtin_amdgcn_fence(__ATOMIC_ACQUIRE, "agent");
            asm volatile("s_waitcnt vmcnt(0)" ::: "memory");
        }
    }
    __syncthreads();
}

__device__ __forceinline__ int next_item(unsigned* ctr, LAS int* slot) {
    __syncthreads();
    if (threadIdx.x == 0) *slot = (int)atomicAdd(ctr, 1u);
    __syncthreads();
    return __builtin_amdgcn_readfirstlane(*slot);
}


#ifdef CHECK_PEER
__device__ __forceinline__ void check_peer(const Params& P, LAS unsigned char* lds, unsigned* ctl) {
    unsigned char* ws = P.ws;
    const int tid = threadIdx.x;
    const bf16_t* QP = (const bf16_t*)(ws + WS_QP); const bf16_t* SK = (const bf16_t*)(ws + WS_SUBK);
    const u32x2* PK = (const u32x2*)(ws + WS_PK);
    unsigned bad_e = 0, bad_g = 0;
    if (tid < 64) {
        LAS float* sc = (LAS float*)lds + tid * 257;
        LAS float* sv = (LAS float*)(lds + 64 * 257 * 4) + tid * 33;
        LAS int* si = (LAS int*)(lds + 64 * 257 * 4 + 64 * 33 * 4) + tid * 33;
        for (int pair = blockIdx.x * 64 + tid; pair < T_TOK * 8; pair += gridDim.x * 64) {
            const int t = pair >> 3, h = pair & 7;
            for (int c = 0; c < 2; ++c)
                for (int k = 0; k < 128; ++k) {
                    float a = 0.f;
                    for (int d = 0; d < 64; ++d) a += bf2f(QP[(size_t)t * 1024 + h * 128 + c * 64 + d]) * bf2f(SK[((size_t)((h * 2 + c) * 128 + k)) * 64 + d]);
                    sc[c * 128 + k] = a;
                }
            for (int c = 0; c < 2; ++c) {
                float pv = 3.0e38f; int pi = -1;
                for (int r = 0; r < 16; ++r) {
                    float bv = -3.0e38f; int bi = -1;
                    for (int k = 0; k < 128; ++k) { const float v = sc[c * 128 + k]; const bool after = (v < pv) || (v == pv && k > pi); if (after && (v > bv)) { bv = v; bi = k; } }
                    sv[c * 16 + r] = bv; si[c * 16 + r] = bi; pv = bv; pi = bi;
                }
            }
            float pv = 3.0e38f; int pi = -1; float best[16]; int bexp[16];
            float mv = 0.f, sum = 0.f;
            for (int r = 0; r < 16; ++r) {
                float bv = -3.0e38f; int bi = -1;
                for (int f = 0; f < 256; ++f) { const float v = sv[f >> 4] + sv[16 + (f & 15)]; const bool after = (v < pv) || (v == pv && f > pi); if (after && (v > bv)) { bv = v; bi = f; } }
                pv = bv; pi = bi;
                const int e = si[bi >> 4] * 128 + si[16 + (bi & 15)];
                if (r == 0) mv = bv;
                const float ev = expf(bv - mv); sum += ev;
                bool found = false; float gpk = 0.f;
                for (int k = 0; k < 16; ++k) { const u32x2 q = PK[(size_t)pair * 16 + k]; if ((int)q.x == e) { found = true; gpk = __uint_as_float(q.y); } }
                if (!found) ++bad_e;
                sc[r] = ev; sc[16 + r] = found ? gpk : -1.f;
            }
            for (int r = 0; r < 16; ++r) { const float gref = sc[r] / sum, gpk = sc[16 + r]; if (gpk >= 0.f && fabsf(gref - gpk) > 0.02f) ++bad_g; }
        }
    }
    if (bad_e) atomicAdd(ctl + 300, bad_e);
    if (bad_g) atomicAdd(ctl + 301, bad_g);
}
#endif

#ifdef CHECK_PROJ
__device__ __forceinline__ void check_proj(const Params& P, unsigned* ctl) {
    unsigned char* ws = P.ws;
    const float* x = P.in[0]; const float* w = P.in[1]; const float* bi = P.in[2];
    const int gtid = blockIdx.x * 512 + threadIdx.x, NT = gridDim.x * 512;
    unsigned bad[5] = {0, 0, 0, 0, 0};
    const int nrows = 128;
    for (int i = gtid; i < nrows * INC; i += NT) {
        const int col = i % INC, row = (i / INC) * 127 + 5;
        float a = bi[col];
        for (int k = 0; k < 1024; ++k) a += x[(size_t)row * 1024 + k] * w[(size_t)k * INC + col];
        float got, ref; int cat;
        if (col < 512) { const int b = row >> 12, sq = row & 4095, g = col >> 4, hp = col & 15; got = bf2f(((const bf16_t*)(ws + WS_UG))[((size_t)((b * 32 + g) * 4096 + sq)) * 16 + hp]); ref = a; cat = 0; }
        else if (col < 1024) { got = bf2f(((const bf16_t*)(ws + WS_Q))[(size_t)row * 512 + col - 512]); ref = a * 0.125f * LOG2E; cat = 1; }
        else if (col < 1792) { const int idx = (col - 1024) >> 7, cc = (col - 1024) & 127; got = bf2f(((const bf16_t*)(ws + WS_KV))[((size_t)idx * T_TOK + row) * 128 + cc]); ref = a; cat = 2; }
        else if (col < 1816) { got = ((const float*)(ws + WS_GATES))[(size_t)row * 24 + col - 1792]; ref = 1.f / (1.f + expf(-a)); cat = 3; }
        else { got = bf2f(((const bf16_t*)P.out)[(size_t)row * 2048 + col - 1816]); ref = 1.f / (1.f + expf(-a)); cat = 4; }
        if (!(fabsf(got - ref) <= 0.04f + 0.02f * fabsf(ref))) ++bad[cat];
    }
    for (int c = 0; c < 5; ++c) if (bad[c]) atomicAdd(ctl + 300 + c, bad[c]);
}
#endif

#ifdef CHECK_S5
__device__ __forceinline__ void check_s5(const Params& P, LAS unsigned char* lds, unsigned* ctl) {
    unsigned char* ws = P.ws;
    if (blockIdx.x >= 16) return;
    const int tid = threadIdx.x, b = blockIdx.x & 3, g = (blockIdx.x * 7 + 3) & 31;
    const float* a_re = P.in[3]; const float* a_im = P.in[4]; const float* log_dt = P.in[5]; const float* b_re = P.in[6]; const float* b_im = P.in[7]; const float* c_re = P.in[8]; const float* c_im = P.in[9]; const float* dsk = P.in[10];
    LAS float* part = (LAS float*)lds;
    const bf16_t* UGp = (const bf16_t*)(ws + WS_UG) + ((size_t)(b * 32 + g) * 4096) * 16;
    const bf16_t* YG = (const bf16_t*)(ws + WS_YG);
    const int p = tid & 63;
    const float dt = expf(log_dt[g]); const float are = a_re[g * 64 + p], aim = a_im[g * 64 + p];
    const cpx lb = lam_pow(are, aim, dt, 1.0f); const cpx cf = bbar_coef(are, aim, dt);
    float bbr[16], bbi[16], cr[16], ci[16];
    for (int j = 0; j < 16; ++j) { const cpx bb = cmul(cf, cpx{b_re[(g * 64 + p) * 16 + j], b_im[(g * 64 + p) * 16 + j]}); bbr[j] = bb.re; bbi[j] = bb.im; cr[j] = c_re[(g * 16 + j) * 64 + p]; ci[j] = c_im[(g * 16 + j) * 64 + p]; }
    float xr = 0.f, xi = 0.f; unsigned bad = 0;
    for (int sq = 0; sq < 4096; ++sq) {
        float u[16];
        for (int j = 0; j < 16; ++j) u[j] = bf2f(UGp[(size_t)sq * 16 + j]);
        float br = 0.f, bim = 0.f;
        for (int j = 0; j < 16; ++j) { br += bbr[j] * u[j]; bim += bbi[j] * u[j]; }
        const float nr = lb.re * xr - lb.im * xi + br, ni = lb.re * xi + lb.im * xr + bim; xr = nr; xi = ni;
        __syncthreads();
        if (tid < 64) for (int j = 0; j < 16; ++j) part[p * 17 + j] = cr[j] * xr - ci[j] * xi;
        __syncthreads();
        if (tid < 16) {
            float y = 0.f; for (int q = 0; q < 64; ++q) y += part[q * 17 + tid];
            y += dsk[g * 16 + tid] * u[tid];
            const float ref = gelu_tanh(y); const float got = bf2f(YG[((size_t)(b * 4096 + sq)) * 512 + g * 16 + tid]);
            if (!(fabsf(got - ref) <= 0.03f + 0.03f * fabsf(ref))) ++bad;
        }
    }
    if (bad) atomicAdd(ctl + 300, bad);
}
#endif

#ifdef CHECK_ATTN
__device__ __forceinline__ void check_attn(const Params& P, LAS unsigned char* lds, unsigned* ctl) {
    unsigned char* ws = P.ws;
    const int tid = threadIdx.x, lane = tid & 63, r = tid >> 6;
    const bf16_t* Qp = (const bf16_t*)(ws + WS_Q); const bf16_t* KVp = (const bf16_t*)(ws + WS_KV);
    const float* GT = (const float*)(ws + WS_GATES); const bf16_t* Op = (const bf16_t*)(ws + WS_O);
    LAS float* sc = (LAS float*)lds;
    LAS float* impH = sc + 1024;
    LAS int* sel = (LAS int*)(impH + 256);
    unsigned bad = 0, badsel = 0;
    for (int smp = 0; smp < 3; ++smp) {
        const int id = blockIdx.x * 3 + smp;
        const int b = id & 3, g = (id >> 2) & 1;
        int t = (int)(((unsigned)id * 2654435761u) >> 20) & 4095;
        if (id < 16) t = id * 9;
        if (id >= 16 && id < 32) t = 1000 + (id - 16) * 4;
        const size_t rowq = (size_t)b * 4096 + t;
        const int hd = g * 4 + (r & 3);
        const float nslope2 = -exp2f(-(float)(hd + 1)) * LOG2E;
        const float q = r < 4 ? bf2f(Qp[rowq * 512 + hd * 64 + lane]) : 0.f;
        const bf16_t* KC = (const bf16_t*)(ws + WS_KC) + (size_t)(b * 2 + g) * 256 * 64; const bf16_t* VC = (const bf16_t*)(ws + WS_VC) + (size_t)(b * 2 + g) * 256 * 64;
        float tot = 0.f;
        __syncthreads();
        if (r < 4) {
            const int ncmp = t >= 31 ? (t - 31) / 16 + 1 : 0;
            float m = -1e30f;
            for (int c = 0; c < ncmp; ++c) { float s2 = wave_sum(q * bf2f(KC[c * 64 + lane])) + nslope2 * (float)(t - (16 * c + 31)); if (lane == 0) sc[r * 256 + c] = s2; m = fmaxf(m, s2); }
            float l = 0.f;
            for (int c = 0; c < ncmp; ++c) l += exp2f(sc[r * 256 + c] - m);
            float o = 0.f;
            for (int c = 0; c < ncmp; ++c) { const float p = exp2f(sc[r * 256 + c] - m) / l; o += p * bf2f(VC[c * 64 + lane]); }
            tot += GT[rowq * 24 + g * 12 + r * 3 + 0] * o;
            float im = 0.f;
            for (int cc = 4 * lane - 1; cc <= 4 * lane + 3; ++cc) if (cc >= 0 && cc < ncmp) im += exp2f(sc[r * 256 + cc] - m) / l;
            impH[r * 64 + lane] = im;
        }
        __syncthreads();
        if (tid < 64) {
            const int j = tid, cur = t >> 6; const float imp = impH[j] + impH[64 + j] + impH[128 + j] + impH[192 + j];
            const bool valid = j <= cur, forced = (j == 0) || (j == cur) || (j == cur - 1);
            const float key = valid ? imp + (forced ? 1.0e4f : 0.f) : -1e30f;
            sc[j] = key;
        }
        __syncthreads();
        if (tid < 64) {
            const int j = tid; const float key = sc[j]; int cnt = 0;
            for (int jp = 0; jp < 64; ++jp) { const float sj = sc[jp]; cnt += ((sj > key) || (sj == key && jp < j)) ? 1 : 0; }
            sel[j] = (cnt < 16) ? 1 : 0;
        }
        __syncthreads();
        if (r < 4) {
            const bf16_t* Ks = KVp + (size_t)2 * T_TOK * 128; const bf16_t* Vs = KVp + (size_t)3 * T_TOK * 128;
            float m = -1e30f, l = 0.f, o = 0.f;
            for (int j = 0; j < 64; ++j) if (sel[j]) for (int kk = 0; kk < 64; ++kk) { const int kp = 64 * j + kk; if (kp > t) break;
                const float s2 = wave_sum(q * bf2f(Ks[((size_t)b * 4096 + kp) * 128 + g * 64 + lane])) + nslope2 * (float)(t - kp);
                const float mn = fmaxf(m, s2), al = exp2f(m - mn), p = exp2f(s2 - mn); l = l * al + p; o = o * al + p * bf2f(Vs[((size_t)b * 4096 + kp) * 128 + g * 64 + lane]); m = mn; }
            tot += GT[rowq * 24 + g * 12 + r * 3 + 1] * o / fmaxf(l, 1e-30f);
            const bf16_t* Kw = KVp + (size_t)4 * T_TOK * 128; const bf16_t* Vw = KVp + (size_t)5 * T_TOK * 128;
            m = -1e30f; l = 0.f; o = 0.f;
            for (int kp = (t - 511 > 0 ? t - 511 : 0); kp <= t; ++kp) {
                const float s2 = wave_sum(q * bf2f(Kw[((size_t)b * 4096 + kp) * 128 + g * 64 + lane])) + nslope2 * (float)(t - kp);
                const float mn = fmaxf(m, s2), al = exp2f(m - mn), p = exp2f(s2 - mn); l = l * al + p; o = o * al + p * bf2f(Vw[((size_t)b * 4096 + kp) * 128 + g * 64 + lane]); m = mn; }
            tot += GT[rowq * 24 + g * 12 + r * 3 + 2] * o / fmaxf(l, 1e-30f);
            const float got = bf2f(Op[rowq * 512 + hd * 64 + lane]);
            if (!(fabsf(got - tot) <= 0.02f + 0.03f * fabsf(tot))) ++bad;
        }
    }
    if (bad) atomicAdd(ctl + 300, bad);
}
#endif

#ifdef CHECK_CMP
__device__ __forceinline__ void check_cmp(const Params& P, LAS unsigned char* lds, unsigned* ctl) {
    unsigned char* ws = P.ws;
    const int tid = threadIdx.x;
    LAS float* h1 = (LAS float*)lds;
    unsigned bad = 0;
    for (int smp = 0; smp < 4; ++smp) {
        const int id = blockIdx.x * 4 + smp;
        const int kv = id & 1, b = (id >> 1) & 3, g = (id >> 3) & 1; int c = (int)(((unsigned)id * 2654435761u) >> 22) % 255; if (id < 32) c = 254 - (id >> 4);
        const bf16_t* src = (const bf16_t*)(ws + WS_KV) + (size_t)kv * T_TOK * 128;
        const float* pe = P.in[kv ? 16 : 13]; const float* w1 = P.in[kv ? 17 : 14]; const float* w2 = P.in[kv ? 18 : 15];
        const bf16_t* dst = (const bf16_t*)(ws + (kv ? WS_VC : WS_KC));
        __syncthreads();
        if (tid < 128) { float a = 0.f;
            for (int k = 0; k < 2048; ++k) { const int l = k >> 6, d = k & 63; a += (bf2f(src[((size_t)(b * 4096 + 16 * c + l)) * 128 + g * 64 + d]) + pe[k]) * w1[(size_t)k * 128 + tid]; }
            h1[tid] = gelu_tanh(a); }
        __syncthreads();
        if (tid < 64) { float a = 0.f; for (int n = 0; n < 128; ++n) a += h1[n] * w2[n * 64 + tid];
            const float got = bf2f(dst[((size_t)((b * 2 + g) * 256 + c)) * 64 + tid]);
            if (!(fabsf(got - a) <= 0.02f + 0.03f * fabsf(a))) ++bad; }
    }
    if (bad) atomicAdd(ctl + 300, bad);
}
#endif

#ifdef CHECK_X1
#ifndef X1TOL
#define X1TOL 0.03f
#endif
#ifndef X1SRC
#define X1SRC 0
#endif
__device__ __forceinline__ void check_x1(const Params& P, LAS unsigned char* lds, unsigned* ctl, const bf16_t* GMcopy) {
    unsigned char* ws = P.ws;
    const int tid = threadIdx.x; const int row = (int)(((unsigned)blockIdx.x * 2654435761u) >> 18) & 16383;
    LAS float* yg = (LAS float*)lds; LAS float* z = yg + 512; LAS float* o = z + 512; LAS float* m = o + 512; LAS float* rr = m + 1024; LAS float* red = rr + 1024;
    const bf16_t* YG = (const bf16_t*)(ws + WS_YG); const bf16_t* Op = (const bf16_t*)(ws + WS_O);
    const float* wglu = P.in[11]; const float* wups = P.in[12]; const float* wupn = P.in[19]; const float* wout = P.in[20];
    yg[tid] = bf2f(YG[(size_t)row * 512 + tid]); o[tid] = bf2f(Op[(size_t)row * 512 + tid]);
    __syncthreads();
    { float ga = 0.f, gb = 0.f; for (int k = 0; k < 512; ++k) { ga += yg[k] * wglu[(size_t)k * 1024 + tid]; gb += yg[k] * wglu[(size_t)k * 1024 + 512 + tid]; } z[tid] = ga / (1.f + expf(-gb)); }
    __syncthreads();
    if (CHECK_X1 == 2) { const float got = bf2f(((const bf16_t*)(ws + WS_Z))[(size_t)row * 512 + tid]); if (!(fabsf(got - z[tid]) <= 0.02f + 0.03f * fabsf(z[tid]))) atomicAdd(ctl + 300, 1u); return; }
    for (int n = tid; n < 1024; n += 512) { float ya = 0.f, yb = 0.f; for (int k = 0; k < 512; ++k) { ya += z[k] * wups[(size_t)k * 1024 + n]; yb += o[k] * wupn[(size_t)k * 1024 + n]; }
        m[n] = bf2f(GMcopy[(size_t)blockIdx.x * 2048 + n]) * ya + bf2f(GMcopy[(size_t)blockIdx.x * 2048 + 1024 + n]) * yb; }
    __syncthreads();
    if (CHECK_X1 == 3) { for (int n = tid; n < 1024; n += 512) { const float got = bf2f(((const bf16_t*)(ws + WS_MIXIN))[(size_t)row * 1024 + n]); if (!(fabsf(got - m[n]) <= 0.02f + 0.03f * fabsf(m[n]))) atomicAdd(ctl + 300, 1u); } return; }
    for (int n = tid; n < 1024; n += 512) { float a = 0.f; for (int k = 0; k < 1024; ++k) a += m[k] * wout[(size_t)k * 1024 + n]; rr[n] = DN_ALPHA * P.in[0][(size_t)row * 1024 + n] + a; }
    __syncthreads();
    if (CHECK_X1 == 4) { for (int n = tid; n < 1024; n += 512) { const float got = P.out[(size_t)row * 1024 + n]; if (!(fabsf(got - rr[n]) <= 0.03f + 0.03f * fabsf(rr[n]))) atomicAdd(ctl + 300, 1u); } return; }
    float sm = 0.f; for (int n = tid; n < 1024; n += 512) sm += rr[n]; sm = wave_sum(sm); if ((tid & 63) == 0) red[tid >> 6] = sm; __syncthreads();
    float mean = 0.f; for (int i = 0; i < 8; ++i) mean += red[i]; mean *= (1.f / 1024.f); __syncthreads();
    float sq = 0.f; for (int n = tid; n < 1024; n += 512) sq += (rr[n] - mean) * (rr[n] - mean); sq = wave_sum(sq); if ((tid & 63) == 0) red[tid >> 6] = sq; __syncthreads();
    float var = 0.f; for (int i = 0; i < 8; ++i) var += red[i]; var *= (1.f / 1024.f);
    const float rstd = 1.f / sqrtf(var + LN_EPS); unsigned bad = 0;
    for (int n = tid; n < 1024; n += 512) { const float ref = (rr[n] - mean) * rstd * P.in[21][n] + P.in[22][n]; const float got = X1SRC ? bf2f(((const bf16_t*)(ws + WS_X1B))[(size_t)row * 1024 + n]) : P.out[(size_t)row * 1024 + n]; if (!(fabsf(got - ref) <= X1TOL + X1TOL * fabsf(ref))) ++bad; }
    if (bad) atomicAdd(ctl + 300, bad);
}
#endif

#ifdef CHECK_QP
__device__ __forceinline__ void check_qp(const Params& P, LAS unsigned char* lds, unsigned* ctl) {
    const int tid = threadIdx.x; const int row = (int)(((unsigned)blockIdx.x * 2654435761u) >> 18) & 16383;
    LAS float* xs = (LAS float*)lds;
    for (int n = tid; n < 1024; n += 512) xs[n] = P.out[(size_t)row * 1024 + n];
    __syncthreads();
    const float* wq = P.in[23]; const bf16_t* QP = (const bf16_t*)(P.ws + WS_QP);
    for (int n = tid; n < 1024; n += 512) { float a = 0.f; for (int k = 0; k < 1024; ++k) a += xs[k] * wq[(size_t)k * 1024 + n];
        const float got = bf2f(QP[(size_t)row * 1024 + n]); if (!(fabsf(got - a) <= 0.03f + 0.03f * fabsf(a))) atomicAdd(ctl + 300, 1u); }
}
#endif

#ifdef CHECK_P10
__device__ __forceinline__ void check_p10(const Params& P, LAS unsigned char* lds, unsigned* ctl) {
    const int tid = threadIdx.x; const int row = (int)(((unsigned)blockIdx.x * 2654435761u) >> 18) & 16383;
    LAS float* xs = (LAS float*)lds; LAS float* wgt = xs + 1024; LAS float* rr = wgt + 128; LAS float* red = rr + 1024;
    const float* xsave = (const float*)(P.ws + WS_Z) + (size_t)blockIdx.x * 1024;
    for (int n = tid; n < 1024; n += 512) xs[n] = xsave[n];
    __syncthreads();
    const u32x2* pk = (const u32x2*)(P.ws + WS_PK) + (size_t)row * 128;
    const float* ut = P.in[25]; const float* vt = P.in[26];
    if (tid < 128) { const u32x2 q = pk[tid]; float h = 0.f;
#pragma nounroll
        for (int k = 0; k < 1024; ++k) h += ut[(size_t)q.x * 1024 + k] * xs[k]; wgt[tid] = __uint_as_float(q.y) * (ABL_NOH ? 1.f : gelu_tanh(h)); }
    __syncthreads();
    for (int n = tid; n < 1024; n += 512) { float y = 0.f;
#pragma nounroll
        for (int k = 0; k < 128; ++k) y += wgt[k] * vt[(size_t)pk[k].x * 1024 + n]; rr[n] = DN_ALPHA * xs[n] + (ABL_NOPEER ? 0.f : y); }
    __syncthreads();
    float sm = 0.f; for (int n = tid; n < 1024; n += 512) sm += rr[n]; sm = wave_sum(sm); if ((tid & 63) == 0) red[tid >> 6] = sm; __syncthreads();
    float mean = 0.f; for (int i = 0; i < 8; ++i) mean += red[i]; mean *= (1.f / 1024.f); __syncthreads();
    float sq = 0.f; for (int n = tid; n < 1024; n += 512) sq += (rr[n] - mean) * (rr[n] - mean); sq = wave_sum(sq); if ((tid & 63) == 0) red[tid >> 6] = sq; __syncthreads();
    float var = 0.f; for (int i = 0; i < 8; ++i) var += red[i]; var *= (1.f / 1024.f);
    const float rstd = 1.f / sqrtf(var + LN_EPS);
    for (int n = tid; n < 1024; n += 512) { const float ref = (rr[n] - mean) * rstd * P.in[27][n] + P.in[28][n]; const float got = P.out[(size_t)row * 1024 + n]; if (!(fabsf(got - ref) <= 0.03f + 0.03f * fabsf(ref))) atomicAdd(ctl + 300, 1u); }
}
#endif
#ifndef STOP_AFTER
#define STOP_AFTER 99
#endif

#ifndef DG_A
#define DG_A 0
#define DG_B 0
#endif
__device__ __forceinline__ void digest(const Params& P) {
    const int gtid = blockIdx.x * 512 + threadIdx.x, NT = gridDim.x * 512;
    const unsigned short* a = (const unsigned short*)(P.ws + (size_t)(DG_A < 0 ? 0 : DG_A) * MiB); const unsigned short* b = (const unsigned short*)(P.ws + (size_t)DG_B * MiB);
    for (int i = gtid; i < 8 * 1024 * 1024; i += NT) { P.out[i] = (float)a[i]; P.out[8 * 1024 * 1024 + i] = (float)b[i]; }
}
#ifndef NC_A
#define NC_A -1
#define NC_AN 0
#define NC_B -1
#define NC_BN 0
#define NC_C -1
#define NC_CN 0
#endif
__device__ __forceinline__ void nan_probe(const Params& P, unsigned* ctl, const XcdBarrier& bar) {
    const int gtid = blockIdx.x * 512 + threadIdx.x, NT = gridDim.x * 512;
    const int offs[3] = {NC_A, NC_B, NC_C}, szs[3] = {NC_AN, NC_BN, NC_CN};
#pragma unroll
    for (int w = 0; w < 3; ++w) if (offs[w] >= 0) {
        const unsigned short* a = (const unsigned short*)(P.ws + (size_t)offs[w] * KiB); unsigned cnt = 0;
        for (size_t i = gtid; i < (size_t)szs[w] * KiB / 2; i += NT) cnt += ((a[i] & 0x7f80u) == 0x7f80u) ? 1u : 0u;
        if (cnt) atomicAdd(ctl + 300 + w, cnt);
    }
    xcd_barrier(bar);
    float c = 0.f;
#pragma unroll
    for (int w = 0; w < 3; ++w) if (offs[w] >= 0) { if (__hip_atomic_load(ctl + 300 + w, __ATOMIC_RELAXED, __HIP_MEMORY_SCOPE_AGENT) != 0u) c += (float)(1 << w); }
#ifdef NC_COUNT
    c = log2f(1.0f + (float)__hip_atomic_load(ctl + 300, __ATOMIC_RELAXED, __HIP_MEMORY_SCOPE_AGENT));
#endif
    for (int i = gtid; i < T_TOK * DM; i += NT) P.out[i] = c;
}
#define PHASE_END(k) do { if (STOP_AFTER == (k)) { GRID_BAR(); if (NC_A >= 0) nan_probe(P, ctl, bar); else if (DG_A >= 0) digest(P); return; } } while (0)
__global__ void __launch_bounds__(512, 2) hybrid_fwd(Params P) {
    extern __shared__ __attribute__((aligned(16))) unsigned char lds_raw[];
    LAS unsigned char* lds = (LAS unsigned char*)lds_raw;
    LAS int* slot = (LAS int*)(lds + LDS_BYTES - 64);
    cg::grid_group grid = cg::this_grid();
    unsigned char* ws = P.ws;
    unsigned* ctl = (unsigned*)(ws + WS_CTL);
    const int tid = threadIdx.x, lane = tid & 63, wave = __builtin_amdgcn_readfirstlane(tid >> 6);
    const int G = gridDim.x;
    volatile LAS unsigned* MISC = (volatile LAS unsigned*)(lds + LDS_BYTES - 32);
    if (tid < 2) MISC[tid] = 0u;
    __syncthreads();
    const XcdBarrier bar = xcd_barrier_post(ctl + CW_BAR, MISC);
#define GRID_BAR() xcd_barrier(bar)

    p0_prologue(P, lds);
#if DUP_PHASE == 0
    p0_prologue(P, lds);
#endif
    asm volatile("s_waitcnt vmcnt(0)" ::: "memory");
    grid.sync();
    if (tid == 0) { __builtin_amdgcn_fence(__ATOMIC_ACQUIRE, "agent"); asm volatile("s_waitcnt vmcnt(0)" ::: "memory"); }
    __syncthreads();

#if DUP_PHASE == 1
    {
        pg8::Gemm g{(const bf16_t*)(ws + WS_XB), (const bf16_t*)(ws + WS_WIN), T_TOK, INCP, 1024};
        pg8::StaticOrder S; S.init(T_TOK, INCP, G, (int)blockIdx.x);
        pg8::Epi8<FInProj> E{FInProj{P.in[2], (bf16_t*)(ws + WS_UG), (bf16_t*)(ws + WS_Q), (bf16_t*)(ws + WS_KV), (float*)(ws + WS_GATES), (bf16_t*)P.out}};
        pg8::gemm_phase(lds, g, S, E);
    }
    GRID_BAR();
#endif
    {
        pg8::Gemm g{(const bf16_t*)(ws + WS_XB), (const bf16_t*)(ws + WS_WIN), T_TOK, INCP, 1024};
        pg8::StaticOrder S; S.init(T_TOK, INCP, G, (int)blockIdx.x);
        pg8::Epi8<FInProj> E{FInProj{P.in[2], (bf16_t*)(ws + WS_UG), (bf16_t*)(ws + WS_Q), (bf16_t*)(ws + WS_KV), (float*)(ws + WS_GATES), (bf16_t*)P.out}};
        pg8::gemm_phase(lds, g, S, E);
    }
    GRID_BAR();

#ifdef CHECK_PROJ
    check_proj(P, ctl);
    GRID_BAR();
    { float c = 0.f; for (int k = 0; k < 5; ++k) if (__hip_atomic_load(ctl + 300 + k, __ATOMIC_RELAXED, __HIP_MEMORY_SCOPE_AGENT) != 0u) c += (float)(k < 3 ? (1 << k) : 0);
      if (CHECK_PROJ == 1) { c = 0.f; if (__hip_atomic_load(ctl + 303, __ATOMIC_RELAXED, __HIP_MEMORY_SCOPE_AGENT) != 0u) c += 1.f; if (__hip_atomic_load(ctl + 304, __ATOMIC_RELAXED, __HIP_MEMORY_SCOPE_AGENT) != 0u) c += 2.f; }
      for (int i = blockIdx.x * 512 + tid; i < T_TOK * DM; i += G * 512) P.out[i] = c; }
    return;
#endif
    PHASE_END(1);
#if DUP_PHASE == 2
    for (;;) { const int it = next_item(ctl + 384, slot); if (it >= 256) break; compress_item(P, lds, it); }
    s5_tables(P);
    GRID_BAR();
#endif
    for (;;) { const int it = next_item(ctl + CW_Q2, slot); if (it >= 256 + 288) break; if (it < 256) compress_item(P, lds, it); else ktab_item(P, lds, it - 256); }
    s5_tables(P);
    GRID_BAR();

#ifdef CHECK_CMP
    check_cmp(P, lds, ctl);
    GRID_BAR();
    { const float c = log2f(1.0f + (float)__hip_atomic_load(ctl + 300, __ATOMIC_RELAXED, __HIP_MEMORY_SCOPE_AGENT));
      for (int i = blockIdx.x * 512 + tid; i < T_TOK * DM; i += G * 512) P.out[i] = c; }
    return;
#endif
    PHASE_END(2);
#if DUP_PHASE == 3
    for (;;) { const int it = next_item(ctl + 256, slot); if (it >= 128) break; s5_item(P, lds, it & 31, it >> 5); }
    for (;;) { const int k = next_item(ctl + 320, slot); if (k >= 512) break; attn_item(P, lds, (k & 7) >> 1, k & 1, 63 - (k >> 3)); }
    GRID_BAR();
#endif
#if DUP_PHASE == 32
    for (;;) { const int k = next_item(ctl + 320, slot); if (k >= 512) break; attn_item(P, lds, (k & 7) >> 1, k & 1, 63 - (k >> 3)); }
    GRID_BAR();
#endif
#if DUP_PHASE == 31
    for (;;) { const int it = next_item(ctl + 256, slot); if (it >= 128) break; s5_item(P, lds, it & 31, it >> 5); }
    GRID_BAR();
#endif
    for (;;) { const int it = next_item(ctl + CW_Q3, slot); if (it >= 128) break; s5_item(P, lds, it & 31, it >> 5); }
#ifndef SKIP_ATTN
    for (;;) { const int k = next_item(ctl + CW_Q3B, slot); if (k >= 512) break; attn_item(P, lds, (k & 7) >> 1, k & 1, 63 - (k >> 3)); }
#endif
    GRID_BAR();

#ifdef CHECK_ATTN
    check_attn(P, lds, ctl);
    GRID_BAR();
    { const float c = log2f(1.0f + (float)__hip_atomic_load(ctl + 300, __ATOMIC_RELAXED, __HIP_MEMORY_SCOPE_AGENT));
      for (int i = blockIdx.x * 512 + tid; i < T_TOK * DM; i += G * 512) P.out[i] = c; }
    return;
#endif
#ifdef CHECK_S5
    check_s5(P, lds, ctl);
    GRID_BAR();
    { const float c = log2f(1.0f + (float)__hip_atomic_load(ctl + 300, __ATOMIC_RELAXED, __HIP_MEMORY_SCOPE_AGENT));
      for (int i = blockIdx.x * 512 + tid; i < T_TOK * DM; i += G * 512) P.out[i] = c; }
    return;
#endif
    PHASE_END(3);
    {
        pg8::Gemm g{(const bf16_t*)(ws + WS_YG), (const bf16_t*)(ws + WS_WGLU), T_TOK, 1024, 512};
        pg8::StaticOrder S; S.init(T_TOK, 1024, G, (int)blockIdx.x);
        EpiGLU E{(bf16_t*)(ws + WS_Z)};
        pg8::gemm_phase(lds, g, S, E);
    }
    GRID_BAR();

#if defined(CHECK_X1) && CHECK_X1 == 2
    check_x1(P, lds, ctl, (const bf16_t*)(ws + WS_PK));
    GRID_BAR();
    { const float c = log2f(1.0f + (float)__hip_atomic_load(ctl + 300, __ATOMIC_RELAXED, __HIP_MEMORY_SCOPE_AGENT));
      for (int i = blockIdx.x * 512 + tid; i < T_TOK * DM; i += G * 512) P.out[i] = c; }
    return;
#endif
    PHASE_END(4);
    {
        pg8::Gemm g{(const bf16_t*)(ws + WS_Z), (const bf16_t*)(ws + WS_WUPS), T_TOK, 1024, 512};
        pg8::StaticOrder S; S.init(T_TOK, 1024, G, (int)blockIdx.x);
        pg8::Epi8<FUp1> E{FUp1{(const bf16_t*)P.out, (bf16_t*)(ws + WS_M1)}};
        pg8::gemm_phase(lds, g, S, E);
    }
    {
        pg8::Gemm g{(const bf16_t*)(ws + WS_O), (const bf16_t*)(ws + WS_WUPN), T_TOK, 1024, 512};
        pg8::StaticOrder S; S.init(T_TOK, 1024, G, (int)blockIdx.x);
        pg8::Epi8<FUp2> E{FUp2{(const bf16_t*)P.out, (const bf16_t*)(ws + WS_M1), (bf16_t*)(ws + WS_MIXIN)}};
        pg8::gemm_phase(lds, g, S, E);
    }
    GRID_BAR();

#ifdef CHECK_X1
    { const int row = (int)(((unsigned)blockIdx.x * 2654435761u) >> 18) & 16383; bf16_t* dstg = (bf16_t*)(ws + WS_PK); const bf16_t* srcg = (const bf16_t*)P.out;
      for (int i = tid; i < 2048; i += 512) dstg[(size_t)blockIdx.x * 2048 + i] = srcg[(size_t)row * 2048 + i]; }
    GRID_BAR();
#if CHECK_X1 == 3
    check_x1(P, lds, ctl, (const bf16_t*)(ws + WS_PK));
    GRID_BAR();
    { const float c = log2f(1.0f + (float)__hip_atomic_load(ctl + 300, __ATOMIC_RELAXED, __HIP_MEMORY_SCOPE_AGENT));
      for (int i = blockIdx.x * 512 + tid; i < T_TOK * DM; i += G * 512) P.out[i] = c; }
    return;
#endif
#endif
    PHASE_END(5);
    {
        pg8::Gemm g{(const bf16_t*)(ws + WS_MIXIN), (const bf16_t*)(ws + WS_WOUT), T_TOK, 1024, 1024};
        pg8::StaticOrder S; S.init(T_TOK, 1024, G, (int)blockIdx.x);
        pg8::Epi8<FOut> E{FOut{P.in[0], P.out}};
        pg8::gemm_phase(lds, g, S, E);
    }
    GRID_BAR();

#if defined(CHECK_X1) && CHECK_X1 == 4
    check_x1(P, lds, ctl, (const bf16_t*)(ws + WS_PK));
    GRID_BAR();
    { const float c = log2f(1.0f + (float)__hip_atomic_load(ctl + 300, __ATOMIC_RELAXED, __HIP_MEMORY_SCOPE_AGENT));
      for (int i = blockIdx.x * 512 + tid; i < T_TOK * DM; i += G * 512) P.out[i] = c; }
    return;
#endif
    PHASE_END(6);
    {
        const float* g1 = P.in[21]; const float* b1 = P.in[22];
        for (int row = blockIdx.x * 8 + wave; row < T_TOK; row += G * 8) {
            f32x4* xr = (f32x4*)(P.out + (size_t)row * 1024) + lane;
            f32x4 v[4]; float s = 0.f;
#pragma unroll
            for (int j = 0; j < 4; ++j) { v[j] = xr[64 * j]; s += (v[j][0] + v[j][1]) + (v[j][2] + v[j][3]); }
            const float mean = wave_sum(s) * (1.f / 1024.f); float s2 = 0.f;
#pragma unroll
            for (int j = 0; j < 4; ++j) { v[j] = v[j] - mean; s2 += (v[j][0] * v[j][0] + v[j][1] * v[j][1]) + (v[j][2] * v[j][2] + v[j][3] * v[j][3]); }
            const float rstd = 1.f / sqrtf(wave_sum(s2) * (1.f / 1024.f) + LN_EPS);
            u32x2* ob = (u32x2*)((bf16_t*)(ws + WS_X1B) + (size_t)row * 1024) + lane;
#pragma unroll
            for (int j = 0; j < 4; ++j) {
                const f32x4 gg = ((const f32x4*)g1)[64 * j + lane], bb = ((const f32x4*)b1)[64 * j + lane];
                const f32x4 o = v[j] * rstd * gg + bb; xr[64 * j] = o;
                u32x2 pw; pw.x = cvt_pk_bf16(o[0], o[1]); pw.y = cvt_pk_bf16(o[2], o[3]); ob[64 * j] = pw;
            }
        }
    }
    GRID_BAR();

#ifdef CHECK_X1
    check_x1(P, lds, ctl, (const bf16_t*)(ws + WS_PK));
    GRID_BAR();
    { const float c = log2f(1.0f + (float)__hip_atomic_load(ctl + 300, __ATOMIC_RELAXED, __HIP_MEMORY_SCOPE_AGENT));
      for (int i = blockIdx.x * 512 + tid; i < T_TOK * DM; i += G * 512) P.out[i] = c; }
    return;
#endif
    PHASE_END(7);
    {
        pg8::Gemm g{(const bf16_t*)(ws + WS_X1B), (const bf16_t*)(ws + WS_WQ), T_TOK, 1024, 1024};
        pg8::StaticOrder S; S.init(T_TOK, 1024, G, (int)blockIdx.x);
        pg8::Epi8<FQP> E{FQP{(bf16_t*)(ws + WS_QP)}};
        pg8::gemm_phase(lds, g, S, E);
    }
    GRID_BAR();

#ifdef CHECK_QP
    check_qp(P, lds, ctl);
    GRID_BAR();
    { const float c = log2f(1.0f + (float)__hip_atomic_load(ctl + 300, __ATOMIC_RELAXED, __HIP_MEMORY_SCOPE_AGENT));
      for (int i = blockIdx.x * 512 + tid; i < T_TOK * DM; i += G * 512) P.out[i] = c; }
    return;
#endif
    PHASE_END(8);
#if DUP_PHASE == 9
    { const int gw9 = blockIdx.x * 8 + wave; peer_score_pair(P, lds, (gw9 >> 3) * 32, ((gw9 + 2048) >> 3) * 32, gw9 & 7, wave, lane); }
    GRID_BAR();
#endif
    { const int gw9 = blockIdx.x * 8 + wave; peer_score_pair(P, lds, (gw9 >> 3) * 32, ((gw9 + 2048) >> 3) * 32, gw9 & 7, wave, lane); }
    GRID_BAR();

#ifdef CHECK_PEER
    check_peer(P, lds, ctl);
    GRID_BAR();
    { const float c = log2f(1.0f + (float)__hip_atomic_load(ctl + 300 + CHECK_PEER, __ATOMIC_RELAXED, __HIP_MEMORY_SCOPE_AGENT));
      for (int i = blockIdx.x * 512 + tid; i < T_TOK * DM; i += G * 512) P.out[i] = c; }
    return;
#endif
    PHASE_END(9);
#ifdef CHECK_P10
    { const int row = (int)(((unsigned)blockIdx.x * 2654435761u) >> 18) & 16383; float* xsave = (float*)(ws + WS_Z) + (size_t)blockIdx.x * 1024;
      for (int n = tid; n < 1024; n += 512) xsave[n] = P.out[(size_t)row * 1024 + n]; }
    GRID_BAR();
#endif
#if DUP_PHASE == 10
    for (int tok = blockIdx.x * 8 + wave; tok < T_TOK; tok += G * 8) peer_token(P, tok, lane, (float*)(ws + WS_Z));
    GRID_BAR();
#endif
#ifdef P10_OLD
    for (int tok = blockIdx.x * 8 + wave; tok < T_TOK; tok += G * 8) peer_token(P, tok, lane, P.out);
#else
    { int ln10 = threadIdx.x & 63; asm volatile("" : "+v"(ln10));
      for (int tq = (blockIdx.x * 8 + wave) * 4; tq < T_TOK; tq += G * 8 * 4) peer_round4(P, lds + wave * 6144, tq, ln10); }
#endif
#ifdef CHECK_P10
    GRID_BAR();
    check_p10(P, lds, ctl);
    GRID_BAR();
    { const float c = log2f(1.0f + (float)__hip_atomic_load(ctl + 300, __ATOMIC_RELAXED, __HIP_MEMORY_SCOPE_AGENT));
      for (int i = blockIdx.x * 512 + tid; i < T_TOK * DM; i += G * 512) P.out[i] = c; }
#endif
}

extern "C" void kernel_launch(void* const* d_in, const int* in_sizes, int n_in, void* d_out, int out_size, void* d_ws, size_t ws_size, hipStream_t stream) {
    static int grid_blocks = 0;
    if (grid_blocks == 0) {
        if (n_in != 29 || out_size != T_TOK * DM || ws_size < WS_NEED) { fprintf(stderr, "kernel_launch: unexpected problem shape (n_in %d, out %d, ws %zu)\n", n_in, out_size, ws_size); grid_blocks = -1; return; }
        int dev = 0, cus = 0, per_cu = 0;
        hipGetDevice(&dev);
        hipDeviceGetAttribute(&cus, hipDeviceAttributeMultiprocessorCount, dev);
        hipFuncSetAttribute((const void*)hybrid_fwd, hipFuncAttributeMaxDynamicSharedMemorySize, LDS_BYTES);
        hipOccupancyMaxActiveBlocksPerMultiprocessor(&per_cu, (const void*)hybrid_fwd, 512, LDS_BYTES);
        if (per_cu < 1) { fprintf(stderr, "kernel_launch: occupancy query reports %d blocks per CU\n", per_cu); per_cu = 1; }
        grid_blocks = cus;
    }
    if (grid_blocks < 0) return;
    hipMemsetAsync((char*)d_ws + WS_CTL, 0, CTL_BYTES, stream);
    Params p{};
    for (int i = 0; i < 29; ++i) p.in[i] = (const float*)d_in[i];
    p.out = (float*)d_out; p.ws = (unsigned char*)d_ws;
    void* args[] = {&p};
    hipError_t e = hipLaunchCooperativeKernel((const void*)hybrid_fwd, dim3(grid_blocks), dim3(512), args, LDS_BYTES, stream);
    if (e != hipSuccess) fprintf(stderr, "cooperative launch failed: %s (grid %d)\n", hipGetErrorString(e), grid_blocks);
}
```
